# Optimizing an MI355X kernel written in HIP

```python
import jax, jax.numpy as jnp
from jax import lax
import numpy as np

D_MODEL = 1024
BATCH = 1
SEQ = 16384
DEPTH = 2

N_EVEN = (DEPTH + 1) // 2
N_ODD = DEPTH // 2
N_SUBLAYERS = 3
D_FF = 2816
EPS = 1e-6

A_WIDTH = D_MODEL // 2
A_GROUPS = 8
A_CONV = 31
B_WIDTH = D_MODEL // 2
B_CONV = 3
EVEN_IN = 2 * A_WIDTH + 3 * B_WIDTH
EVEN_MIX = A_WIDTH + B_WIDTH

POOL_WINDOWS = (2, 4, 8, 16)
C_GROUPS = len(POOL_WINDOWS)
C_WIDTH = D_MODEL // 2
C_GROUP_DIM = C_WIDTH // C_GROUPS
D_HEADS = 8
HEAD_DIM = 64
D_WIDTH = D_HEADS * HEAD_DIM
ODD_IN = C_WIDTH + 3 * D_WIDTH
ODD_MIX = C_WIDTH + D_WIDTH
MOBA_BLOCK = 256
MOBA_TOPK = 3
Q_CHUNK = 128

kernel_name = "hybrid_conv_pool_moba_macaron_adaln"


def rms_norm(x, g):
    xf = x.astype(jnp.float32)
    y = xf * lax.rsqrt(jnp.mean(xf * xf, axis=-1, keepdims=True) + EPS)
    return (y * g.astype(jnp.float32)).astype(x.dtype)


def modulate(h, shift, scale):
    return h * (1.0 + scale[:, None, :]) + shift[:, None, :]


def group_layer_norm(u, n_groups, g, b):
    bn, s, ch = u.shape
    uf = u.astype(jnp.float32).reshape(bn, s, n_groups, ch // n_groups)
    mu = jnp.mean(uf, axis=-1, keepdims=True)
    var = jnp.mean(jnp.square(uf - mu), axis=-1, keepdims=True)
    y = ((uf - mu) * lax.rsqrt(var + EPS)).reshape(bn, s, ch)
    return (y * g + b).astype(u.dtype)


def causal_depthwise_conv(u, w):
    k, ch = w.shape
    return lax.conv_general_dilated(
        u, w[:, None, :], window_strides=(1,), padding=[(k - 1, 0)],
        dimension_numbers=("NWC", "WIO", "NWC"), feature_group_count=ch)


def swiglu(h, w_gate, w_up, w_down):
    return (jax.nn.silu(h @ w_gate) * (h @ w_up)) @ w_down


def conv_mixers(h, w_in, conv_a_w, conv_a_b, ln_a_g, ln_a_b, conv_b_w, w_out):
    z = h @ w_in
    a_val, a_gate, b_gate, c_gate, b_val = jnp.split(
        z, [A_WIDTH, 2 * A_WIDTH, 2 * A_WIDTH + B_WIDTH, 2 * A_WIDTH + 2 * B_WIDTH], axis=-1)
    a = a_val * jax.nn.sigmoid(a_gate)
    a = causal_depthwise_conv(a, conv_a_w) + conv_a_b
    a = jax.nn.silu(group_layer_norm(a, A_GROUPS, ln_a_g, ln_a_b))
    bb = b_gate * causal_depthwise_conv(c_gate * b_val, conv_b_w)
    return jnp.concatenate([a, bb], axis=-1) @ w_out


def multiscale_pool(u, pool_w, pool_b, pool_scale):
    bn, s, _ = u.shape
    ug = u.reshape(bn, s, C_GROUPS, C_GROUP_DIM).astype(jnp.float32)
    cs0 = jnp.pad(jnp.cumsum(ug, axis=1), ((0, 0), (1, 0), (0, 0), (0, 0)))
    t1 = jnp.arange(1, s + 1, dtype=jnp.float32)
    means = []
    for g, w in enumerate(POOL_WINDOWS):
        upper = cs0[:, 1:, g]
        lower = jnp.pad(cs0[:, :s + 1 - w, g], ((0, 0), (w - 1, 0), (0, 0)))
        means.append((upper - lower) / jnp.minimum(t1, w)[None, :, None])
    pooled = (jnp.stack(means, axis=2) - ug).astype(u.dtype)
    mixed = jnp.einsum("bsgc,gcd->bsgd", pooled, pool_w) + pool_b
    return mixed.reshape(bn, s, C_WIDTH) * pool_scale


def moba_attention(q, k, v):
    bn, s, _ = q.shape
    s_pad = -(-s // MOBA_BLOCK) * MOBA_BLOCK
    nb = s_pad // MOBA_BLOCK
    topk = min(MOBA_TOPK, nb)

    def to_heads(t):
        return t.reshape(bn, s, D_HEADS, HEAD_DIM).transpose(0, 2, 1, 3)

    pad = ((0, 0), (0, 0), (0, s_pad - s), (0, 0))
    qh = to_heads(q) * (HEAD_DIM ** -0.5)
    kh = jnp.pad(to_heads(k), pad)
    vh = jnp.pad(to_heads(v), pad)
    k_blocks = kh.reshape(bn, D_HEADS, nb, MOBA_BLOCK, HEAD_DIM)
    v_blocks = vh.reshape(bn, D_HEADS, nb, MOBA_BLOCK, HEAD_DIM)
    k_mean = jnp.mean(k_blocks.astype(jnp.float32), axis=3)
    slopes = jnp.asarray(2.0 ** (-8.0 * np.arange(1, D_HEADS + 1) / D_HEADS), dtype=jnp.float32)
    b_idx = jnp.arange(bn)[:, None, None, None]
    h_idx = jnp.arange(D_HEADS)[None, :, None, None]
    offs = jnp.arange(MOBA_BLOCK)
    blk_ids = jnp.arange(nb)
    slot_ids = jnp.arange(topk)

    def chunk(ci):
        q0 = ci * Q_CHUNK
        own = q0 // MOBA_BLOCK
        qc = lax.dynamic_slice_in_dim(qh, q0, Q_CHUNK, axis=2)
        qpos = q0 + jnp.arange(Q_CHUNK)
        gate = jnp.einsum("bhqd,bhnd->bhqn", qc.astype(jnp.float32), k_mean)
        gate = jnp.where(blk_ids < own, gate, -jnp.inf)
        _, sel = lax.top_k(gate, topk)
        sel_valid = slot_ids < own
        k_sel = k_blocks[b_idx, h_idx, sel]
        v_sel = v_blocks[b_idx, h_idx, sel]
        s_sel = jnp.einsum("bhqd,bhqjkd->bhqjk", qc, k_sel).astype(jnp.float32)
        kpos_sel = sel[..., None] * MOBA_BLOCK + offs
        s_sel = s_sel - slopes[:, None, None, None] * (qpos[:, None, None] - kpos_sel)
        s_sel = jnp.where(sel_valid[:, None], s_sel, -jnp.inf)
        s_sel = s_sel.reshape(bn, D_HEADS, Q_CHUNK, topk * MOBA_BLOCK)
        k_own = lax.dynamic_slice_in_dim(kh, own * MOBA_BLOCK, MOBA_BLOCK, axis=2)
        v_own = lax.dynamic_slice_in_dim(vh, own * MOBA_BLOCK, MOBA_BLOCK, axis=2)
        dist = qpos[:, None] - (own * MOBA_BLOCK + offs)[None, :]
        s_own = jnp.einsum("bhqd,bhkd->bhqk", qc, k_own).astype(jnp.float32)
        s_own = jnp.where(dist >= 0, s_own - slopes[:, None, None] * dist, -jnp.inf)
        p = jax.nn.softmax(jnp.concatenate([s_sel, s_own], axis=-1), axis=-1).astype(v.dtype)
        p_sel, p_own = jnp.split(p, [topk * MOBA_BLOCK], axis=-1)
        p_sel = p_sel.reshape(bn, D_HEADS, Q_CHUNK, topk, MOBA_BLOCK)
        return (jnp.einsum("bhqjk,bhqjkd->bhqd", p_sel, v_sel)
                + jnp.einsum("bhqk,bhkd->bhqd", p_own, v_own))

    out = lax.map(chunk, jnp.arange(s // Q_CHUNK))
    return out.transpose(1, 0, 3, 2, 4).reshape(bn, s, D_WIDTH)


def pool_moba_mixers(h, w_in, pool_w, pool_b, pool_scale, w_out):
    z = h @ w_in
    u, q, k, v = jnp.split(z, [C_WIDTH, C_WIDTH + D_WIDTH, C_WIDTH + 2 * D_WIDTH], axis=-1)
    pooled = multiscale_pool(u, pool_w, pool_b, pool_scale)
    att = moba_attention(q, k, v)
    return jnp.concatenate([pooled, att], axis=-1) @ w_out


def setup_inputs(seed: int = 0) -> dict:
    key = jax.random.key(seed)
    ks = jax.random.split(key, 24)
    f32 = jnp.float32

    def nrm(k, shape, scale):
        return jax.random.normal(k, shape, dtype=f32) * scale

    return {
        "x": nrm(ks[0], (BATCH, SEQ, D_MODEL), 1.0),
        "c": nrm(ks[1], (BATCH, D_MODEL), 1.0),
        "ada_w": nrm(ks[2], (DEPTH, D_MODEL, N_SUBLAYERS * 3 * D_MODEL), D_MODEL ** -0.5),
        "ada_b": nrm(ks[3], (DEPTH, N_SUBLAYERS * 3 * D_MODEL), 0.02),
        "ffn_norm": 1.0 + nrm(ks[4], (DEPTH, 2, D_MODEL), 0.05),
        "ffn_w_gate": nrm(ks[5], (DEPTH, 2, D_MODEL, D_FF), D_MODEL ** -0.5),
        "ffn_w_up": nrm(ks[6], (DEPTH, 2, D_MODEL, D_FF), D_MODEL ** -0.5),
        "ffn_w_down": nrm(ks[7], (DEPTH, 2, D_FF, D_MODEL), D_FF ** -0.5),
        "mix_norm": 1.0 + nrm(ks[8], (DEPTH, D_MODEL), 0.05),
        "conv_w_in": nrm(ks[9], (N_EVEN, D_MODEL, EVEN_IN), D_MODEL ** -0.5),
        "conv_a_w": nrm(ks[10], (N_EVEN, A_CONV, A_WIDTH), A_CONV ** -0.5),
        "conv_a_b": nrm(ks[11], (N_EVEN, A_WIDTH), 0.02),
        "conv_a_ln_g": 1.0 + nrm(ks[12], (N_EVEN, A_WIDTH), 0.05),
        "conv_a_ln_b": nrm(ks[13], (N_EVEN, A_WIDTH), 0.02),
        "conv_b_w": nrm(ks[14], (N_EVEN, B_CONV, B_WIDTH), B_CONV ** -0.5),
        "conv_w_out": nrm(ks[15], (N_EVEN, EVEN_MIX, D_MODEL), EVEN_MIX ** -0.5),
        "pm_w_in": nrm(ks[16], (N_ODD, D_MODEL, ODD_IN), D_MODEL ** -0.5),
        "pool_w": nrm(ks[17], (N_ODD, C_GROUPS, C_GROUP_DIM, C_GROUP_DIM), C_GROUP_DIM ** -0.5),
        "pool_b": nrm(ks[18], (N_ODD, C_GROUPS, C_GROUP_DIM), 0.02),
        "pool_scale": 1.0 + nrm(ks[19], (N_ODD, C_WIDTH), 0.1),
        "pm_w_out": nrm(ks[20], (N_ODD, ODD_MIX, D_MODEL), ODD_MIX ** -0.5),
        "final_norm": 1.0 + nrm(ks[21], (D_MODEL,), 0.05),
    }


def reference(x, c, ada_w, ada_b, ffn_norm, ffn_w_gate, ffn_w_up, ffn_w_down, mix_norm,
              conv_w_in, conv_a_w, conv_a_b, conv_a_ln_g, conv_a_ln_b, conv_b_w, conv_w_out,
              pm_w_in, pool_w, pool_b, pool_scale, pm_w_out, final_norm):
    bn = x.shape[0]
    cond = jax.nn.silu(c)
    for i in range(DEPTH):
        mod = (cond @ ada_w[i] + ada_b[i]).reshape(bn, N_SUBLAYERS, 3, D_MODEL)
        h = modulate(rms_norm(x, ffn_norm[i, 0]), mod[:, 0, 0], mod[:, 0, 1])
        x = x + 0.5 * mod[:, 0, 2][:, None, :] * swiglu(
            h, ffn_w_gate[i, 0], ffn_w_up[i, 0], ffn_w_down[i, 0])
        h = modulate(rms_norm(x, mix_norm[i]), mod[:, 1, 0], mod[:, 1, 1])
        if i % 2 == 0:
            e = i // 2
            y = conv_mixers(h, conv_w_in[e], conv_a_w[e], conv_a_b[e], conv_a_ln_g[e],
                            conv_a_ln_b[e], conv_b_w[e], conv_w_out[e])
        else:
            o = i // 2
            y = pool_moba_mixers(h, pm_w_in[o], pool_w[o], pool_b[o], pool_scale[o], pm_w_out[o])
        x = x + mod[:, 1, 2][:, None, :] * y
        h = modulate(rms_norm(x, ffn_norm[i, 1]), mod[:, 2, 0], mod[:, 2, 1])
        x = x + 0.5 * mod[:, 2, 2][:, None, :] * swiglu(
            h, ffn_w_gate[i, 1], ffn_w_up[i, 1], ffn_w_down[i, 1])
    return rms_norm(x, final_norm)
```

```cpp
#include <hip/hip_runtime.h>
#include <hip/hip_bf16.h>
#include <cstdio>
#include <cstdint>
#include <cmath>

#ifndef MK_N_LAUNCHES
#define MK_N_LAUNCHES 20
#endif

constexpr int M = 16384, D = 1024, DFF = 2816, NGU = 2 * DFF, NCIN = 2560, NPIN = 2048;
constexpr int NHEAD = 8, HD = 64, MBLK = 256, NBLK = M / MBLK;
constexpr float EPS = 1e-6f;
constexpr float LOG2E = 1.4426950408889634f;
constexpr float QSCALE = 0.125f * LOG2E;

namespace pg8 {
#define PG8_LAS __attribute__((address_space(3)))
typedef unsigned short bf16_t;
typedef short bf16x8 __attribute__((ext_vector_type(8)));
typedef float f32x4 __attribute__((ext_vector_type(4)));
typedef unsigned u32x4 __attribute__((ext_vector_type(4)));
constexpr int BM = 256, BK = 64, HALF = 128, HTB = HALF * BK * 2  , STAGE_BYTES = 8 * HTB, NXCD = 8, WGM = 8;

__host__ __device__ __forceinline__ int lds_byte(int r, int c) { const int st = (r >> 4) * 2 + (c >> 5), rr = r & 15, cc = c & 31, ob = rr * 64 + cc * 2; return st * 1024 + (ob ^ (((ob >> 9) & 1) << 5)); }
__host__ __device__ __forceinline__ void stage_rc(int b, int& R, int& C) { const int st = b / 1024, sb = b % 1024, swz = sb ^ (((sb >> 9) & 1) << 5); R = (st >> 1) * 16 + swz / 64; C = (st & 1) * 32 + (swz % 64) / 2; }
__host__ __device__ __forceinline__ int perm32(int rho) { const int n = rho >> 4, i = rho & 15; return 8 * (i >> 2) + 4 * n + (i & 3); }

struct Unit { int pm, pn; };
struct Gemm { const bf16_t* A; const bf16_t* Bt; int M, N, K; };

struct StaticOrder {
    int nM, nN, nwg, G, c;
    __host__ __device__ void init(int M, int N, int G_, int c_) { nM = M / BM; nN = N / BM; nwg = nM * nN; G = G_; c = c_; }
    __host__ __device__ bool next(int i, Unit& u) const {
        const long L = (long)i * G + c; if (L >= nwg) return false;
        int wgid = (int)L; { const int q = nwg / NXCD, r = nwg % NXCD, xcd = wgid % NXCD, off = wgid / NXCD; wgid = (xcd < r ? xcd * (q + 1) : r * (q + 1) + (xcd - r) * q) + off; }
        const int nig = WGM * nN, gid = wgid / nig, fm = gid * WGM, gsz = (nM - fm) < WGM ? (nM - fm) : WGM;
        u.pm = fm + ((wgid % nig) % gsz); u.pn = (wgid % nig) / gsz; return true;
    }
    __device__ __forceinline__ void a_ready(const Unit&) const {}
    __device__ __forceinline__ void done(const Unit&) const {}
};

__device__ __forceinline__ unsigned cvt_pk_bf16(float lo, float hi) { unsigned r; asm volatile("v_cvt_pk_bf16_f32 %0, %1, %2" : "=v"(r) : "v"(lo), "v"(hi)); return r; }

typedef unsigned u32x2 __attribute__((ext_vector_type(2)));
__device__ __forceinline__ void load_rinv(const float* ssq, int row0, float (&rinv)[2][4]) {
#pragma unroll
    for (int ai = 0; ai < 2; ++ai)
#pragma unroll
        for (int m = 0; m < 4; ++m) { const int r = row0 + ai * HALF + m * 16;
            const float s = ((ssq[r] + ssq[M + r]) + ssq[2 * M + r]) + ssq[3 * M + r];
            rinv[ai][m] = 1.0f / sqrtf(s * (1.0f / 1024.0f) + EPS); }
}
__device__ __forceinline__ float sigm(float z) { return __builtin_amdgcn_rcpf(1.0f + __builtin_amdgcn_exp2f(-LOG2E * z)); }
__device__ __forceinline__ u32x4 pack8(const f32x4 a, const f32x4 b) { u32x4 w; w.x = cvt_pk_bf16(a[0], a[1]); w.y = cvt_pk_bf16(a[2], a[3]); w.z = cvt_pk_bf16(b[0], b[1]); w.w = cvt_pk_bf16(b[2], b[3]); return w; }

struct EpiGU {
    static constexpr bool PERM = true, AFTER_DRAIN = false;
    bf16_t* O; const float* bias; const float* ssq;
    __device__ __forceinline__ void operator()(const f32x4 (&acc)[2][2][4][2], const Unit& u, int wr, int wc, int fr, int fq) const {
        asm volatile("" : "+v"(fr), "+v"(fq));
        const int row0 = u.pm * BM + wr * 64 + fr, bcol0 = u.pn * BM + wc * 32 + 8 * fq, ocol0 = u.pn * HALF + wc * 32 + 8 * fq;
        f32x4 bv[2][2];
#pragma unroll
        for (int bj = 0; bj < 2; ++bj)
#pragma unroll
            for (int n = 0; n < 2; ++n) bv[bj][n] = *(const f32x4*)(bias + bcol0 + bj * HALF + 4 * n);
        float rinv[2][4]; load_rinv(ssq, row0, rinv);
#pragma unroll
        for (int ai = 0; ai < 2; ++ai)
#pragma unroll
            for (int m = 0; m < 4; ++m) { const float ri = rinv[ai][m]; bf16_t* rowp = O + (size_t)(row0 + ai * HALF + m * 16) * DFF + ocol0;
                f32x4 hv[2];
#pragma unroll
                for (int n = 0; n < 2; ++n) { const f32x4 g = acc[ai][0][m][n] * ri + bv[0][n], up = acc[ai][1][m][n] * ri + bv[1][n];
#pragma unroll
                    for (int e = 0; e < 4; ++e) hv[n][e] = g[e] * up[e] * sigm(g[e]); }
                *(u32x4*)rowp = pack8(hv[0], hv[1]);
                if (m & 1) asm volatile("" ::: "memory"); }
    }
};
struct EpiCin {
    static constexpr bool PERM = true, AFTER_DRAIN = false;
    bf16_t* O; const float* bias; const float* ssq;
    template <int KIND> __device__ __forceinline__ void run(const f32x4 (&acc)[2][2][4][2], const f32x4 (&bv)[2][2], const float (&rinv)[2][4], bf16_t* base) const {
#pragma unroll
        for (int ai = 0; ai < 2; ++ai)
#pragma unroll
            for (int m = 0; m < 4; ++m) { const float ri = rinv[ai][m]; bf16_t* rowp = base + (size_t)(ai * HALF + m * 16) * 1536;
                f32x4 z0[2], z1[2];
#pragma unroll
                for (int n = 0; n < 2; ++n) { z0[n] = acc[ai][0][m][n] * ri + bv[0][n]; z1[n] = acc[ai][1][m][n] * ri + bv[1][n]; }
                if (KIND == 2) { *(u32x4*)rowp = pack8(z0[0], z0[1]); *(u32x4*)(rowp + HALF) = pack8(z1[0], z1[1]); }
                else { f32x4 o[2];
#pragma unroll
                    for (int n = 0; n < 2; ++n)
#pragma unroll
                        for (int e = 0; e < 4; ++e) o[n][e] = KIND == 0 ? z0[n][e] * sigm(z1[n][e]) : z0[n][e] * z1[n][e];
                    *(u32x4*)rowp = pack8(o[0], o[1]); }
                asm volatile("" ::: "memory"); }
    }
    __device__ __forceinline__ void operator()(const f32x4 (&acc)[2][2][4][2], const Unit& u, int wr, int wc, int fr, int fq) const {
        asm volatile("" : "+v"(fr), "+v"(fq));
        const int row0 = u.pm * BM + wr * 64 + fr, bcol0 = u.pn * BM + wc * 32 + 8 * fq;
        f32x4 bv[2][2];
#pragma unroll
        for (int bj = 0; bj < 2; ++bj)
#pragma unroll
            for (int n = 0; n < 2; ++n) bv[bj][n] = *(const f32x4*)(bias + bcol0 + bj * HALF + 4 * n);
        float rinv[2][4]; load_rinv(ssq, row0, rinv);
        const int ocol0 = (u.pn >= 8 ? 1024 + 256 * (u.pn - 8) : 128 * u.pn) + wc * 32 + 8 * fq;
        bf16_t* base = O + (size_t)row0 * 1536 + ocol0;
        if (u.pn < 4) run<0>(acc, bv, rinv, base); else if (u.pn < 8) run<1>(acc, bv, rinv, base); else run<2>(acc, bv, rinv, base);
    }
};
struct EpiPin {
    static constexpr bool PERM = true, AFTER_DRAIN = false;
    bf16_t* O; const float* bias; const float* ssq;
    __device__ __forceinline__ void operator()(const f32x4 (&acc)[2][2][4][2], const Unit& u, int wr, int wc, int fr, int fq) const {
        asm volatile("" : "+v"(fr), "+v"(fq));
        const int row0 = u.pm * BM + wr * 64 + fr, bcol0 = u.pn * BM + wc * 32 + 8 * fq;
        f32x4 bv[2][2];
#pragma unroll
        for (int bj = 0; bj < 2; ++bj)
#pragma unroll
            for (int n = 0; n < 2; ++n) bv[bj][n] = *(const f32x4*)(bias + bcol0 + bj * HALF + 4 * n);
        float rinv[2][4]; load_rinv(ssq, row0, rinv);
        const int t = u.pn >> 1; const int slot = t == 0 ? 3 : t - 1;
        const float sc = t == 1 ? QSCALE : 1.0f;
        bf16_t* base = O + (size_t)slot * ((size_t)M * 512) + (size_t)row0 * 512 + 256 * (u.pn & 1) + wc * 32 + 8 * fq;
#pragma unroll
        for (int ai = 0; ai < 2; ++ai)
#pragma unroll
            for (int m = 0; m < 4; ++m) { const float ri = rinv[ai][m] * sc; bf16_t* rowp = base + (size_t)(ai * HALF + m * 16) * 512;
#pragma unroll
                for (int bj = 0; bj < 2; ++bj) { const f32x4 z0 = acc[ai][bj][m][0] * ri + bv[bj][0] * sc, z1 = acc[ai][bj][m][1] * ri + bv[bj][1] * sc;
                    *(u32x4*)(rowp + bj * HALF) = pack8(z0, z1); }
                asm volatile("" ::: "memory"); }
    }
};
struct EpiRes {
    static constexpr bool PERM = false, AFTER_DRAIN = true;
    const float* xin; float* xout; bf16_t* xb; const float* bias; float* ssq;
    __device__ __forceinline__ void fused(f32x4 (&acc)[2][2][4][2], const Unit& u, int wr, int wc, int fr, int fq, PG8_LAS unsigned char* lds, int wid, int lane) const {
        PG8_LAS float* P = (PG8_LAS float*)lds;
        asm volatile("" : "+v"(fr), "+v"(fq));
        const int col0 = u.pn * BM + wc * 32 + 4 * fq;
        f32x4 bv[2][2];
#pragma unroll
        for (int bj = 0; bj < 2; ++bj)
#pragma unroll
            for (int n = 0; n < 2; ++n) bv[bj][n] = bias ? *(const f32x4*)(bias + col0 + bj * HALF + n * 16) : (f32x4){0.f, 0.f, 0.f, 0.f};
#pragma unroll
        for (int ai = 0; ai < 2; ++ai)
#pragma unroll
            for (int m = 0; m < 4; ++m) { const int rt = ai * HALF + wr * 64 + m * 16 + fr; const size_t off = (size_t)(u.pm * BM + rt) * D + col0; float ss = 0.f;
#pragma unroll
                for (int bj = 0; bj < 2; ++bj)
#pragma unroll
                    for (int n = 0; n < 2; ++n) { const int c = bj * HALF + n * 16; const f32x4 v = *(const f32x4*)(xin + off + c) + acc[ai][bj][m][n] + bv[bj][n];
                        *(f32x4*)(xout + off + c) = v; ss += (v[0] * v[0] + v[1] * v[1]) + (v[2] * v[2] + v[3] * v[3]);
                        u32x2 w; w.x = cvt_pk_bf16(v[0], v[1]); w.y = cvt_pk_bf16(v[2], v[3]); *(u32x2*)(xb + off + c) = w; }
                ss += __shfl_xor(ss, 16); ss += __shfl_xor(ss, 32);
                if (fq == 0) P[rt * 4 + wc] = ss;
                if (m & 1) asm volatile("" ::: "memory"); }
        asm volatile("s_waitcnt lgkmcnt(0)" ::: "memory"); __builtin_amdgcn_s_barrier(); asm volatile("" ::: "memory");
        const int tid = wid * 64 + lane;
        if (tid < 256) { const float s = ((P[tid * 4 + 0] + P[tid * 4 + 1]) + P[tid * 4 + 2]) + P[tid * 4 + 3]; ssq[(size_t)u.pn * M + u.pm * BM + tid] = s; }
        asm volatile("s_waitcnt lgkmcnt(0)" ::: "memory"); __builtin_amdgcn_s_barrier(); asm volatile("" ::: "memory");
    }
};

template <class Epi, class Sched, bool ALIGN_EPI = false, bool SP2 = false>
__device__ __forceinline__ void gemm_phase(PG8_LAS unsigned char* lds, const Gemm g, const Sched& S, const Epi& E) {
    int tid = threadIdx.x; asm volatile("" : "+v"(tid));
    const int wid = __builtin_amdgcn_readfirstlane(tid >> 6), lane = tid & 63, wr = wid >> 2, wc = wid & 3, fr = lane & 15, fq = lane >> 4;
    const int K = g.K, nt = K / BK;
    unsigned voffA[2], voffB[2];
#pragma unroll
    for (int i = 0; i < 2; ++i) { int R, C; stage_rc(tid * 16 + i * 8192, R, C); const int Rb = Epi::PERM ? ((R & ~31) + perm32(R & 31)) : R;
        voffA[i] = (unsigned)(R * K + C) * 2u; voffB[i] = (unsigned)(Rb * K + C) * 2u; }
    const size_t kstep = (size_t)(BK * 2);
    const size_t hstep = (size_t)HALF * K * 2;
    const size_t tstep = 2 * hstep;
    const unsigned ldsw = (unsigned)wid * 1024u;
    const int aoff = lds_byte(wr * 64 + fr, fq * 8), boff = lds_byte(wc * 32 + fr, fq * 8);
#define PG8_SA(b, h) (((b) * 2 + (h)) * HTB)
#define PG8_SB(b, h) ((4 + (b) * 2 + (h)) * HTB)
#define PG8_STAGE(bufoff, gbase, voff) do { _Pragma("unroll") for (int _i = 0; _i < 2; ++_i) \
        __builtin_amdgcn_global_load_lds((const unsigned*)((const char*)(gbase) + (voff)[_i]), (PG8_LAS unsigned*)(lds + (bufoff) + ldsw + _i * 8192), 16, 0, 0); } while (0)
#define PG8_LDA(dst, b, h) do { _Pragma("unroll") for (int m = 0; m < 4; ++m) _Pragma("unroll") for (int k = 0; k < 2; ++k) dst[m][k] = *(const PG8_LAS bf16x8*)(lds + PG8_SA(b, h) + aoff + m * 2048 + k * 1024); } while (0)
#define PG8_LDB(dst, b, h) do { _Pragma("unroll") for (int n = 0; n < 2; ++n) _Pragma("unroll") for (int k = 0; k < 2; ++k) dst[n][k] = *(const PG8_LAS bf16x8*)(lds + PG8_SB(b, h) + boff + n * 2048 + k * 1024); } while (0)
#define PG8_MMA(ai, bj, At, Bt) do { __builtin_amdgcn_s_setprio(1); _Pragma("unroll") for (int m = 0; m < 4; ++m) _Pragma("unroll") for (int n = 0; n < 2; ++n) _Pragma("unroll") for (int k = 0; k < 2; ++k) \
        acc[ai][bj][m][n] = __builtin_amdgcn_mfma_f32_16x16x32_bf16(Bt[n][k], At[m][k], acc[ai][bj][m][n], 0, 0, 0); __builtin_amdgcn_s_setprio(0); } while (0)
#define PG8_WAIT_V(n) asm volatile("s_waitcnt vmcnt(" #n ")" ::: "memory")
#define PG8_WAIT_L(n) asm volatile("s_waitcnt lgkmcnt(" #n ")" ::: "memory")
#define PG8_BAR __builtin_amdgcn_s_barrier()
#define PG8_SCHED __builtin_amdgcn_sched_barrier(0)
    Unit cur, nxt; int ui = 0;
    if (!S.next(0, cur)) return;
    f32x4 acc[2][2][4][2];
#pragma unroll
    for (int a = 0; a < 2; ++a)
#pragma unroll
        for (int b = 0; b < 2; ++b)
#pragma unroll
            for (int m = 0; m < 4; ++m)
#pragma unroll
                for (int n = 0; n < 2; ++n) acc[a][b][m][n] = (f32x4){0.f, 0.f, 0.f, 0.f};
    bf16x8 At[4][2], B0[2][2], B1[2][2];
    const char* cA = (const char*)g.A + (size_t)cur.pm * tstep; const char* cB = (const char*)g.Bt + (size_t)cur.pn * tstep;
    S.a_ready(cur);
    if constexpr (SP2) {
        PG8_STAGE(PG8_SB(0, 0), cB, voffB); PG8_STAGE(PG8_SB(0, 1), cB + hstep, voffB); PG8_STAGE(PG8_SA(0, 0), cA, voffA); PG8_STAGE(PG8_SA(0, 1), cA + hstep, voffA);
        if (wr == 1) PG8_BAR;
        PG8_WAIT_V(2); PG8_BAR;
        PG8_STAGE(PG8_SB(1, 0), cB + kstep, voffB); PG8_STAGE(PG8_SA(1, 0), cA + kstep, voffA); PG8_STAGE(PG8_SB(1, 1), cB + hstep + kstep, voffB);
        PG8_WAIT_V(6); PG8_BAR;
    } else {
        PG8_STAGE(PG8_SB(0, 0), cB, voffB); PG8_STAGE(PG8_SA(0, 0), cA, voffA); PG8_STAGE(PG8_SB(0, 1), cB + hstep, voffB); PG8_STAGE(PG8_SA(0, 1), cA + hstep, voffA);
        if (wr == 1) PG8_BAR;
        PG8_WAIT_V(4); PG8_BAR;
        PG8_STAGE(PG8_SB(1, 0), cB + kstep, voffB); PG8_STAGE(PG8_SA(1, 0), cA + kstep, voffA); PG8_STAGE(PG8_SB(1, 1), cB + hstep + kstep, voffB);
        PG8_WAIT_V(6); PG8_BAR;
    }
    for (;;) {
        const bool has_next = S.next(ui + 1, nxt);
        const char* nA = has_next ? (const char*)g.A + (size_t)nxt.pm * tstep : cA; const char* nB = has_next ? (const char*)g.Bt + (size_t)nxt.pn * tstep : cB;
        for (int t = 0; t < nt; t += 2) {
            const bool last = (t == nt - 2);
            const char* a1 = cA + (size_t)(t + 1) * kstep;
            const char* a2 = last ? nA : cA + (size_t)(t + 2) * kstep; const char* b2 = last ? nB : cB + (size_t)(t + 2) * kstep;
            const char* a3 = a2 + kstep; const char* b3 = b2 + kstep;
            if (last && has_next) S.a_ready(nxt);
            if constexpr (SP2) {
            PG8_LDB(B0, 0, 0); PG8_LDB(B1, 0, 1); PG8_SCHED; PG8_LDA(At, 0, 0); PG8_STAGE(PG8_SA(1, 1), a1 + hstep, voffA);
            PG8_WAIT_V(8); PG8_WAIT_L(0); PG8_BAR; PG8_MMA(0, 0, At, B0); PG8_MMA(0, 1, At, B1); PG8_BAR; PG8_SCHED;
            PG8_LDA(At, 0, 1); PG8_STAGE(PG8_SB(0, 0), b2, voffB); PG8_STAGE(PG8_SB(0, 1), b2 + hstep, voffB); PG8_STAGE(PG8_SA(0, 0), a2, voffA);
            PG8_WAIT_V(8); PG8_WAIT_L(0); PG8_BAR; PG8_MMA(1, 0, At, B0); PG8_MMA(1, 1, At, B1); PG8_BAR; PG8_SCHED;
            PG8_LDB(B0, 1, 0); PG8_LDB(B1, 1, 1); PG8_SCHED; PG8_LDA(At, 1, 0); PG8_STAGE(PG8_SA(0, 1), a2 + hstep, voffA);
            PG8_WAIT_V(8); PG8_WAIT_L(0); PG8_BAR; PG8_MMA(0, 0, At, B0); PG8_MMA(0, 1, At, B1); PG8_BAR; PG8_SCHED;
            PG8_LDA(At, 1, 1); PG8_STAGE(PG8_SB(1, 0), b3, voffB); PG8_STAGE(PG8_SB(1, 1), b3 + hstep, voffB); PG8_STAGE(PG8_SA(1, 0), a3, voffA);
            PG8_WAIT_V(8); PG8_WAIT_L(0); PG8_BAR; PG8_MMA(1, 0, At, B0); PG8_MMA(1, 1, At, B1); PG8_BAR; PG8_SCHED;
            } else {
            PG8_LDB(B0, 0, 0); PG8_SCHED; PG8_LDA(At, 0, 0); PG8_STAGE(PG8_SA(1, 1), a1 + hstep, voffA);
            PG8_WAIT_L(8); PG8_BAR; PG8_WAIT_L(0); PG8_MMA(0, 0, At, B0); PG8_BAR; PG8_SCHED;
            PG8_LDB(B1, 0, 1); PG8_STAGE(PG8_SB(0, 0), b2, voffB);
            PG8_BAR; PG8_WAIT_L(0); PG8_MMA(0, 1, At, B1); PG8_BAR;
            PG8_LDA(At, 0, 1); PG8_STAGE(PG8_SA(0, 0), a2, voffA);
            PG8_BAR; PG8_WAIT_L(0); PG8_MMA(1, 0, At, B0); PG8_BAR; PG8_SCHED;
            PG8_STAGE(PG8_SB(0, 1), b2 + hstep, voffB);
            PG8_WAIT_V(6); PG8_BAR; PG8_MMA(1, 1, At, B1); PG8_BAR;
            PG8_LDB(B0, 1, 0); PG8_SCHED; PG8_LDA(At, 1, 0); PG8_STAGE(PG8_SA(0, 1), a2 + hstep, voffA);
            PG8_WAIT_L(8); PG8_BAR; PG8_WAIT_L(0); PG8_MMA(0, 0, At, B0); PG8_BAR; PG8_SCHED;
            PG8_LDB(B1, 1, 1); PG8_STAGE(PG8_SB(1, 0), b3, voffB);
            PG8_BAR; PG8_WAIT_L(0); PG8_MMA(0, 1, At, B1); PG8_BAR;
            PG8_LDA(At, 1, 1); PG8_STAGE(PG8_SA(1, 0), a3, voffA);
            PG8_BAR; PG8_WAIT_L(0); PG8_MMA(1, 0, At, B0); PG8_BAR; PG8_SCHED;
            PG8_STAGE(PG8_SB(1, 1), b3 + hstep, voffB);
            PG8_WAIT_V(6); PG8_BAR; PG8_MMA(1, 1, At, B1); PG8_BAR;
            }
        }
        if constexpr (ALIGN_EPI) { if (wr == 0) PG8_BAR; }
        if constexpr (!Epi::AFTER_DRAIN) { E(acc, cur, wr, wc, fr, fq); S.done(cur); }
        if (!has_next) break;
#pragma unroll
        for (int a = 0; a < 2; ++a)
#pragma unroll
            for (int b = 0; b < 2; ++b)
#pragma unroll
                for (int m = 0; m < 4; ++m)
#pragma unroll
                    for (int n = 0; n < 2; ++n) acc[a][b][m][n] = (f32x4){0.f, 0.f, 0.f, 0.f};
        cur = nxt; cA = nA; cB = nB; ++ui;
        if constexpr (ALIGN_EPI) { if (wr == 1) PG8_BAR; }
    }
    PG8_WAIT_V(0);
    if constexpr (!ALIGN_EPI) { if (wr == 0) PG8_BAR; }
    PG8_BAR;
    if constexpr (Epi::AFTER_DRAIN) { E.fused(acc, cur, wr, wc, fr, fq, lds, wid, lane); S.done(cur); }
#undef PG8_SA
#undef PG8_SB
#undef PG8_STAGE
#undef PG8_LDA
#undef PG8_LDB
#undef PG8_MMA
#undef PG8_WAIT_V
#undef PG8_WAIT_L
#undef PG8_BAR
#undef PG8_SCHED
}
}
#define GAS __attribute__((address_space(1)))
#define LAS __attribute__((address_space(3)))
typedef unsigned short bf16;
typedef unsigned v4u __attribute__((ext_vector_type(4)));
typedef float f32x4 __attribute__((ext_vector_type(4)));
typedef short bf16x8 __attribute__((ext_vector_type(8)));
typedef GAS unsigned gu32;
typedef GAS unsigned long long gu64;
#define RLX_AGENT __ATOMIC_RELAXED, __HIP_MEMORY_SCOPE_AGENT
#define LDS_WAIT() asm volatile("s_waitcnt lgkmcnt(0)" ::: "memory")
#define VM_WAIT() asm volatile("s_waitcnt vmcnt(0)" ::: "memory")
__device__ __forceinline__ unsigned long long rt() { return __builtin_amdgcn_s_memrealtime(); }
__device__ __forceinline__ unsigned f2bf(float f) { unsigned u = __builtin_bit_cast(unsigned, f); return (u + 0x7fffu + ((u >> 16) & 1u)) >> 16; }
__device__ __forceinline__ unsigned pk2(float lo, float hi) { return f2bf(lo) | (f2bf(hi) << 16); }

#define XB_TMO      128
#define XB_XCNT(j)  (256  + 64 * (j))
#define XB_XSUB(j)  (1280 + 64 * (j))
#define XB_XGEN(j)  (2304 + 64 * (j))
#define XB_TOP      3328
#define XB_TOPGEN   3392
#define XCD_BAR_WORDS 3456
#define XB_SPIN_CAP (1u << 18)

__device__ __forceinline__ unsigned xb_ld(unsigned* p)              { return __hip_atomic_load(p, __ATOMIC_RELAXED, __HIP_MEMORY_SCOPE_AGENT); }
__device__ __forceinline__ unsigned xb_add(unsigned* p, unsigned v) { return __hip_atomic_fetch_add(p, v, __ATOMIC_RELAXED, __HIP_MEMORY_SCOPE_AGENT); }
__device__ __forceinline__ unsigned xb_xcc_id() { return (unsigned)__builtin_amdgcn_s_getreg((3 << 11) | 20) & 0xFu; }
#define XB_SPIN(cond, bar) do { unsigned _sp = 0; while (cond) { __builtin_amdgcn_s_sleep(1); \
    if ((++_sp & 255u) == 0u) { if (xb_ld(&(bar)[XB_TMO])) break; if (_sp > XB_SPIN_CAP) { atomicAdd(&(bar)[XB_TMO], 1u); break; } } } } while (0)

struct XcdBarrier {
    unsigned* bar; unsigned x;
    volatile LAS unsigned* st;
};

__device__ __forceinline__ XcdBarrier xcd_barrier_post(unsigned* bar, volatile LAS unsigned* st) {
    XcdBarrier b; b.bar = bar; b.x = xb_xcc_id(); b.st = st;
    if (threadIdx.x == 0) (void)xb_add(&bar[XB_XCNT(b.x)], 1u);
    return b;
}
__device__ __forceinline__ void xcd_barrier_complete(unsigned* bar, unsigned x, unsigned& nloc, unsigned& nx) {
    const unsigned G = gridDim.x * gridDim.y * gridDim.z;
    unsigned sum, cnt, mine, sp = 0u;
    for (;;) {
        sum = 0u; cnt = 0u; mine = 0u;
#pragma unroll
        for (unsigned j = 0; j < 16; ++j) { const unsigned c = xb_ld(&bar[XB_XCNT(j)]); sum += c; cnt += (c > 0u) ? 1u : 0u; mine = (j == x) ? c : mine; }
        if (sum == G) break;
        __builtin_amdgcn_s_sleep(1);
        if ((++sp & 255u) == 0u) { if (xb_ld(&bar[XB_TMO])) break; if (sp > XB_SPIN_CAP) { atomicAdd(&bar[XB_TMO], 1u); break; } }
    }
    nloc = mine > 0u ? mine : 1u; nx = cnt > 0u ? cnt : 1u;
}

__device__ __forceinline__ void xcd_barrier(const XcdBarrier& b) {
    asm volatile("s_waitcnt vmcnt(0)" ::: "memory");
    __syncthreads();
    if (threadIdx.x == 0) {
        unsigned* bar = b.bar;
        __builtin_amdgcn_s_waitcnt(0);
        unsigned nloc = b.st[0], nx = b.st[1];
        if (nloc == 0u) { xcd_barrier_complete(bar, b.x, nloc, nx); b.st[0] = nloc; b.st[1] = nx; }
        const unsigned old = xb_add(&bar[XB_XSUB(b.x)], 1u);
        const unsigned gen = old / nloc;
        if (old + 1u == (gen + 1u) * nloc) {
            __builtin_amdgcn_fence(__ATOMIC_RELEASE, "agent");
            asm volatile("s_waitcnt vmcnt(0)" ::: "memory");
            const unsigned og = xb_add(&bar[XB_TOP], 1u);
            const unsigned tg = og / nx;
            if (og + 1u == (tg + 1u) * nx) xb_add(&bar[XB_TOPGEN], 1u);
            else XB_SPIN(xb_ld(&bar[XB_TOPGEN]) == tg, bar);
            __builtin_amdgcn_fence(__ATOMIC_ACQUIRE, "agent");
            xb_add(&bar[XB_XGEN(b.x)], 1u);
            asm volatile("s_waitcnt vmcnt(0)" ::: "memory");
        } else {
            XB_SPIN(xb_ld(&bar[XB_XGEN(b.x)]) == gen, bar);
            __builtin_amdgcn_fence(__ATOMIC_ACQUIRE, "agent");
            asm volatile("s_waitcnt vmcnt(0)" ::: "memory");
        }
    }
    __syncthreads();
}

constexpr size_t MiB = 1u << 20;
constexpr size_t WS_CTL = 0, CTL_ZERO_BYTES = 1 * MiB;
constexpr size_t WS_MOD = 1 * MiB;
constexpr size_t WS_BGU = WS_MOD + 128 * 1024;
constexpr size_t WS_BCIN = WS_MOD + 256 * 1024;
constexpr size_t WS_BPIN = WS_MOD + 272 * 1024;
constexpr size_t WS_BEFF = WS_MOD + 288 * 1024;
constexpr size_t WS_BPOUT = WS_MOD + 296 * 1024;
constexpr size_t WS_KMEAN = WS_MOD + 512 * 1024;
constexpr size_t WS_SSQ = 2 * MiB;
constexpr size_t WS_ML = 3 * MiB;
constexpr size_t WS_WEFF = 6 * MiB;
constexpr size_t WS_WGU = 8 * MiB;
constexpr size_t WS_WDN = 52 * MiB;
constexpr size_t WS_WCIN = 74 * MiB, WS_WCOUT = 79 * MiB, WS_WPIN = 81 * MiB, WS_WPOUT = 85 * MiB;
constexpr size_t WS_XB = 88 * MiB;
constexpr size_t WS_R1 = 120 * MiB;
constexpr size_t WS_Q = WS_R1, WS_K = WS_R1 + 16 * MiB, WS_V = WS_R1 + 32 * MiB, WS_U = WS_R1 + 48 * MiB, WS_LIST = WS_R1 + 64 * MiB;
constexpr size_t WS_MIX = 208 * MiB;
constexpr size_t WS_PO = 240 * MiB;
constexpr size_t WS_END = 288 * MiB;
constexpr int LIST_PER_HEAD = 256 * 2016;
static_assert(WS_R1 + (size_t)M * DFF * 2 <= WS_MIX && WS_LIST + (size_t)8 * LIST_PER_HEAD * 4 <= WS_MIX && WS_PO + (size_t)3 * M * 512 * 2 <= WS_END, "d_ws map");
constexpr int CW_TMO = 0, CW_CODE = 1, CW_BAR = 4096, CW_CUR = 8192;

constexpr int RING_OFF = 0, RING_BYTES = 131072;
constexpr int LDSCTL_OFF = RING_BYTES, MISC_OFF = LDSCTL_OFF + 320;
constexpr int LDS_BYTES = 147456;

enum Phase { PH_P0 = 0, PH_P1, PH_L0_GU1, PH_L0_DN1, PH_L0_CIN, PH_L0_CONV, PH_L0_COUT, PH_L0_GU2, PH_L0_DN2,
             PH_L1_GU1, PH_L1_DN1, PH_L1_PIN, PH_L1_PRE, PH_L1_SEL, PH_L1_ATTA, PH_L1_ATTB, PH_L1_POUT, PH_L1_GU2, PH_L1_DN2, PH_FINAL, NPHASE };
constexpr int NWAVES = 8;
constexpr int N_LAUNCHES = MK_N_LAUNCHES;

struct Frame {
    LAS unsigned char* lds;
    volatile LAS unsigned* MISC;
    gu32* ctl;
    int tid, lane, wave, G, bx;
    float* out;
    unsigned char* ws;
};
enum InIdx { IN_X = 0, IN_C, IN_ADA_W, IN_ADA_B, IN_FFN_NORM, IN_W_GATE, IN_W_UP, IN_W_DOWN, IN_MIX_NORM, IN_CONV_W_IN, IN_CONV_A_W, IN_CONV_A_B, IN_LN_A_G, IN_LN_A_B, IN_CONV_B_W,
             IN_CONV_W_OUT, IN_PM_W_IN, IN_POOL_W, IN_POOL_B, IN_POOL_SCALE, IN_PM_W_OUT, IN_FINAL_NORM };
typedef __attribute__((address_space(4))) const unsigned char* kptr_t;
__device__ __forceinline__ const float* inptr(int i) {
    kptr_t p = (kptr_t)__builtin_amdgcn_kernarg_segment_ptr(); asm volatile("" : "+s"(p));
    return *(const float* const __attribute__((address_space(4)))*)(p + 8 * i);
}
#define WSP(T, off) ((T*)(F.ws + (off)))

__device__ __forceinline__ float wave_sum(float v) {
#pragma unroll
    for (int o = 1; o < 64; o <<= 1) v += __shfl_xor(v, o);
    return v;
}
__device__ __forceinline__ float bf2f(unsigned h) { return __uint_as_float(h << 16); }
__device__ __forceinline__ void wg_sync() { __syncthreads(); }

__device__ __forceinline__ void p0_phase(Frame& F) {
    LAS float* sm = (LAS float*)F.lds;
    LAS float* red = sm + 1024;
    const float* cvec = inptr(IN_C); const float* ada_w = inptr(IN_ADA_W); const float* ada_b = inptr(IN_ADA_B);
    for (int k = F.tid; k < 1024; k += NWAVES * 64) { const float v = cvec[k]; sm[k] = v / (1.0f + expf(-v)); }
    wg_sync();
    for (int wg = F.bx; wg < 256; wg += F.G) {
        const int layer = wg >> 7, cbase = (wg & 127) * 72;
        const float* W = ada_w + (size_t)layer * 1024 * 9216 + cbase;
        const int rr = F.lane / 18, cc = F.lane - rr * 18;
        f32x4 acc = {0.f, 0.f, 0.f, 0.f};
        if (rr < 3) {
            const int kb = 128 * F.wave;
#pragma unroll 8
            for (int it = 0; it < 43; ++it) { const int kk = 3 * it + rr; if (kk < 128) { const int k = kb + kk; const f32x4 w = *(const f32x4*)(W + (size_t)k * 9216 + 4 * cc); acc += w * sm[k]; } }
#pragma unroll
            for (int e = 0; e < 4; ++e) red[(F.wave * 3 + rr) * 72 + 4 * cc + e] = acc[e];
        }
        wg_sync();
        if (F.tid < 72) { float s = ada_b[layer * 9216 + cbase + F.tid];
            for (int j = 0; j < 24; ++j) s += red[j * 72 + F.tid];
            WSP(float, WS_MOD)[layer * 9216 + cbase + F.tid] = s; }
        wg_sync();
    }
    { const int gw = F.bx * NWAVES + F.wave, NGW = F.G * NWAVES; bf16* XB = WSP(bf16, WS_XB); float* SSQ = WSP(float, WS_SSQ); const float* xin = inptr(IN_X);
      for (int m = gw; m < M; m += NGW) {
          const f32x4* xr = (const f32x4*)(xin + (size_t)m * D) + F.lane; f32x4 v[4]; float s = 0.f;
#pragma unroll
          for (int j = 0; j < 4; ++j) { v[j] = xr[64 * j]; s += (v[j][0] * v[j][0] + v[j][1] * v[j][1]) + (v[j][2] * v[j][2] + v[j][3] * v[j][3]); }
          s = wave_sum(s);
          unsigned long long* o8 = (unsigned long long*)(XB + (size_t)m * D) + F.lane;
#pragma unroll
          for (int j = 0; j < 4; ++j) o8[64 * j] = (unsigned long long)pk2(v[j][0], v[j][1]) | ((unsigned long long)pk2(v[j][2], v[j][3]) << 32);
          if (F.lane < 4) SSQ[(size_t)F.lane * M + m] = F.lane == 0 ? s : 0.f;
      } }
    const float* pool_w = inptr(IN_POOL_W); const float* pool_scale = inptr(IN_POOL_SCALE); const float* pm_w_out = inptr(IN_PM_W_OUT); const float* pool_b = inptr(IN_POOL_B);
    for (int gid = F.bx * NWAVES * 64 + F.tid; gid < 512 * 256; gid += F.G * NWAVES * 64) {
        const int krow = gid >> 8, n4 = (gid & 255) * 4, g = krow >> 7;
        const float* pw = pool_w + (size_t)krow * 128; const float* ps = pool_scale + g * 128; const float* wo = pm_w_out + (size_t)(g * 128) * 1024 + n4;
        f32x4 acc = {0.f, 0.f, 0.f, 0.f};
#pragma unroll 8
        for (int d = 0; d < 128; ++d) { const float a = pw[d] * ps[d]; acc += *(const f32x4*)(wo + (size_t)d * 1024) * a; }
        *(f32x4*)(WSP(float, WS_WEFF) + (size_t)krow * 1024 + n4) = acc;
    }
    for (int n = F.bx * NWAVES * 64 + F.tid; n < 1024; n += F.G * NWAVES * 64) {
        float s = 0.f;
        for (int k = 0; k < 512; ++k) s += pool_b[k] * pool_scale[k] * pm_w_out[(size_t)k * 1024 + n];
        WSP(float, WS_BEFF)[n] = s;
    }
}

__device__ __forceinline__ void prep_strip(Frame& F, const float* src, int ldn, const float* src2, int ksplit, int kbeg, int ktiles,
                                           bf16* dst, int ldk, bool useG, const LAS float* Gs, const LAS float* Ss, const float* rsc, float rs_mul, float* bias_out, LAS float* red) {
    const int r = F.lane >> 4, c16 = F.lane & 15;
    f32x4 rs = {rs_mul, rs_mul, rs_mul, rs_mul};
    if (rsc) { const f32x4 g = *(const f32x4*)(rsc + 4 * c16); rs = g * rs_mul; }
    f32x4 bacc = {0.f, 0.f, 0.f, 0.f};
    for (int t = F.wave; t < ktiles; t += NWAVES) {
        const int k0 = kbeg + 64 * t + 16 * r;
        f32x4 v[16];
#pragma unroll
        for (int i = 0; i < 16; ++i) { const int k = k0 + i; const float* p = (src2 && k >= ksplit) ? src2 + (size_t)k * ldn : src + (size_t)k * ldn; v[i] = *(const f32x4*)(p + 4 * c16); }
        if (useG) {
#pragma unroll
            for (int i = 0; i < 16; ++i) { bacc += v[i] * Ss[k0 + i]; v[i] = v[i] * Gs[k0 + i]; }
        }
#pragma unroll
        for (int e = 0; e < 4; ++e) {
            v4u lo, hi; const float s = rs[e];
            lo.x = pk2(v[0][e] * s, v[1][e] * s);   lo.y = pk2(v[2][e] * s, v[3][e] * s);   lo.z = pk2(v[4][e] * s, v[5][e] * s);   lo.w = pk2(v[6][e] * s, v[7][e] * s);
            hi.x = pk2(v[8][e] * s, v[9][e] * s);   hi.y = pk2(v[10][e] * s, v[11][e] * s); hi.z = pk2(v[12][e] * s, v[13][e] * s); hi.w = pk2(v[14][e] * s, v[15][e] * s);
            bf16* o = dst + (size_t)(4 * c16 + e) * ldk + k0;
            *(v4u*)o = lo; *(v4u*)(o + 8) = hi;
        }
    }
    if (bias_out) {
#pragma unroll
        for (int e = 0; e < 4; ++e) { float s = bacc[e]; s += __shfl_xor(s, 16); s += __shfl_xor(s, 32); bacc[e] = s; }
        if (r == 0) {
#pragma unroll
            for (int e = 0; e < 4; ++e) red[F.wave * 64 + 4 * c16 + e] = bacc[e];
        }
        wg_sync();
        if (F.tid < 64) { float s = 0.f;
#pragma unroll
            for (int w = 0; w < NWAVES; ++w) s += red[w * 64 + F.tid];
            bias_out[F.tid] = s; }
        wg_sync();
    }
}
__device__ __forceinline__ void p1_phase(Frame& F) {
    LAS float* Gs = (LAS float*)F.lds;
    LAS float* Ss = Gs + 1024;
    LAS float* red = Ss + 1024;
    const float* MOD = WSP(float, WS_MOD);
    constexpr int N_GU = 352, N_CIN = 40, N_PIN = 32, N_COUT = 16, N_POUT = 16, N_DN = 256;
    constexpr int NITEMS = N_GU + N_CIN + N_PIN + N_COUT + N_POUT + N_DN;
    for (int it = F.bx; it < NITEMS; it += F.G) {
        int s = it;
        if (s < N_GU + N_CIN + N_PIN) {
            const float *nrm, *md; const float* src; int ldn; bf16* dst; float* bias; int n0, drow;
            if (s < N_GU) { const int f = s / 88, r = s % 88, isup = r / 44; n0 = (r % 44) * 64;
                src = inptr(isup ? IN_W_UP : IN_W_GATE) + (size_t)f * 1024 * DFF + n0; ldn = DFF;
                drow = 256 * (n0 / 128) + 128 * isup + (n0 % 128); dst = WSP(bf16, WS_WGU) + (size_t)f * NGU * 1024 + (size_t)drow * 1024; bias = WSP(float, WS_BGU) + f * NGU + drow;
                nrm = inptr(IN_FFN_NORM) + f * 1024; md = MOD + (f >> 1) * 9216 + ((f & 1) ? 6 : 0) * 1024; }
            else if (s < N_GU + N_CIN) { s -= N_GU; n0 = s * 64; const int seg = n0 / 512, c = n0 % 512, t2 = 256 * (c / 128) + (c % 128);
                drow = seg == 0 ? t2 : seg == 1 ? t2 + 128 : seg == 2 ? 2048 + c : seg == 3 ? 1024 + t2 : 1024 + t2 + 128;
                src = inptr(IN_CONV_W_IN) + n0; ldn = NCIN; dst = WSP(bf16, WS_WCIN) + (size_t)drow * 1024; bias = WSP(float, WS_BCIN) + drow;
                nrm = inptr(IN_MIX_NORM); md = MOD + 3 * 1024; }
            else { s -= N_GU + N_CIN; n0 = s * 64; drow = n0;
                src = inptr(IN_PM_W_IN) + n0; ldn = NPIN; dst = WSP(bf16, WS_WPIN) + (size_t)drow * 1024; bias = WSP(float, WS_BPIN) + drow;
                nrm = inptr(IN_MIX_NORM) + 1024; md = MOD + 9216 + 3 * 1024; }
            for (int k = F.tid; k < 1024; k += NWAVES * 64) { Gs[k] = nrm[k] * (1.0f + md[1024 + k]); Ss[k] = md[k]; }
            wg_sync();
            prep_strip(F, src, ldn, nullptr, 0, 0, 16, dst, 1024, true, Gs, Ss, nullptr, 1.0f, bias, red);
            continue;
        }
        s -= N_GU + N_CIN + N_PIN;
        if (s < N_COUT) { const int n0 = s * 64;
            prep_strip(F, inptr(IN_CONV_W_OUT) + n0, 1024, nullptr, 0, 0, 16, WSP(bf16, WS_WCOUT) + (size_t)n0 * 1024, 1024, false, Gs, Ss, MOD + 5 * 1024 + n0, 1.0f, nullptr, red);
            continue; }
        s -= N_COUT;
        if (s < N_POUT) { const int n0 = s * 64; const float* gate = MOD + 9216 + 5 * 1024 + n0;
            prep_strip(F, WSP(float, WS_WEFF) + n0, 1024, inptr(IN_PM_W_OUT) + n0, 512, 0, 16, WSP(bf16, WS_WPOUT) + (size_t)n0 * 1024, 1024, false, Gs, Ss, gate, 1.0f, nullptr, red);
            if (F.tid < 64) WSP(float, WS_BPOUT)[n0 + F.tid] = gate[F.tid] * WSP(float, WS_BEFF)[n0 + F.tid];
            continue; }
        s -= N_POUT;
        { const int f = s / 64, r = s % 64, n0 = (r >> 2) * 64, kq = r & 3;
          const float* gate = MOD + (f >> 1) * 9216 + (((f & 1) ? 6 : 0) + 2) * 1024 + n0;
          prep_strip(F, inptr(IN_W_DOWN) + (size_t)f * DFF * 1024 + n0, 1024, nullptr, 0, 704 * kq, 11, WSP(bf16, WS_WDN) + (size_t)f * 1024 * DFF + (size_t)n0 * DFF, DFF, false, Gs, Ss, gate, 0.5f, nullptr, red); }
    }
}

__device__ __forceinline__ void conv_phase(Frame& F) {
    const bf16* ZC = WSP(bf16, WS_R1); bf16* MIX = WSP(bf16, WS_MIX);
    const int c = F.wave * 64 + F.lane;
    const float* conv_a_w = inptr(IN_CONV_A_W); const float* conv_b_w = inptr(IN_CONV_B_W);
    float w[31];
#pragma unroll
    for (int k = 0; k < 31; ++k) w[k] = conv_a_w[k * 512 + c];
    const float cb = inptr(IN_CONV_A_B)[c], lg = inptr(IN_LN_A_G)[c], lb = inptr(IN_LN_A_B)[c];
    const float w0 = conv_b_w[c], w1 = conv_b_w[512 + c], w2 = conv_b_w[1024 + c];
    for (int unit = F.bx; unit < M / 64; unit += F.G) {
        const int t0 = unit * 64;
        float win[31];
#pragma unroll
        for (int k = 0; k < 31; ++k) win[k] = 0.f;
        for (int jj = 0; jj < 4; ++jj) {
            float nx[31];
#pragma unroll
            for (int i = 0; i < 31; ++i) { const int tt = jj * 31 + i, t = t0 - 30 + tt; nx[i] = (tt < 94 && t >= 0) ? bf2f(ZC[(size_t)t * 1536 + c]) : 0.f; }
#pragma unroll
            for (int i = 0; i < 31; ++i) { const int tt = jj * 31 + i;
                win[i] = nx[i];
                if (tt >= 30 && tt < 94) {
                    float y = cb;
#pragma unroll
                    for (int k = 0; k < 31; ++k) y += w[k] * win[(i + 1 + k) % 31];
                    const float mean = wave_sum(y) * (1.0f / 64.0f), d = y - mean, var = wave_sum(d * d) * (1.0f / 64.0f);
                    const float yn = d * (1.0f / sqrtf(var + EPS)) * lg + lb;
                    const float sv = yn / (1.0f + __builtin_amdgcn_exp2f(-LOG2E * yn));
                    MIX[(size_t)(t0 - 30 + tt) * 1024 + c] = (bf16)f2bf(sv);
                }
                __builtin_amdgcn_sched_barrier(0); }
        }
        float p2 = t0 >= 2 ? bf2f(ZC[(size_t)(t0 - 2) * 1536 + 512 + c]) : 0.f, p1 = t0 >= 1 ? bf2f(ZC[(size_t)(t0 - 1) * 1536 + 512 + c]) : 0.f;
#pragma unroll 8
        for (int tt = 0; tt < 64; ++tt) { const int t = t0 + tt; const float cur = bf2f(ZC[(size_t)t * 1536 + 512 + c]), bg = bf2f(ZC[(size_t)t * 1536 + 1024 + c]);
            MIX[(size_t)t * 1024 + 512 + c] = (bf16)f2bf(bg * (w0 * p2 + w1 * p1 + w2 * cur)); p2 = p1; p1 = cur; }
    }
}

__device__ __forceinline__ void pre_phase(Frame& F) {
    const bf16* Kb = WSP(bf16, WS_K); const bf16* U = WSP(bf16, WS_U); bf16* MIX = WSP(bf16, WS_MIX); float* KM = WSP(float, WS_KMEAN);
    LAS float* part = (LAS float*)F.lds;
    for (int unit = F.bx; unit < NBLK * NHEAD; unit += F.G) {
        const int b = unit >> 3, h = unit & 7, key = F.tid >> 3, ch = F.tid & 7;
        float s[8];
#pragma unroll
        for (int e = 0; e < 8; ++e) s[e] = 0.f;
#pragma unroll
        for (int i = 0; i < 4; ++i) { const v4u q = *(const v4u*)(Kb + (size_t)(b * 256 + 64 * i + key) * 512 + h * 64 + ch * 8);
            s[0] += bf2f(q.x & 0xffffu); s[1] += bf2f(q.x >> 16); s[2] += bf2f(q.y & 0xffffu); s[3] += bf2f(q.y >> 16);
            s[4] += bf2f(q.z & 0xffffu); s[5] += bf2f(q.z >> 16); s[6] += bf2f(q.w & 0xffffu); s[7] += bf2f(q.w >> 16); }
#pragma unroll
        for (int e = 0; e < 8; ++e) part[F.tid * 8 + e] = s[e];
        wg_sync();
        if (F.tid < 64) { const int cq = F.tid >> 3, e = F.tid & 7; float t = 0.f;
            for (int kk = 0; kk < 64; ++kk) t += part[(kk * 8 + cq) * 8 + e];
            KM[(size_t)(h * 64 + b) * 64 + F.tid] = t * (1.0f / 256.0f); }
        wg_sync();
    }
    for (int idx = F.bx * NWAVES * 64 + F.tid; idx < M * 64; idx += F.G * NWAVES * 64) {
        const int t = idx >> 6, ch = idx & 63, w = 2 << (ch >> 4), n = (t + 1) < w ? (t + 1) : w;
        float s[8], u0[8];
#pragma unroll
        for (int e = 0; e < 8; ++e) s[e] = 0.f;
        for (int j = 0; j < n; ++j) { const v4u q = *(const v4u*)(U + (size_t)(t - j) * 512 + ch * 8);
            float v[8] = {bf2f(q.x & 0xffffu), bf2f(q.x >> 16), bf2f(q.y & 0xffffu), bf2f(q.y >> 16), bf2f(q.z & 0xffffu), bf2f(q.z >> 16), bf2f(q.w & 0xffffu), bf2f(q.w >> 16)};
#pragma unroll
            for (int e = 0; e < 8; ++e) { s[e] += v[e]; if (j == 0) u0[e] = v[e]; } }
        const float inv = 1.0f / (float)n; v4u o;
        o.x = pk2(s[0] * inv - u0[0], s[1] * inv - u0[1]); o.y = pk2(s[2] * inv - u0[2], s[3] * inv - u0[3]);
        o.z = pk2(s[4] * inv - u0[4], s[5] * inv - u0[5]); o.w = pk2(s[6] * inv - u0[6], s[7] * inv - u0[7]);
        *(v4u*)(MIX + (size_t)t * 1024 + ch * 8) = o;
    }
}

__device__ __forceinline__ int list_off(int b) { return 256 * (63 * b - (b * (b - 1)) / 2); }
__device__ __forceinline__ void sel_phase(Frame& F) {
    const bf16* Qb = WSP(bf16, WS_Q); const float* KM = WSP(float, WS_KMEAN); unsigned* LIST = WSP(unsigned, WS_LIST);
    LAS float* km = (LAS float*)F.lds;
    for (int unit = F.bx; unit < NHEAD * (M / 512); unit += F.G) {
        const int h = unit & 7, chunk = unit >> 3, t = chunk * 512 + F.tid, own = t >> 8, nb = 2 * chunk + 1;
        wg_sync();
        for (int i = F.tid; i < nb * 64; i += NWAVES * 64) km[i] = KM[(size_t)h * 4096 + i];
        wg_sync();
        float q[64];
#pragma unroll
        for (int i = 0; i < 8; ++i) { const v4u v = *(const v4u*)(Qb + (size_t)t * 512 + h * 64 + i * 8);
            q[8 * i + 0] = bf2f(v.x & 0xffffu); q[8 * i + 1] = bf2f(v.x >> 16); q[8 * i + 2] = bf2f(v.y & 0xffffu); q[8 * i + 3] = bf2f(v.y >> 16);
            q[8 * i + 4] = bf2f(v.z & 0xffffu); q[8 * i + 5] = bf2f(v.z >> 16); q[8 * i + 6] = bf2f(v.w & 0xffffu); q[8 * i + 7] = bf2f(v.w >> 16); }
        float v0 = -INFINITY, v1 = -INFINITY, v2 = -INFINITY; int i0 = 0, i1 = 0, i2 = 0;
        for (int b = 0; b < nb; ++b) {
            float g = 0.f;
#pragma unroll
            for (int d4 = 0; d4 < 16; ++d4) { const f32x4 kv = *(const LAS f32x4*)(km + b * 64 + 4 * d4); g += (q[4 * d4] * kv[0] + q[4 * d4 + 1] * kv[1]) + (q[4 * d4 + 2] * kv[2] + q[4 * d4 + 3] * kv[3]); }
            if (b < own) {
                if (g > v0) { v2 = v1; i2 = i1; v1 = v0; i1 = i0; v0 = g; i0 = b; }
                else if (g > v1) { v2 = v1; i2 = i1; v1 = g; i1 = b; }
                else if (g > v2) { v2 = g; i2 = b; }
            }
        }
        const int nsel = own < 3 ? own : 3;
        if (nsel > 0) { const unsigned p = atomicAdd((unsigned*)F.ctl + CW_CUR + h * 64 + i0, 1u); LIST[(size_t)h * LIST_PER_HEAD + list_off(i0) + p] = (unsigned)t; }
        if (nsel > 1) { const unsigned p = atomicAdd((unsigned*)F.ctl + CW_CUR + h * 64 + i1, 1u); LIST[(size_t)h * LIST_PER_HEAD + list_off(i1) + p] = (unsigned)t | (1u << 16); }
        if (nsel > 2) { const unsigned p = atomicAdd((unsigned*)F.ctl + CW_CUR + h * 64 + i2, 1u); LIST[(size_t)h * LIST_PER_HEAD + list_off(i2) + p] = (unsigned)t | (2u << 16); }
    }
}

namespace att {
typedef short s16x4 __attribute__((ext_vector_type(4)));
typedef float f32x16 __attribute__((ext_vector_type(16)));
typedef short v4i16_t __attribute__((ext_vector_type(4)));
typedef float f32x2_t __attribute__((ext_vector_type(2)));
typedef __bf16 bf16x2_t __attribute__((ext_vector_type(2)));
constexpr int KOFF = 0, VOFF = 32768, WSF_OFF = 65536, QL_OFF = WSF_OFF + 2048, COEF_OFF = QL_OFF + 1024, SCAN_OFF = COEF_OFF + 4096, ATT_LDS_END = SCAN_OFF + 2048;
__device__ __forceinline__ int crow(int r, int hi) { return (r & 3) + 8 * (r >> 2) + 4 * hi; }
__device__ __forceinline__ unsigned cvtpk(float lo, float hi) { f32x2_t v = {lo, hi}; bf16x2_t b = __builtin_convertvector(v, bf16x2_t); return __builtin_bit_cast(unsigned, b); }
__device__ __forceinline__ s16x4 vtr(const LAS unsigned char* p) { return __builtin_bit_cast(s16x4, __builtin_amdgcn_ds_read_tr16_b64_v4i16((LAS v4i16_t*)p)); }
#define ATT_MFMA(a, b, c) __builtin_amdgcn_mfma_f32_32x32x16_bf16(a, b, c, 0, 0, 0)

__device__ __forceinline__ void load_kv(LAS unsigned char* lds, const bf16* Kb, const bf16* Vb, int b, int h, int wave, int lane) {
    const bf16* ks = Kb + (size_t)(b * 256 + lane) * 512 + h * 64 + wave * 8;
    const int vkey = 16 * (wave & 3) + (lane >> 2);
    const bf16* vs = Vb + (size_t)(b * 256 + vkey) * 512 + h * 64 + (wave >> 2) * 32 + (lane & 3) * 8;
    v4u kq[4], vq[4];
#pragma unroll
    for (int i = 0; i < 4; ++i) { kq[i] = *(const v4u*)(ks + (size_t)i * 64 * 512); vq[i] = *(const v4u*)(vs + (size_t)i * 64 * 512); }
#pragma unroll
    for (int i = 0; i < 4; ++i) { *(LAS v4u*)(lds + KOFF + i * 8192 + wave * 1024 + lane * 16) = kq[i];
                                  *(LAS v4u*)(lds + VOFF + i * 8192 + (wave >> 2) * 4096 + vkey * 64 + (lane & 3) * 16) = vq[i]; }
}

template <bool OWN>
__device__ __forceinline__ void item(Frame& F, int h, int b, const unsigned* list, int nrows) {
    LAS unsigned char* lds = F.lds;
    const int lane = F.lane, wave = F.wave, r32 = lane & 31, hi = lane >> 5;
    LAS float* wsf = (LAS float*)(lds + WSF_OFF) + wave * 64;
    LAS unsigned* QL = (LAS unsigned*)(lds + QL_OFF);
    LAS float* coef = (LAS float*)(lds + COEF_OFF) + wave * 128;
    const bf16* Qb = WSP(bf16, WS_Q);
    wg_sync();
    load_kv(lds, WSP(bf16, WS_K), WSP(bf16, WS_V), b, h, wave, lane);
    if (F.tid < 256) { unsigned e;
        if (OWN) e = (unsigned)(b * 256 + F.tid);
        else { const int rr = F.tid < nrows ? F.tid : nrows - 1; e = list[rr] | (F.tid < nrows ? 0u : 0x80000000u); }
        QL[F.tid] = e; }
    wg_sync();
    const unsigned ent = QL[wave * 32 + r32];
    const int t = (int)(ent & 0x3fffu);
    bf16x8 qr[4];
#pragma unroll
    for (int d0 = 0; d0 < 4; ++d0) qr[d0] = *(const bf16x8*)(Qb + (size_t)t * 512 + h * 64 + d0 * 16 + hi * 8);
    const float slope2 = LOG2E / (float)(2 << h);
    float m = -INFINITY, l = 0.f; f32x16 o[2]; o[0] = f32x16{}; o[1] = f32x16{};
    const int ntile = OWN ? ((wave * 32 + 31) >> 6) + 1 : 4;
#pragma unroll 1
    for (int tile = 0; tile < ntile; ++tile) {
        const float base = slope2 * (float)(b * 256 + tile * 64 + 4 * hi - t);
        f32x16 p0, p1;
#pragma unroll
        for (int r = 0; r < 16; ++r) { p0[r] = base + slope2 * (float)((r & 3) + 8 * (r >> 2)); p1[r] = p0[r] + 32.0f * slope2; }
        const LAS unsigned char* kb = lds + KOFF + tile * 8192 + hi * 1024 + r32 * 16;
#pragma unroll
        for (int d0 = 0; d0 < 4; ++d0) { const bf16x8 k0 = *(const LAS bf16x8*)(kb + d0 * 2048), k1 = *(const LAS bf16x8*)(kb + d0 * 2048 + 512);
            p0 = ATT_MFMA(k0, qr[d0], p0); p1 = ATT_MFMA(k1, qr[d0], p1); }
        if (OWN) { const int qo = t - b * 256, kk = tile * 64 + 4 * hi;
#pragma unroll
            for (int r = 0; r < 16; ++r) { const int kv = kk + (r & 3) + 8 * (r >> 2); if (kv > qo) p0[r] = -INFINITY; if (kv + 32 > qo) p1[r] = -INFINITY; } }
        float rm = fmaxf(p0[0], p1[0]);
#pragma unroll
        for (int r = 1; r < 16; ++r) rm = fmaxf(rm, fmaxf(p0[r], p1[r]));
        rm = fmaxf(rm, __shfl_xor(rm, 32));
        const float mn = fmaxf(m, rm), alpha = __builtin_amdgcn_exp2f(m - mn);
        m = mn;
        float ls = 0.f;
#pragma unroll
        for (int r = 0; r < 16; ++r) { p0[r] = __builtin_amdgcn_exp2f(p0[r] - mn); p1[r] = __builtin_amdgcn_exp2f(p1[r] - mn); ls += p0[r] + p1[r]; }
        l = l * alpha + ls;
        if (tile > 0) {
            if (hi == 0) wsf[r32] = alpha;
            asm volatile("s_waitcnt lgkmcnt(0)" ::: "memory");
#pragma unroll
            for (int r = 0; r < 16; ++r) { const float a = wsf[crow(r, hi)]; o[0][r] *= a; o[1][r] *= a; }
        }
        bf16x8 pa[4];
        { v4u w0 = {cvtpk(p0[0], p0[1]), cvtpk(p0[2], p0[3]), cvtpk(p0[4], p0[5]), cvtpk(p0[6], p0[7])};
          v4u w1 = {cvtpk(p0[8], p0[9]), cvtpk(p0[10], p0[11]), cvtpk(p0[12], p0[13]), cvtpk(p0[14], p0[15])};
          v4u w2 = {cvtpk(p1[0], p1[1]), cvtpk(p1[2], p1[3]), cvtpk(p1[4], p1[5]), cvtpk(p1[6], p1[7])};
          v4u w3 = {cvtpk(p1[8], p1[9]), cvtpk(p1[10], p1[11]), cvtpk(p1[12], p1[13]), cvtpk(p1[14], p1[15])};
          pa[0] = __builtin_bit_cast(bf16x8, w0); pa[1] = __builtin_bit_cast(bf16x8, w1); pa[2] = __builtin_bit_cast(bf16x8, w2); pa[3] = __builtin_bit_cast(bf16x8, w3); }
        const LAS unsigned char* vb = lds + VOFF + tile * 8192 + ((lane >> 4) & 1) * 32 + (lane & 3) * 8 + (4 * hi + ((lane & 15) >> 2)) * 64;
#pragma unroll
        for (int d0 = 0; d0 < 2; ++d0)
#pragma unroll
            for (int ks = 0; ks < 4; ++ks) { const s16x4 lo = vtr(vb + d0 * 4096 + ks * 1024), hh = vtr(vb + d0 * 4096 + ks * 1024 + 512);
                const bf16x8 vf = {lo[0], lo[1], lo[2], lo[3], hh[0], hh[1], hh[2], hh[3]};
                o[d0] = ATT_MFMA(pa[ks], vf, o[d0]); }
    }
    l += __shfl_xor(l, 32);
    if (!OWN) {
        if (hi == 0) wsf[32 + r32] = l;
        asm volatile("s_waitcnt lgkmcnt(0)" ::: "memory");
        bf16* PO = WSP(bf16, WS_PO); float* ML = WSP(float, WS_ML);
#pragma unroll
        for (int r = 0; r < 16; ++r) { const int q = crow(r, hi); const unsigned e = QL[wave * 32 + q]; const float rl = 1.0f / wsf[32 + q];
            if (!(e & 0x80000000u)) { const int tq = (int)(e & 0x3fffu), j = (int)((e >> 16) & 3u); bf16* op = PO + ((size_t)j * M + tq) * 512 + h * 64 + r32;
                op[0] = (bf16)f2bf(o[0][r] * rl); op[32] = (bf16)f2bf(o[1][r] * rl); } }
        if (hi == 0 && !(ent & 0x80000000u)) { const int j = (int)((ent >> 16) & 3u); f32x2_t ml = {m, l}; *(f32x2_t*)(ML + (((size_t)j * M + t) * 8 + h) * 2) = ml; }
    } else {
        const int nsel = b < 3 ? b : 3;
        if (hi == 0) { const float* ML = WSP(float, WS_ML); float mj[3], lj[3]; float mx = m;
#pragma unroll
            for (int j = 0; j < 3; ++j) { if (j < nsel) { const f32x2_t ml = *(const f32x2_t*)(ML + (((size_t)j * M + t) * 8 + h) * 2); mj[j] = ml[0]; lj[j] = ml[1]; mx = fmaxf(mx, mj[j]); } else { mj[j] = -INFINITY; lj[j] = 0.f; } }
            const float ao = __builtin_amdgcn_exp2f(m - mx); float wj[3]; float den = ao * l;
#pragma unroll
            for (int j = 0; j < 3; ++j) { wj[j] = j < nsel ? lj[j] * __builtin_amdgcn_exp2f(mj[j] - mx) : 0.f; den += wj[j]; }
            const float inv = 1.0f / den; f32x4 cf = {ao * inv, wj[0] * inv, wj[1] * inv, wj[2] * inv};
            *(LAS f32x4*)(coef + r32 * 4) = cf; }
        asm volatile("s_waitcnt lgkmcnt(0)" ::: "memory");
        const bf16* PO = WSP(bf16, WS_PO); bf16* MIX = WSP(bf16, WS_MIX);
#pragma unroll
        for (int r = 0; r < 16; ++r) { const int q = crow(r, hi), tq = b * 256 + wave * 32 + q; const f32x4 cf = *(const LAS f32x4*)(coef + q * 4);
            float a0 = cf[0] * o[0][r], a1 = cf[0] * o[1][r];
#pragma unroll
            for (int j = 0; j < 3; ++j) if (j < nsel) { const bf16* pp = PO + ((size_t)j * M + tq) * 512 + h * 64 + r32; a0 += cf[1 + j] * bf2f(pp[0]); a1 += cf[1 + j] * bf2f(pp[32]); }
            bf16* op = MIX + (size_t)tq * 1024 + 512 + h * 64 + r32; op[0] = (bf16)f2bf(a0); op[32] = (bf16)f2bf(a1); }
    }
}
}

__device__ __forceinline__ void atta_phase(Frame& F) {
    LAS unsigned* SC = (LAS unsigned*)(F.lds + att::SCAN_OFF);
    const unsigned* cur = (const unsigned*)F.ctl + CW_CUR;
    { const unsigned cn = __hip_atomic_load(cur + F.tid, __ATOMIC_RELAXED, __HIP_MEMORY_SCOPE_AGENT); SC[F.tid] = (cn + 255u) >> 8; }
    wg_sync();
    for (int off = 1; off < 512; off <<= 1) { const unsigned v = SC[F.tid] + (F.tid >= off ? SC[F.tid - off] : 0u); wg_sync(); SC[F.tid] = v; wg_sync(); }
    const int total = (int)SC[511];
    for (int idx = F.bx; idx < total; idx += F.G) {
        int lo = 0, hi = 511;
        while (lo < hi) { const int mid = (lo + hi) >> 1; if ((int)SC[mid] > idx) hi = mid; else lo = mid + 1; }
        const int i = lo, h = i >> 6, b = i & 63, before = i ? (int)SC[i - 1] : 0, chunk = idx - before;
        const int cn = (int)__hip_atomic_load(cur + i, __ATOMIC_RELAXED, __HIP_MEMORY_SCOPE_AGENT);
        const int nrows = (cn - chunk * 256) < 256 ? (cn - chunk * 256) : 256;
        att::item<false>(F, h, b, WSP(unsigned, WS_LIST) + (size_t)h * LIST_PER_HEAD + list_off(b) + chunk * 256, nrows);
    }
}
__device__ __forceinline__ void attb_phase(Frame& F) {
    for (int idx = F.bx; idx < NHEAD * NBLK; idx += F.G) att::item<true>(F, idx & 7, idx >> 3, nullptr, 256);
}

__device__ __forceinline__ void final_phase(Frame& F) {
    const int gw = F.bx * NWAVES + F.wave, NGW = F.G * NWAVES; const float* SSQ = WSP(float, WS_SSQ);
    f32x4 g[4]; const float* fnorm = inptr(IN_FINAL_NORM);
#pragma unroll
    for (int j = 0; j < 4; ++j) g[j] = ((const f32x4*)fnorm)[F.lane + 64 * j];
    for (int m = gw; m < M; m += NGW) {
        const float s = ((SSQ[m] + SSQ[M + m]) + SSQ[2 * M + m]) + SSQ[3 * M + m];
        const float ri = 1.0f / sqrtf(s * (1.0f / 1024.0f) + EPS);
        f32x4* xr = (f32x4*)(F.out + (size_t)m * D) + F.lane;
#pragma unroll
        for (int j = 0; j < 4; ++j) { const f32x4 v = xr[64 * j]; xr[64 * j] = v * ri * g[j]; }
    }
}

struct Args { const float* in[22]; float* out; unsigned char* ws; int ph_lo, ph_hi; };
__global__ void __launch_bounds__(NWAVES * 64, 2) skel_fwd(Args args) {
    extern __shared__ __attribute__((aligned(16))) unsigned char lds[];
    Frame F;
    F.lds = (LAS unsigned char*)lds;
    F.MISC = (volatile LAS unsigned*)(F.lds + MISC_OFF);
    F.tid = threadIdx.x; F.lane = F.tid & 63; F.wave = __builtin_amdgcn_readfirstlane(F.tid >> 6);
    F.G = gridDim.x; F.bx = blockIdx.x;
    F.ws = args.ws; F.ctl = (gu32*)(args.ws + WS_CTL); F.out = args.out;
    for (int u = F.tid; u < (LDS_BYTES - LDSCTL_OFF) / 4; u += NWAVES * 64) ((LAS unsigned*)(F.lds + LDSCTL_OFF))[u] = 0u;
    __syncthreads();
    XcdBarrier bar; bar.bar = (unsigned*)(F.ctl + CW_BAR); bar.x = 0; bar.st = nullptr;
    if (N_LAUNCHES == 1) bar = xcd_barrier_post((unsigned*)(F.ctl + CW_BAR), F.MISC + 8);
    const int lo = args.ph_lo, hi = args.ph_hi;
#ifndef DBG_ONLY
#define DBG_ONLY -1
#endif
#define IN(k) (lo <= (k) && (k) < hi && (DBG_ONLY < 0 || (k) == DBG_ONLY))
#define SEAM(k) do { if (IN(k) && IN((k) + 1)) xcd_barrier(bar); asm volatile("" : "+v"(F.tid), "+v"(F.lane)); } while (0)
    const pg8::bf16_t* XB = (const pg8::bf16_t*)(args.ws + WS_XB); const float* SSQ = (const float*)(args.ws + WS_SSQ);

    if (IN(PH_P0)) { p0_phase(F); } SEAM(PH_P0);
    if (IN(PH_P1)) { p1_phase(F); } SEAM(PH_P1);
#pragma unroll 1
    for (int layer = 0; layer < 2; ++layer) {
#pragma unroll 1
        for (int sub = 0; sub < 3; ++sub) {
            if (sub != 1) {
                const int f = layer * 2 + (sub == 2 ? 1 : 0);
                const int ph_gu = layer == 0 ? (sub == 0 ? PH_L0_GU1 : PH_L0_GU2) : (sub == 0 ? PH_L1_GU1 : PH_L1_GU2);
                if (IN(ph_gu)) {
                    pg8::Gemm g{XB, (const pg8::bf16_t*)(args.ws + WS_WGU) + (size_t)f * NGU * 1024, M, NGU, D}; pg8::StaticOrder S; S.init(M, NGU, F.G, F.bx);
                    pg8::EpiGU E{(pg8::bf16_t*)(args.ws + WS_R1), (const float*)(args.ws + WS_BGU) + f * NGU, SSQ};
                    pg8::gemm_phase<pg8::EpiGU, pg8::StaticOrder, true, true>(F.lds + RING_OFF, g, S, E);
                }
                SEAM(ph_gu);
                if (IN(ph_gu + 1)) {
                    pg8::Gemm g{(const pg8::bf16_t*)(args.ws + WS_R1), (const pg8::bf16_t*)(args.ws + WS_WDN) + (size_t)f * 1024 * DFF, M, D, DFF}; pg8::StaticOrder S; S.init(M, D, F.G, F.bx);
                    pg8::EpiRes E{(layer == 0 && sub == 0) ? inptr(IN_X) : F.out, F.out, (pg8::bf16_t*)(args.ws + WS_XB), nullptr, (float*)(args.ws + WS_SSQ)};
                    pg8::gemm_phase<pg8::EpiRes, pg8::StaticOrder, false, true>(F.lds + RING_OFF, g, S, E);
                }
                SEAM(ph_gu + 1);
            } else if (layer == 0) {
                if (IN(PH_L0_CIN)) {
                    pg8::Gemm g{XB, (const pg8::bf16_t*)(args.ws + WS_WCIN), M, NCIN, D}; pg8::StaticOrder S; S.init(M, NCIN, F.G, F.bx);
                    pg8::EpiCin E{(pg8::bf16_t*)(args.ws + WS_R1), (const float*)(args.ws + WS_BCIN), SSQ};
                    pg8::gemm_phase<pg8::EpiCin, pg8::StaticOrder, true, true>(F.lds + RING_OFF, g, S, E);
                }
                SEAM(PH_L0_CIN);
                if (IN(PH_L0_CONV)) conv_phase(F);
                SEAM(PH_L0_CONV);
                if (IN(PH_L0_COUT)) {
                    pg8::Gemm g{(const pg8::bf16_t*)(args.ws + WS_MIX), (const pg8::bf16_t*)(args.ws + WS_WCOUT), M, D, D}; pg8::StaticOrder S; S.init(M, D, F.G, F.bx);
                    pg8::EpiRes E{F.out, F.out, (pg8::bf16_t*)(args.ws + WS_XB), nullptr, (float*)(args.ws + WS_SSQ)};
                    pg8::gemm_phase<pg8::EpiRes, pg8::StaticOrder, false, true>(F.lds + RING_OFF, g, S, E);
                }
                SEAM(PH_L0_COUT);
            } else {
                if (IN(PH_L1_PIN)) {
                    pg8::Gemm g{XB, (const pg8::bf16_t*)(args.ws + WS_WPIN), M, NPIN, D}; pg8::StaticOrder S; S.init(M, NPIN, F.G, F.bx);
                    pg8::EpiPin E{(pg8::bf16_t*)(args.ws + WS_Q), (const float*)(args.ws + WS_BPIN), SSQ};
                    pg8::gemm_phase<pg8::EpiPin, pg8::StaticOrder, true, true>(F.lds + RING_OFF, g, S, E);
                }
                SEAM(PH_L1_PIN);
                if (IN(PH_L1_PRE)) pre_phase(F);
                SEAM(PH_L1_PRE);
                if (IN(PH_L1_SEL)) sel_phase(F);
                SEAM(PH_L1_SEL);
                if (IN(PH_L1_ATTA)) atta_phase(F);
                SEAM(PH_L1_ATTA);
                if (IN(PH_L1_ATTB)) attb_phase(F);
                SEAM(PH_L1_ATTB);
                if (IN(PH_L1_POUT)) {
                    pg8::Gemm g{(const pg8::bf16_t*)(args.ws + WS_MIX), (const pg8::bf16_t*)(args.ws + WS_WPOUT), M, D, D}; pg8::StaticOrder S; S.init(M, D, F.G, F.bx);
                    pg8::EpiRes E{F.out, F.out, (pg8::bf16_t*)(args.ws + WS_XB), (const float*)(args.ws + WS_BPOUT), (float*)(args.ws + WS_SSQ)};
                    pg8::gemm_phase<pg8::EpiRes, pg8::StaticOrder, false, true>(F.lds + RING_OFF, g, S, E);
                }
                SEAM(PH_L1_POUT);
            }
        }
    }
    if (IN(PH_FINAL)) final_phase(F);
#undef IN
#undef SEAM
}

extern "C" void kernel_launch(void* const* d_in, const int* in_sizes, int n_in, void* d_out, int out_size, void* d_ws, size_t ws_size, hipStream_t stream) {
    static int grid = 0;
    if (grid == 0) {
        if (n_in != 22 || in_sizes[0] != M * D || out_size != M * D || ws_size < WS_END) { fprintf(stderr, "kernel_launch: unexpected shapes/workspace (n_in %d, ws %zu < %zu); nothing launched\n", n_in, ws_size, (size_t)WS_END); grid = -1; return; }
        int dev = 0, cus = 0;
        if (hipGetDevice(&dev) != hipSuccess || hipDeviceGetAttribute(&cus, hipDeviceAttributeMultiprocessorCount, dev) != hipSuccess) { grid = -1; return; }
        if (hipFuncSetAttribute((const void*)skel_fwd, hipFuncAttributeMaxDynamicSharedMemorySize, LDS_BYTES) != hipSuccess) { fprintf(stderr, "kernel_launch: hipFuncSetAttribute failed\n"); grid = -1; return; }
        (void)hipGetLastError();
        grid = cus;
        if (grid != 256) fprintf(stderr, "kernel_launch: %d CUs; this kernel is laid out for 256\n", grid);
    }
    if (grid < 0) return;
    if (hipMemsetAsync((char*)d_ws + WS_CTL, 0, CTL_ZERO_BYTES, stream) != hipSuccess) return;
    Args a{};
    for (int i = 0; i < 22; ++i) a.in[i] = (const float*)d_in[i];
    a.out = (float*)d_out; a.ws = (unsigned char*)d_ws;
    for (int li = 0; li < N_LAUNCHES; ++li) {
        a.ph_lo = (N_LAUNCHES == 1) ? 0 : li; a.ph_hi = (N_LAUNCHES == 1) ? (int)NPHASE : li + 1;
        hipLaunchKernelGGL(skel_fwd, dim3(grid), dim3(NWAVES * 64), LDS_BYTES, stream, a);
        if (hipPeekAtLastError() != hipSuccess) { fprintf(stderr, "kernel_launch: launch %d failed\n", li); break; }
    }
}
```

```cpp
#include <hip/hip_runtime.h>
#include <hip/hip_bf16.h>
#include <cstdio>
#include <cstdint>
#include <cmath>

#ifndef MK_N_LAUNCHES
#define MK_N_LAUNCHES 1
#endif

constexpr int M = 16384, D = 1024, DFF = 2816, NGU = 2 * DFF, NCIN = 2560, NPIN = 2048;
constexpr int NHEAD = 8, HD = 64, MBLK = 256, NBLK = M / MBLK;
constexpr float EPS = 1e-6f;
constexpr float LOG2E = 1.4426950408889634f;
constexpr float QSCALE = 0.125f * LOG2E;

namespace pg8 {
#define PG8_LAS __attribute__((address_space(3)))
typedef unsigned short bf16_t;
typedef short bf16x8 __attribute__((ext_vector_type(8)));
typedef float f32x4 __attribute__((ext_vector_type(4)));
typedef unsigned u32x4 __attribute__((ext_vector_type(4)));
constexpr int BM = 256, BK = 64, HALF = 128, HTB = HALF * BK * 2  , STAGE_BYTES = 8 * HTB, NXCD = 8, WGM = 8;

__host__ __device__ __forceinline__ int lds_byte(int r, int c) { const int st = (r >> 4) * 2 + (c >> 5), rr = r & 15, cc = c & 31, ob = rr * 64 + cc * 2; return st * 1024 + (ob ^ (((ob >> 9) & 1) << 5)); }
__host__ __device__ __forceinline__ void stage_rc(int b, int& R, int& C) { const int st = b / 1024, sb = b % 1024, swz = sb ^ (((sb >> 9) & 1) << 5); R = (st >> 1) * 16 + swz / 64; C = (st & 1) * 32 + (swz % 64) / 2; }
__host__ __device__ __forceinline__ int perm32(int rho) { const int n = rho >> 4, i = rho & 15; return 8 * (i >> 2) + 4 * n + (i & 3); }

struct Unit { int pm, pn; };
struct Gemm { const bf16_t* A; const bf16_t* Bt; int M, N, K; };

struct StaticOrder {
    int nM, nN, nwg, G, c;
    __host__ __device__ void init(int M, int N, int G_, int c_) { nM = M / BM; nN = N / BM; nwg = nM * nN; G = G_; c = c_; }
    __host__ __device__ bool next(int i, Unit& u) const {
        const long L = (long)i * G + c; if (L >= nwg) return false;
        int wgid = (int)L; { const int q = nwg / NXCD, r = nwg % NXCD, xcd = wgid % NXCD, off = wgid / NXCD; wgid = (xcd < r ? xcd * (q + 1) : r * (q + 1) + (xcd - r) * q) + off; }
        const int nig = WGM * nN, gid = wgid / nig, fm = gid * WGM, gsz = (nM - fm) < WGM ? (nM - fm) : WGM;
        u.pm = fm + ((wgid % nig) % gsz); u.pn = (wgid % nig) / gsz; return true;
    }
    __device__ __forceinline__ void a_ready(const Unit&) const {}
    __device__ __forceinline__ void done(const Unit&) const {}
};

__device__ __forceinline__ unsigned cvt_pk_bf16(float lo, float hi) { unsigned r; asm volatile("v_cvt_pk_bf16_f32 %0, %1, %2" : "=v"(r) : "v"(lo), "v"(hi)); return r; }

typedef unsigned u32x2 __attribute__((ext_vector_type(2)));
__device__ __forceinline__ void load_rinv(const float* ssq, int row0, float (&rinv)[2][4]) {
#pragma unroll
    for (int ai = 0; ai < 2; ++ai)
#pragma unroll
        for (int m = 0; m < 4; ++m) { const int r = row0 + ai * HALF + m * 16;
            const float s = ((ssq[r] + ssq[M + r]) + ssq[2 * M + r]) + ssq[3 * M + r];
            rinv[ai][m] = 1.0f / sqrtf(s * (1.0f / 1024.0f) + EPS); }
}
__device__ __forceinline__ float sigm(float z) { return __builtin_amdgcn_rcpf(1.0f + __builtin_amdgcn_exp2f(-LOG2E * z)); }
__device__ __forceinline__ u32x4 pack8(const f32x4 a, const f32x4 b) { u32x4 w; w.x = cvt_pk_bf16(a[0], a[1]); w.y = cvt_pk_bf16(a[2], a[3]); w.z = cvt_pk_bf16(b[0], b[1]); w.w = cvt_pk_bf16(b[2], b[3]); return w; }

struct EpiGU {
    static constexpr bool PERM = true, AFTER_DRAIN = false;
    bf16_t* O; const float* bias; const float* ssq;
    __device__ __forceinline__ void operator()(const f32x4 (&acc)[2][2][4][2], const Unit& u, int wr, int wc, int fr, int fq) const {
        asm volatile("" : "+v"(fr), "+v"(fq));
        const int row0 = u.pm * BM + wr * 64 + fr, bcol0 = u.pn * BM + wc * 32 + 8 * fq, ocol0 = u.pn * HALF + wc * 32 + 8 * fq;
        f32x4 bv[2][2];
#pragma unroll
        for (int bj = 0; bj < 2; ++bj)
#pragma unroll
            for (int n = 0; n < 2; ++n) bv[bj][n] = *(const f32x4*)(bias + bcol0 + bj * HALF + 4 * n);
        float rinv[2][4]; load_rinv(ssq, row0, rinv);
#pragma unroll
        for (int ai = 0; ai < 2; ++ai)
#pragma unroll
            for (int m = 0; m < 4; ++m) { const float ri = rinv[ai][m]; bf16_t* rowp = O + (size_t)(row0 + ai * HALF + m * 16) * DFF + ocol0;
                f32x4 hv[2];
#pragma unroll
                for (int n = 0; n < 2; ++n) { const f32x4 g = acc[ai][0][m][n] * ri + bv[0][n], up = acc[ai][1][m][n] * ri + bv[1][n];
#pragma unroll
                    for (int e = 0; e < 4; ++e) hv[n][e] = g[e] * up[e] * sigm(g[e]); }
                *(u32x4*)rowp = pack8(hv[0], hv[1]);
                if (m & 1) asm volatile("" ::: "memory"); }
    }
};
struct EpiCin {
    static constexpr bool PERM = true, AFTER_DRAIN = false;
    bf16_t* O; const float* bias; const float* ssq;
    template <int KIND> __device__ __forceinline__ void run(const f32x4 (&acc)[2][2][4][2], const f32x4 (&bv)[2][2], const float (&rinv)[2][4], bf16_t* base) const {
#pragma unroll
        for (int ai = 0; ai < 2; ++ai)
#pragma unroll
            for (int m = 0; m < 4; ++m) { const float ri = rinv[ai][m]; bf16_t* rowp = base + (size_t)(ai * HALF + m * 16) * 1536;
                f32x4 z0[2], z1[2];
#pragma unroll
                for (int n = 0; n < 2; ++n) { z0[n] = acc[ai][0][m][n] * ri + bv[0][n]; z1[n] = acc[ai][1][m][n] * ri + bv[1][n]; }
                if (KIND == 2) { *(u32x4*)rowp = pack8(z0[0], z0[1]); *(u32x4*)(rowp + HALF) = pack8(z1[0], z1[1]); }
                else { f32x4 o[2];
#pragma unroll
                    for (int n = 0; n < 2; ++n)
#pragma unroll
                        for (int e = 0; e < 4; ++e) o[n][e] = KIND == 0 ? z0[n][e] * sigm(z1[n][e]) : z0[n][e] * z1[n][e];
                    *(u32x4*)rowp = pack8(o[0], o[1]); }
                asm volatile("" ::: "memory"); }
    }
    __device__ __forceinline__ void operator()(const f32x4 (&acc)[2][2][4][2], const Unit& u, int wr, int wc, int fr, int fq) const {
        asm volatile("" : "+v"(fr), "+v"(fq));
        const int row0 = u.pm * BM + wr * 64 + fr, bcol0 = u.pn * BM + wc * 32 + 8 * fq;
        f32x4 bv[2][2];
#pragma unroll
        for (int bj = 0; bj < 2; ++bj)
#pragma unroll
            for (int n = 0; n < 2; ++n) bv[bj][n] = *(const f32x4*)(bias + bcol0 + bj * HALF + 4 * n);
        float rinv[2][4]; load_rinv(ssq, row0, rinv);
        const int ocol0 = (u.pn >= 8 ? 1024 + 256 * (u.pn - 8) : 128 * u.pn) + wc * 32 + 8 * fq;
        bf16_t* base = O + (size_t)row0 * 1536 + ocol0;
        if (u.pn < 4) run<0>(acc, bv, rinv, base); else if (u.pn < 8) run<1>(acc, bv, rinv, base); else run<2>(acc, bv, rinv, base);
    }
};
struct EpiPin {
    static constexpr bool PERM = true, AFTER_DRAIN = false;
    bf16_t* O; const float* bias; const float* ssq;
    __device__ __forceinline__ void operator()(const f32x4 (&acc)[2][2][4][2], const Unit& u, int wr, int wc, int fr, int fq) const {
        asm volatile("" : "+v"(fr), "+v"(fq));
        const int row0 = u.pm * BM + wr * 64 + fr, bcol0 = u.pn * BM + wc * 32 + 8 * fq;
        f32x4 bv[2][2];
#pragma unroll
        for (int bj = 0; bj < 2; ++bj)
#pragma unroll
            for (int n = 0; n < 2; ++n) bv[bj][n] = *(const f32x4*)(bias + bcol0 + bj * HALF + 4 * n);
        float rinv[2][4]; load_rinv(ssq, row0, rinv);
        const int t = u.pn >> 1; const int slot = t == 0 ? 3 : t - 1;
        const float sc = t == 1 ? QSCALE : 1.0f;
        bf16_t* base = O + (size_t)slot * ((size_t)M * 512) + (size_t)row0 * 512 + 256 * (u.pn & 1) + wc * 32 + 8 * fq;
#pragma unroll
        for (int ai = 0; ai < 2; ++ai)
#pragma unroll
            for (int m = 0; m < 4; ++m) { const float ri = rinv[ai][m] * sc; bf16_t* rowp = base + (size_t)(ai * HALF + m * 16) * 512;
#pragma unroll
                for (int bj = 0; bj < 2; ++bj) { const f32x4 z0 = acc[ai][bj][m][0] * ri + bv[bj][0] * sc, z1 = acc[ai][bj][m][1] * ri + bv[bj][1] * sc;
                    *(u32x4*)(rowp + bj * HALF) = pack8(z0, z1); }
                asm volatile("" ::: "memory"); }
    }
};
struct EpiRes {
    static constexpr bool PERM = false, AFTER_DRAIN = true;
    const float* xin; float* xout; bf16_t* xb; const float* bias; float* ssq;
    __device__ __forceinline__ void fused(f32x4 (&acc)[2][2][4][2], const Unit& u, int wr, int wc, int fr, int fq, PG8_LAS unsigned char* lds, int wid, int lane) const {
        PG8_LAS float* P = (PG8_LAS float*)lds;
        asm volatile("" : "+v"(fr), "+v"(fq));
        const int col0 = u.pn * BM + wc * 32 + 4 * fq;
        f32x4 bv[2][2];
#pragma unroll
        for (int bj = 0; bj < 2; ++bj)
#pragma unroll
            for (int n = 0; n < 2; ++n) bv[bj][n] = bias ? *(const f32x4*)(bias + col0 + bj * HALF + n * 16) : (f32x4){0.f, 0.f, 0.f, 0.f};
#pragma unroll
        for (int ai = 0; ai < 2; ++ai)
#pragma unroll
            for (int m = 0; m < 4; ++m) { const int rt = ai * HALF + wr * 64 + m * 16 + fr; const size_t off = (size_t)(u.pm * BM + rt) * D + col0; float ss = 0.f;
#pragma unroll
                for (int bj = 0; bj < 2; ++bj)
#pragma unroll
                    for (int n = 0; n < 2; ++n) { const int c = bj * HALF + n * 16; const f32x4 v = *(const f32x4*)(xin + off + c) + acc[ai][bj][m][n] + bv[bj][n];
                        *(f32x4*)(xout + off + c) = v; ss += (v[0] * v[0] + v[1] * v[1]) + (v[2] * v[2] + v[3] * v[3]);
                        u32x2 w; w.x = cvt_pk_bf16(v[0], v[1]); w.y = cvt_pk_bf16(v[2], v[3]); *(u32x2*)(xb + off + c) = w; }
                ss += __shfl_xor(ss, 16); ss += __shfl_xor(ss, 32);
                if (fq == 0) P[rt * 4 + wc] = ss;
                if (m & 1) asm volatile("" ::: "memory"); }
        asm volatile("s_waitcnt lgkmcnt(0)" ::: "memory"); __builtin_amdgcn_s_barrier(); asm volatile("" ::: "memory");
        const int tid = wid * 64 + lane;
        if (tid < 256) { const float s = ((P[tid * 4 + 0] + P[tid * 4 + 1]) + P[tid * 4 + 2]) + P[tid * 4 + 3]; ssq[(size_t)u.pn * M + u.pm * BM + tid] = s; }
        asm volatile("s_waitcnt lgkmcnt(0)" ::: "memory"); __builtin_amdgcn_s_barrier(); asm volatile("" ::: "memory");
    }
};

template <class Epi, class Sched, bool ALIGN_EPI = false, bool SP2 = false>
__device__ __forceinline__ void gemm_phase(PG8_LAS unsigned char* lds, const Gemm g, const Sched& S, const Epi& E) {
    int tid = threadIdx.x; asm volatile("" : "+v"(tid));
    const int wid = __builtin_amdgcn_readfirstlane(tid >> 6), lane = tid & 63, wr = wid >> 2, wc = wid & 3, fr = lane & 15, fq = lane >> 4;
    const int K = g.K, nt = K / BK;
    unsigned voffA[2], voffB[2];
#pragma unroll
    for (int i = 0; i < 2; ++i) { int R, C; stage_rc(tid * 16 + i * 8192, R, C); const int Rb = Epi::PERM ? ((R & ~31) + perm32(R & 31)) : R;
        voffA[i] = (unsigned)(R * K + C) * 2u; voffB[i] = (unsigned)(Rb * K + C) * 2u; }
    const size_t kstep = (size_t)(BK * 2);
    const size_t hstep = (size_t)HALF * K * 2;
    const size_t tstep = 2 * hstep;
    const unsigned ldsw = (unsigned)wid * 1024u;
    const int aoff = lds_byte(wr * 64 + fr, fq * 8), boff = lds_byte(wc * 32 + fr, fq * 8);
#define PG8_SA(b, h) (((b) * 2 + (h)) * HTB)
#define PG8_SB(b, h) ((4 + (b) * 2 + (h)) * HTB)
#define PG8_STAGE(bufoff, gbase, voff) do { _Pragma("unroll") for (int _i = 0; _i < 2; ++_i) \
        __builtin_amdgcn_global_load_lds((const unsigned*)((const char*)(gbase) + (voff)[_i]), (PG8_LAS unsigned*)(lds + (bufoff) + ldsw + _i * 8192), 16, 0, 0); } while (0)
#define PG8_LDA(dst, b, h) do { _Pragma("unroll") for (int m = 0; m < 4; ++m) _Pragma("unroll") for (int k = 0; k < 2; ++k) dst[m][k] = *(const PG8_LAS bf16x8*)(lds + PG8_SA(b, h) + aoff + m * 2048 + k * 1024); } while (0)
#define PG8_LDB(dst, b, h) do { _Pragma("unroll") for (int n = 0; n < 2; ++n) _Pragma("unroll") for (int k = 0; k < 2; ++k) dst[n][k] = *(const PG8_LAS bf16x8*)(lds + PG8_SB(b, h) + boff + n * 2048 + k * 1024); } while (0)
#define PG8_MMA(ai, bj, At, Bt) do { __builtin_amdgcn_s_setprio(1); _Pragma("unroll") for (int m = 0; m < 4; ++m) _Pragma("unroll") for (int n = 0; n < 2; ++n) _Pragma("unroll") for (int k = 0; k < 2; ++k) \
        acc[ai][bj][m][n] = __builtin_amdgcn_mfma_f32_16x16x32_bf16(Bt[n][k], At[m][k], acc[ai][bj][m][n], 0, 0, 0); __builtin_amdgcn_s_setprio(0); } while (0)
#define PG8_WAIT_V(n) asm volatile("s_waitcnt vmcnt(" #n ")" ::: "memory")
#define PG8_WAIT_L(n) asm volatile("s_waitcnt lgkmcnt(" #n ")" ::: "memory")
#define PG8_BAR __builtin_amdgcn_s_barrier()
#define PG8_SCHED __builtin_amdgcn_sched_barrier(0)
    Unit cur, nxt; int ui = 0;
    if (!S.next(0, cur)) return;
    f32x4 acc[2][2][4][2];
#pragma unroll
    for (int a = 0; a < 2; ++a)
#pragma unroll
        for (int b = 0; b < 2; ++b)
#pragma unroll
            for (int m = 0; m < 4; ++m)
#pragma unroll
                for (int n = 0; n < 2; ++n) acc[a][b][m][n] = (f32x4){0.f, 0.f, 0.f, 0.f};
    bf16x8 At[4][2], B0[2][2], B1[2][2];
    const char* cA = (const char*)g.A + (size_t)cur.pm * tstep; const char* cB = (const char*)g.Bt + (size_t)cur.pn * tstep;
    S.a_ready(cur);
    if constexpr (SP2) {
        PG8_STAGE(PG8_SB(0, 0), cB, voffB); PG8_STAGE(PG8_SB(0, 1), cB + hstep, voffB); PG8_STAGE(PG8_SA(0, 0), cA, voffA); PG8_STAGE(PG8_SA(0, 1), cA + hstep, voffA);
        if (wr == 1) PG8_BAR;
        PG8_WAIT_V(2); PG8_BAR;
        PG8_STAGE(PG8_SB(1, 0), cB + kstep, voffB); PG8_STAGE(PG8_SA(1, 0), cA + kstep, voffA); PG8_STAGE(PG8_SB(1, 1), cB + hstep + kstep, voffB);
        PG8_WAIT_V(6); PG8_BAR;
    } else {
        PG8_STAGE(PG8_SB(0, 0), cB, voffB); PG8_STAGE(PG8_SA(0, 0), cA, voffA); PG8_STAGE(PG8_SB(0, 1), cB + hstep, voffB); PG8_STAGE(PG8_SA(0, 1), cA + hstep, voffA);
        if (wr == 1) PG8_BAR;
        PG8_WAIT_V(4); PG8_BAR;
        PG8_STAGE(PG8_SB(1, 0), cB + kstep, voffB); PG8_STAGE(PG8_SA(1, 0), cA + kstep, voffA); PG8_STAGE(PG8_SB(1, 1), cB + hstep + kstep, voffB);
        PG8_WAIT_V(6); PG8_BAR;
    }
    for (;;) {
        const bool has_next = S.next(ui + 1, nxt);
        const char* nA = has_next ? (const char*)g.A + (size_t)nxt.pm * tstep : cA; const char* nB = has_next ? (const char*)g.Bt + (size_t)nxt.pn * tstep : cB;
        for (int t = 0; t < nt; t += 2) {
            const bool last = (t == nt - 2);
            const char* a1 = cA + (size_t)(t + 1) * kstep;
            const char* a2 = last ? nA : cA + (size_t)(t + 2) * kstep; const char* b2 = last ? nB : cB + (size_t)(t + 2) * kstep;
            const char* a3 = a2 + kstep; const char* b3 = b2 + kstep;
            if (last && has_next) S.a_ready(nxt);
            if constexpr (SP2) {
            PG8_LDB(B0, 0, 0); PG8_LDB(B1, 0, 1); PG8_SCHED; PG8_LDA(At, 0, 0); PG8_STAGE(PG8_SA(1, 1), a1 + hstep, voffA);
            PG8_WAIT_V(8); PG8_WAIT_L(0); PG8_BAR; PG8_MMA(0, 0, At, B0); PG8_MMA(0, 1, At, B1); PG8_BAR; PG8_SCHED;
            PG8_LDA(At, 0, 1); PG8_STAGE(PG8_SB(0, 0), b2, voffB); PG8_STAGE(PG8_SB(0, 1), b2 + hstep, voffB); PG8_STAGE(PG8_SA(0, 0), a2, voffA);
            PG8_WAIT_V(8); PG8_WAIT_L(0); PG8_BAR; PG8_MMA(1, 0, At, B0); PG8_MMA(1, 1, At, B1); PG8_BAR; PG8_SCHED;
            PG8_LDB(B0, 1, 0); PG8_LDB(B1, 1, 1); PG8_SCHED; PG8_LDA(At, 1, 0); PG8_STAGE(PG8_SA(0, 1), a2 + hstep, voffA);
            PG8_WAIT_V(8); PG8_WAIT_L(0); PG8_BAR; PG8_MMA(0, 0, At, B0); PG8_MMA(0, 1, At, B1); PG8_BAR; PG8_SCHED;
            PG8_LDA(At, 1, 1); PG8_STAGE(PG8_SB(1, 0), b3, voffB); PG8_STAGE(PG8_SB(1, 1), b3 + hstep, voffB); PG8_STAGE(PG8_SA(1, 0), a3, voffA);
            PG8_WAIT_V(8); PG8_WAIT_L(0); PG8_BAR; PG8_MMA(1, 0, At, B0); PG8_MMA(1, 1, At, B1); PG8_BAR; PG8_SCHED;
            } else {
            PG8_LDB(B0, 0, 0); PG8_SCHED; PG8_LDA(At, 0, 0); PG8_STAGE(PG8_SA(1, 1), a1 + hstep, voffA);
            PG8_WAIT_L(8); PG8_BAR; PG8_WAIT_L(0); PG8_MMA(0, 0, At, B0); PG8_BAR; PG8_SCHED;
            PG8_LDB(B1, 0, 1); PG8_STAGE(PG8_SB(0, 0), b2, voffB);
            PG8_BAR; PG8_WAIT_L(0); PG8_MMA(0, 1, At, B1); PG8_BAR;
            PG8_LDA(At, 0, 1); PG8_STAGE(PG8_SA(0, 0), a2, voffA);
            PG8_BAR; PG8_WAIT_L(0); PG8_MMA(1, 0, At, B0); PG8_BAR; PG8_SCHED;
            PG8_STAGE(PG8_SB(0, 1), b2 + hstep, voffB);
            PG8_WAIT_V(6); PG8_BAR; PG8_MMA(1, 1, At, B1); PG8_BAR;
            PG8_LDB(B0, 1, 0); PG8_SCHED; PG8_LDA(At, 1, 0); PG8_STAGE(PG8_SA(0, 1), a2 + hstep, voffA);
            PG8_WAIT_L(8); PG8_BAR; PG8_WAIT_L(0); PG8_MMA(0, 0, At, B0); PG8_BAR; PG8_SCHED;
            PG8_LDB(B1, 1, 1); PG8_STAGE(PG8_SB(1, 0), b3, voffB);
            PG8_BAR; PG8_WAIT_L(0); PG8_MMA(0, 1, At, B1); PG8_BAR;
            PG8_LDA(At, 1, 1); PG8_STAGE(PG8_SA(1, 0), a3, voffA);
            PG8_BAR; PG8_WAIT_L(0); PG8_MMA(1, 0, At, B0); PG8_BAR; PG8_SCHED;
            PG8_STAGE(PG8_SB(1, 1), b3 + hstep, voffB);
            PG8_WAIT_V(6); PG8_BAR; PG8_MMA(1, 1, At, B1); PG8_BAR;
            }
        }
        if constexpr (ALIGN_EPI) { if (wr == 0) PG8_BAR; }
        if constexpr (!Epi::AFTER_DRAIN) { E(acc, cur, wr, wc, fr, fq); S.done(cur); }
        if (!has_next) break;
#pragma unroll
        for (int a = 0; a < 2; ++a)
#pragma unroll
            for (int b = 0; b < 2; ++b)
#pragma unroll
                for (int m = 0; m < 4; ++m)
#pragma unroll
                    for (int n = 0; n < 2; ++n) acc[a][b][m][n] = (f32x4){0.f, 0.f, 0.f, 0.f};
        cur = nxt; cA = nA; cB = nB; ++ui;
        if constexpr (ALIGN_EPI) { if (wr == 1) PG8_BAR; }
    }
    PG8_WAIT_V(0);
    if constexpr (!ALIGN_EPI) { if (wr == 0) PG8_BAR; }
    PG8_BAR;
    if constexpr (Epi::AFTER_DRAIN) { E.fused(acc, cur, wr, wc, fr, fq, lds, wid, lane); S.done(cur); }
#undef PG8_SA
#undef PG8_SB
#undef PG8_STAGE
#undef PG8_LDA
#undef PG8_LDB
#undef PG8_MMA
#undef PG8_WAIT_V
#undef PG8_WAIT_L
#undef PG8_BAR
#undef PG8_SCHED
}
}
#define GAS __attribute__((address_space(1)))
#define LAS __attribute__((address_space(3)))
typedef unsigned short bf16;
typedef unsigned v4u __attribute__((ext_vector_type(4)));
typedef float f32x4 __attribute__((ext_vector_type(4)));
typedef short bf16x8 __attribute__((ext_vector_type(8)));
typedef GAS unsigned gu32;
typedef GAS unsigned long long gu64;
#define RLX_AGENT __ATOMIC_RELAXED, __HIP_MEMORY_SCOPE_AGENT
#define LDS_WAIT() asm volatile("s_waitcnt lgkmcnt(0)" ::: "memory")
#define VM_WAIT() asm volatile("s_waitcnt vmcnt(0)" ::: "memory")
__device__ __forceinline__ unsigned long long rt() { return __builtin_amdgcn_s_memrealtime(); }
__device__ __forceinline__ unsigned f2bf(float f) { unsigned u = __builtin_bit_cast(unsigned, f); return (u + 0x7fffu + ((u >> 16) & 1u)) >> 16; }
__device__ __forceinline__ unsigned pk2(float lo, float hi) { return f2bf(lo) | (f2bf(hi) << 16); }

#define XB_TMO      128
#define XB_XCNT(j)  (256  + 64 * (j))
#define XB_XSUB(j)  (1280 + 64 * (j))
#define XB_XGEN(j)  (2304 + 64 * (j))
#define XB_TOP      3328
#define XB_TOPGEN   3392
#define XCD_BAR_WORDS 3456
#define XB_SPIN_CAP (1u << 18)

__device__ __forceinline__ unsigned xb_ld(unsigned* p)              { return __hip_atomic_load(p, __ATOMIC_RELAXED, __HIP_MEMORY_SCOPE_AGENT); }
__device__ __forceinline__ unsigned xb_add(unsigned* p, unsigned v) { return __hip_atomic_fetch_add(p, v, __ATOMIC_RELAXED, __HIP_MEMORY_SCOPE_AGENT); }
__device__ __forceinline__ unsigned xb_xcc_id() { return (unsigned)__builtin_amdgcn_s_getreg((3 << 11) | 20) & 0xFu; }
#define XB_SPIN(cond, bar) do { unsigned _sp = 0; while (cond) { __builtin_amdgcn_s_sleep(1); \
    if ((++_sp & 255u) == 0u) { if (xb_ld(&(bar)[XB_TMO])) break; if (_sp > XB_SPIN_CAP) { atomicAdd(&(bar)[XB_TMO], 1u); break; } } } } while (0)

struct XcdBarrier {
    unsigned* bar; unsigned x;
    volatile LAS unsigned* st;
};

__device__ __forceinline__ XcdBarrier xcd_barrier_post(unsigned* bar, volatile LAS unsigned* st) {
    XcdBarrier b; b.bar = bar; b.x = xb_xcc_id(); b.st = st;
    if (threadIdx.x == 0) (void)xb_add(&bar[XB_XCNT(b.x)], 1u);
    return b;
}
__device__ __forceinline__ void xcd_barrier_complete(unsigned* bar, unsigned x, unsigned& nloc, unsigned& nx) {
    const unsigned G = gridDim.x * gridDim.y * gridDim.z;
    unsigned sum, cnt, mine, sp = 0u;
    for (;;) {
        sum = 0u; cnt = 0u; mine = 0u;
#pragma unroll
        for (unsigned j = 0; j < 16; ++j) { const unsigned c = xb_ld(&bar[XB_XCNT(j)]); sum += c; cnt += (c > 0u) ? 1u : 0u; mine = (j == x) ? c : mine; }
        if (sum == G) break;
        __builtin_amdgcn_s_sleep(1);
        if ((++sp & 255u) == 0u) { if (xb_ld(&bar[XB_TMO])) break; if (sp > XB_SPIN_CAP) { atomicAdd(&bar[XB_TMO], 1u); break; } }
    }
    nloc = mine > 0u ? mine : 1u; nx = cnt > 0u ? cnt : 1u;
}

__device__ __forceinline__ void xcd_barrier(const XcdBarrier& b) {
    asm volatile("s_waitcnt vmcnt(0)" ::: "memory");
    __syncthreads();
    if (threadIdx.x == 0) {
        unsigned* bar = b.bar;
        __builtin_amdgcn_s_waitcnt(0);
        unsigned nloc = b.st[0], nx = b.st[1];
        if (nloc == 0u) { xcd_barrier_complete(bar, b.x, nloc, nx); b.st[0] = nloc; b.st[1] = nx; }
        const unsigned old = xb_add(&bar[XB_XSUB(b.x)], 1u);
        const unsigned gen = old / nloc;
        if (old + 1u == (gen + 1u) * nloc) {
            __builtin_amdgcn_fence(__ATOMIC_RELEASE, "agent");
            asm volatile("s_waitcnt vmcnt(0)" ::: "memory");
            const unsigned og = xb_add(&bar[XB_TOP], 1u);
            const unsigned tg = og / nx;
            if (og + 1u == (tg + 1u) * nx) xb_add(&bar[XB_TOPGEN], 1u);
            else XB_SPIN(xb_ld(&bar[XB_TOPGEN]) == tg, bar);
            __builtin_amdgcn_fence(__ATOMIC_ACQUIRE, "agent");
            xb_add(&bar[XB_XGEN(b.x)], 1u);
            asm volatile("s_waitcnt vmcnt(0)" ::: "memory");
        } else {
            XB_SPIN(xb_ld(&bar[XB_XGEN(b.x)]) == gen, bar);
            __builtin_amdgcn_fence(__ATOMIC_ACQUIRE, "agent");
            asm volatile("s_waitcnt vmcnt(0)" ::: "memory");
        }
    }
    __syncthreads();
}

constexpr size_t MiB = 1u << 20;
constexpr size_t WS_CTL = 0, CTL_ZERO_BYTES = 1 * MiB;
constexpr size_t WS_MOD = 1 * MiB;
constexpr size_t WS_BGU = WS_MOD + 128 * 1024;
constexpr size_t WS_BCIN = WS_MOD + 256 * 1024;
constexpr size_t WS_BPIN = WS_MOD + 272 * 1024;
constexpr size_t WS_BEFF = WS_MOD + 288 * 1024;
constexpr size_t WS_BPOUT = WS_MOD + 296 * 1024;
constexpr size_t WS_KMEAN = WS_MOD + 512 * 1024;
constexpr size_t WS_SSQ = 2 * MiB;
constexpr size_t WS_ML = 3 * MiB;
constexpr size_t WS_WEFF = 6 * MiB;
constexpr size_t WS_WGU = 8 * MiB;
constexpr size_t WS_WDN = 52 * MiB;
constexpr size_t WS_WCIN = 74 * MiB, WS_WCOUT = 79 * MiB, WS_WPIN = 81 * MiB, WS_WPOUT = 85 * MiB;
constexpr size_t WS_XB = 88 * MiB;
constexpr size_t WS_R1 = 120 * MiB;
constexpr size_t WS_Q = WS_R1, WS_K = WS_R1 + 16 * MiB, WS_V = WS_R1 + 32 * MiB, WS_U = WS_R1 + 48 * MiB, WS_LIST = WS_R1 + 64 * MiB;
constexpr size_t WS_MIX = 208 * MiB;
constexpr size_t WS_PO = 240 * MiB;
constexpr size_t WS_END = 288 * MiB;
constexpr int LIST_PER_HEAD = 256 * 2016;
static_assert(WS_R1 + (size_t)M * DFF * 2 <= WS_MIX && WS_LIST + (size_t)8 * LIST_PER_HEAD * 4 <= WS_MIX && WS_PO + (size_t)3 * M * 512 * 2 <= WS_END, "d_ws map");
constexpr int CW_TMO = 0, CW_CODE = 1, CW_BAR = 4096, CW_CUR = 8192;

constexpr int RING_OFF = 0, RING_BYTES = 131072;
constexpr int LDSCTL_OFF = RING_BYTES, MISC_OFF = LDSCTL_OFF + 320;
constexpr int LDS_BYTES = 147456;

enum Phase { PH_P0 = 0, PH_P1, PH_L0_GU1, PH_L0_DN1, PH_L0_CIN, PH_L0_CONV, PH_L0_COUT, PH_L0_GU2, PH_L0_DN2,
             PH_L1_GU1, PH_L1_DN1, PH_L1_PIN, PH_L1_PRE, PH_L1_SEL, PH_L1_ATTA, PH_L1_ATTB, PH_L1_POUT, PH_L1_GU2, PH_L1_DN2, PH_FINAL, NPHASE };
constexpr int NWAVES = 8;
constexpr int N_LAUNCHES = MK_N_LAUNCHES;

struct Frame {
    LAS unsigned char* lds;
    volatile LAS unsigned* MISC;
    gu32* ctl;
    int tid, lane, wave, G, bx;
    float* out;
    unsigned char* ws;
};
enum InIdx { IN_X = 0, IN_C, IN_ADA_W, IN_ADA_B, IN_FFN_NORM, IN_W_GATE, IN_W_UP, IN_W_DOWN, IN_MIX_NORM, IN_CONV_W_IN, IN_CONV_A_W, IN_CONV_A_B, IN_LN_A_G, IN_LN_A_B, IN_CONV_B_W,
             IN_CONV_W_OUT, IN_PM_W_IN, IN_POOL_W, IN_POOL_B, IN_POOL_SCALE, IN_PM_W_OUT, IN_FINAL_NORM };
typedef __attribute__((address_space(4))) const unsigned char* kptr_t;
__device__ __forceinline__ const float* inptr(int i) {
    kptr_t p = (kptr_t)__builtin_amdgcn_kernarg_segment_ptr(); asm volatile("" : "+s"(p));
    return *(const float* const __attribute__((address_space(4)))*)(p + 8 * i);
}
#define WSP(T, off) ((T*)(F.ws + (off)))

__device__ __forceinline__ float wave_sum(float v) {
#pragma unroll
    for (int o = 1; o < 64; o <<= 1) v += __shfl_xor(v, o);
    return v;
}
__device__ __forceinline__ float bf2f(unsigned h) { return __uint_as_float(h << 16); }
__device__ __forceinline__ void wg_sync() { __syncthreads(); }

__device__ __forceinline__ void p0_phase(Frame& F) {
    LAS float* sm = (LAS float*)F.lds;
    LAS float* red = sm + 1024;
    const float* cvec = inptr(IN_C); const float* ada_w = inptr(IN_ADA_W); const float* ada_b = inptr(IN_ADA_B);
    for (int k = F.tid; k < 1024; k += NWAVES * 64) { const float v = cvec[k]; sm[k] = v / (1.0f + expf(-v)); }
    wg_sync();
    for (int wg = F.bx; wg < 256; wg += F.G) {
        const int layer = wg >> 7, cbase = (wg & 127) * 72;
        const float* W = ada_w + (size_t)layer * 1024 * 9216 + cbase;
        const int rr = F.lane / 18, cc = F.lane - rr * 18;
        f32x4 acc = {0.f, 0.f, 0.f, 0.f};
        if (rr < 3) {
            const int kb = 128 * F.wave;
#pragma unroll 8
            for (int it = 0; it < 43; ++it) { const int kk = 3 * it + rr; if (kk < 128) { const int k = kb + kk; const f32x4 w = *(const f32x4*)(W + (size_t)k * 9216 + 4 * cc); acc += w * sm[k]; } }
#pragma unroll
            for (int e = 0; e < 4; ++e) red[(F.wave * 3 + rr) * 72 + 4 * cc + e] = acc[e];
        }
        wg_sync();
        if (F.tid < 72) { float s = ada_b[layer * 9216 + cbase + F.tid];
            for (int j = 0; j < 24; ++j) s += red[j * 72 + F.tid];
            WSP(float, WS_MOD)[layer * 9216 + cbase + F.tid] = s; }
        wg_sync();
    }
    { const int gw = F.bx * NWAVES + F.wave, NGW = F.G * NWAVES; bf16* XB = WSP(bf16, WS_XB); float* SSQ = WSP(float, WS_SSQ); const float* xin = inptr(IN_X);
      for (int m = gw; m < M; m += NGW) {
          const f32x4* xr = (const f32x4*)(xin + (size_t)m * D) + F.lane; f32x4 v[4]; float s = 0.f;
#pragma unroll
          for (int j = 0; j < 4; ++j) { v[j] = xr[64 * j]; s += (v[j][0] * v[j][0] + v[j][1] * v[j][1]) + (v[j][2] * v[j][2] + v[j][3] * v[j][3]); }
          s = wave_sum(s);
          unsigned long long* o8 = (unsigned long long*)(XB + (size_t)m * D) + F.lane;
#pragma unroll
          for (int j = 0; j < 4; ++j) o8[64 * j] = (unsigned long long)pk2(v[j][0], v[j][1]) | ((unsigned long long)pk2(v[j][2], v[j][3]) << 32);
          if (F.lane < 4) SSQ[(size_t)F.lane * M + m] = F.lane == 0 ? s : 0.f;
      } }
    const float* pool_w = inptr(IN_POOL_W); const float* pool_scale = inptr(IN_POOL_SCALE); const float* pm_w_out = inptr(IN_PM_W_OUT); const float* pool_b = inptr(IN_POOL_B);
    for (int gid = F.bx * NWAVES * 64 + F.tid; gid < 512 * 256; gid += F.G * NWAVES * 64) {
        const int krow = gid >> 8, n4 = (gid & 255) * 4, g = krow >> 7;
        const float* pw = pool_w + (size_t)krow * 128; const float* ps = pool_scale + g * 128; const float* wo = pm_w_out + (size_t)(g * 128) * 1024 + n4;
        f32x4 acc = {0.f, 0.f, 0.f, 0.f};
#pragma unroll 8
        for (int d = 0; d < 128; ++d) { const float a = pw[d] * ps[d]; acc += *(const f32x4*)(wo + (size_t)d * 1024) * a; }
        *(f32x4*)(WSP(float, WS_WEFF) + (size_t)krow * 1024 + n4) = acc;
    }
    for (int n = F.bx * NWAVES * 64 + F.tid; n < 1024; n += F.G * NWAVES * 64) {
        float s = 0.f;
        for (int k = 0; k < 512; ++k) s += pool_b[k] * pool_scale[k] * pm_w_out[(size_t)k * 1024 + n];
        WSP(float, WS_BEFF)[n] = s;
    }
}

__device__ __forceinline__ void prep_strip(Frame& F, const float* src, int ldn, const float* src2, int ksplit, int kbeg, int ktiles,
                                           bf16* dst, int ldk, bool useG, const LAS float* Gs, const LAS float* Ss, const float* rsc, float rs_mul, float* bias_out, LAS float* red) {
    const int r = F.lane >> 4, c16 = F.lane & 15;
    f32x4 rs = {rs_mul, rs_mul, rs_mul, rs_mul};
    if (rsc) { const f32x4 g = *(const f32x4*)(rsc + 4 * c16); rs = g * rs_mul; }
    f32x4 bacc = {0.f, 0.f, 0.f, 0.f};
    for (int t = F.wave; t < ktiles; t += NWAVES) {
        const int k0 = kbeg + 64 * t + 16 * r;
        f32x4 v[16];
#pragma unroll
        for (int i = 0; i < 16; ++i) { const int k = k0 + i; const float* p = (src2 && k >= ksplit) ? src2 + (size_t)k * ldn : src + (size_t)k * ldn; v[i] = *(const f32x4*)(p + 4 * c16); }
        if (useG) {
#pragma unroll
            for (int i = 0; i < 16; ++i) { bacc += v[i] * Ss[k0 + i]; v[i] = v[i] * Gs[k0 + i]; }
        }
#pragma unroll
        for (int e = 0; e < 4; ++e) {
            v4u lo, hi; const float s = rs[e];
            lo.x = pk2(v[0][e] * s, v[1][e] * s);   lo.y = pk2(v[2][e] * s, v[3][e] * s);   lo.z = pk2(v[4][e] * s, v[5][e] * s);   lo.w = pk2(v[6][e] * s, v[7][e] * s);
            hi.x = pk2(v[8][e] * s, v[9][e] * s);   hi.y = pk2(v[10][e] * s, v[11][e] * s); hi.z = pk2(v[12][e] * s, v[13][e] * s); hi.w = pk2(v[14][e] * s, v[15][e] * s);
            bf16* o = dst + (size_t)(4 * c16 + e) * ldk + k0;
            *(v4u*)o = lo; *(v4u*)(o + 8) = hi;
        }
    }
    if (bias_out) {
#pragma unroll
        for (int e = 0; e < 4; ++e) { float s = bacc[e]; s += __shfl_xor(s, 16); s += __shfl_xor(s, 32); bacc[e] = s; }
        if (r == 0) {
#pragma unroll
            for (int e = 0; e < 4; ++e) red[F.wave * 64 + 4 * c16 + e] = bacc[e];
        }
        wg_sync();
        if (F.tid < 64) { float s = 0.f;
#pragma unroll
            for (int w = 0; w < NWAVES; ++w) s += red[w * 64 + F.tid];
            bias_out[F.tid] = s; }
        wg_sync();
    }
}
__device__ __forceinline__ void p1_phase(Frame& F) {
    LAS float* Gs = (LAS float*)F.lds;
    LAS float* Ss = Gs + 1024;
    LAS float* red = Ss + 1024;
    const float* MOD = WSP(float, WS_MOD);
    constexpr int N_GU = 352, N_CIN = 40, N_PIN = 32, N_COUT = 16, N_POUT = 16, N_DN = 256;
    constexpr int NITEMS = N_GU + N_CIN + N_PIN + N_COUT + N_POUT + N_DN;
    for (int it = F.bx; it < NITEMS; it += F.G) {
        int s = it;
        if (s < N_GU + N_CIN + N_PIN) {
            const float *nrm, *md; const float* src; int ldn; bf16* dst; float* bias; int n0, drow;
            if (s < N_GU) { const int f = s / 88, r = s % 88, isup = r / 44; n0 = (r % 44) * 64;
                src = inptr(isup ? IN_W_UP : IN_W_GATE) + (size_t)f * 1024 * DFF + n0; ldn = DFF;
                drow = 256 * (n0 / 128) + 128 * isup + (n0 % 128); dst = WSP(bf16, WS_WGU) + (size_t)f * NGU * 1024 + (size_t)drow * 1024; bias = WSP(float, WS_BGU) + f * NGU + drow;
                nrm = inptr(IN_FFN_NORM) + f * 1024; md = MOD + (f >> 1) * 9216 + ((f & 1) ? 6 : 0) * 1024; }
            else if (s < N_GU + N_CIN) { s -= N_GU; n0 = s * 64; const int seg = n0 / 512, c = n0 % 512, t2 = 256 * (c / 128) + (c % 128);
                drow = seg == 0 ? t2 : seg == 1 ? t2 + 128 : seg == 2 ? 2048 + c : seg == 3 ? 1024 + t2 : 1024 + t2 + 128;
                src = inptr(IN_CONV_W_IN) + n0; ldn = NCIN; dst = WSP(bf16, WS_WCIN) + (size_t)drow * 1024; bias = WSP(float, WS_BCIN) + drow;
                nrm = inptr(IN_MIX_NORM); md = MOD + 3 * 1024; }
            else { s -= N_GU + N_CIN; n0 = s * 64; drow = n0;
                src = inptr(IN_PM_W_IN) + n0; ldn = NPIN; dst = WSP(bf16, WS_WPIN) + (size_t)drow * 1024; bias = WSP(float, WS_BPIN) + drow;
                nrm = inptr(IN_MIX_NORM) + 1024; md = MOD + 9216 + 3 * 1024; }
            for (int k = F.tid; k < 1024; k += NWAVES * 64) { Gs[k] = nrm[k] * (1.0f + md[1024 + k]); Ss[k] = md[k]; }
            wg_sync();
            prep_strip(F, src, ldn, nullptr, 0, 0, 16, dst, 1024, true, Gs, Ss, nullptr, 1.0f, bias, red);
            continue;
        }
        s -= N_GU + N_CIN + N_PIN;
        if (s < N_COUT) { const int n0 = s * 64;
            prep_strip(F, inptr(IN_CONV_W_OUT) + n0, 1024, nullptr, 0, 0, 16, WSP(bf16, WS_WCOUT) + (size_t)n0 * 1024, 1024, false, Gs, Ss, MOD + 5 * 1024 + n0, 1.0f, nullptr, red);
            continue; }
        s -= N_COUT;
        if (s < N_POUT) { const int n0 = s * 64; const float* gate = MOD + 9216 + 5 * 1024 + n0;
            prep_strip(F, WSP(float, WS_WEFF) + n0, 1024, inptr(IN_PM_W_OUT) + n0, 512, 0, 16, WSP(bf16, WS_WPOUT) + (size_t)n0 * 1024, 1024, false, Gs, Ss, gate, 1.0f, nullptr, red);
            if (F.tid < 64) WSP(float, WS_BPOUT)[n0 + F.tid] = gate[F.tid] * WSP(float, WS_BEFF)[n0 + F.tid];
            continue; }
        s -= N_POUT;
        { const int f = s / 64, r = s % 64, n0 = (r >> 2) * 64, kq = r & 3;
          const float* gate = MOD + (f >> 1) * 9216 + (((f & 1) ? 6 : 0) + 2) * 1024 + n0;
          prep_strip(F, inptr(IN_W_DOWN) + (size_t)f * DFF * 1024 + n0, 1024, nullptr, 0, 704 * kq, 11, WSP(bf16, WS_WDN) + (size_t)f * 1024 * DFF + (size_t)n0 * DFF, DFF, false, Gs, Ss, gate, 0.5f, nullptr, red); }
    }
}

__device__ __forceinline__ void conv_phase(Frame& F) {
    const bf16* ZC = WSP(bf16, WS_R1); bf16* MIX = WSP(bf16, WS_MIX);
    const int c = F.wave * 64 + F.lane;
    const float* conv_a_w = inptr(IN_CONV_A_W); const float* conv_b_w = inptr(IN_CONV_B_W);
    float w[31];
#pragma unroll
    for (int k = 0; k < 31; ++k) w[k] = conv_a_w[k * 512 + c];
    const float cb = inptr(IN_CONV_A_B)[c], lg = inptr(IN_LN_A_G)[c], lb = inptr(IN_LN_A_B)[c];
    const float w0 = conv_b_w[c], w1 = conv_b_w[512 + c], w2 = conv_b_w[1024 + c];
    for (int unit = F.bx; unit < M / 64; unit += F.G) {
        const int t0 = unit * 64;
        float win[31];
#pragma unroll
        for (int k = 0; k < 31; ++k) win[k] = 0.f;
        for (int jj = 0; jj < 4; ++jj) {
            float nx[31];
#pragma unroll
            for (int i = 0; i < 31; ++i) { const int tt = jj * 31 + i, t = t0 - 30 + tt; nx[i] = (tt < 94 && t >= 0) ? bf2f(ZC[(size_t)t * 1536 + c]) : 0.f; }
#pragma unroll
            for (int i = 0; i < 31; ++i) { const int tt = jj * 31 + i;
                win[i] = nx[i];
                if (tt >= 30 && tt < 94) {
                    float y = cb;
#pragma unroll
                    for (int k = 0; k < 31; ++k) y += w[k] * win[(i + 1 + k) % 31];
                    const float mean = wave_sum(y) * (1.0f / 64.0f), d = y - mean, var = wave_sum(d * d) * (1.0f / 64.0f);
                    const float yn = d * (1.0f / sqrtf(var + EPS)) * lg + lb;
                    const float sv = yn / (1.0f + __builtin_amdgcn_exp2f(-LOG2E * yn));
                    MIX[(size_t)(t0 - 30 + tt) * 1024 + c] = (bf16)f2bf(sv);
                }
                __builtin_amdgcn_sched_barrier(0); }
        }
        float p2 = t0 >= 2 ? bf2f(ZC[(size_t)(t0 - 2) * 1536 + 512 + c]) : 0.f, p1 = t0 >= 1 ? bf2f(ZC[(size_t)(t0 - 1) * 1536 + 512 + c]) : 0.f;
#pragma unroll 8
        for (int tt = 0; tt < 64; ++tt) { const int t = t0 + tt; const float cur = bf2f(ZC[(size_t)t * 1536 + 512 + c]), bg = bf2f(ZC[(size_t)t * 1536 + 1024 + c]);
            MIX[(size_t)t * 1024 + 512 + c] = (bf16)f2bf(bg * (w0 * p2 + w1 * p1 + w2 * cur)); p2 = p1; p1 = cur; }
    }
}

__device__ __forceinline__ void pre_phase(Frame& F) {
    const bf16* Kb = WSP(bf16, WS_K); const bf16* U = WSP(bf16, WS_U); bf16* MIX = WSP(bf16, WS_MIX); float* KM = WSP(float, WS_KMEAN);
    LAS float* part = (LAS float*)F.lds;
    for (int unit = F.bx; unit < NBLK * NHEAD; unit += F.G) {
        const int b = unit >> 3, h = unit & 7, key = F.tid >> 3, ch = F.tid & 7;
        float s[8];
#pragma unroll
        for (int e = 0; e < 8; ++e) s[e] = 0.f;
#pragma unroll
        for (int i = 0; i < 4; ++i) { const v4u q = *(const v4u*)(Kb + (size_t)(b * 256 + 64 * i + key) * 512 + h * 64 + ch * 8);
            s[0] += bf2f(q.x & 0xffffu); s[1] += bf2f(q.x >> 16); s[2] += bf2f(q.y & 0xffffu); s[3] += bf2f(q.y >> 16);
            s[4] += bf2f(q.z & 0xffffu); s[5] += bf2f(q.z >> 16); s[6] += bf2f(q.w & 0xffffu); s[7] += bf2f(q.w >> 16); }
#pragma unroll
        for (int e = 0; e < 8; ++e) part[F.tid * 8 + e] = s[e];
        wg_sync();
        if (F.tid < 64) { const int cq = F.tid >> 3, e = F.tid & 7; float t = 0.f;
            for (int kk = 0; kk < 64; ++kk) t += part[(kk * 8 + cq) * 8 + e];
            KM[(size_t)(h * 64 + b) * 64 + F.tid] = t * (1.0f / 256.0f); }
        wg_sync();
    }
    for (int idx = F.bx * NWAVES * 64 + F.tid; idx < M * 64; idx += F.G * NWAVES * 64) {
        const int t = idx >> 6, ch = idx & 63, w = 2 << (ch >> 4), n = (t + 1) < w ? (t + 1) : w;
        float s[8], u0[8];
#pragma unroll
        for (int e = 0; e < 8; ++e) s[e] = 0.f;
        for (int j = 0; j < n; ++j) { const v4u q = *(const v4u*)(U + (size_t)(t - j) * 512 + ch * 8);
            float v[8] = {bf2f(q.x & 0xffffu), bf2f(q.x >> 16), bf2f(q.y & 0xffffu), bf2f(q.y >> 16), bf2f(q.z & 0xffffu), bf2f(q.z >> 16), bf2f(q.w & 0xffffu), bf2f(q.w >> 16)};
#pragma unroll
            for (int e = 0; e < 8; ++e) { s[e] += v[e]; if (j == 0) u0[e] = v[e]; } }
        const float inv = 1.0f / (float)n; v4u o;
        o.x = pk2(s[0] * inv - u0[0], s[1] * inv - u0[1]); o.y = pk2(s[2] * inv - u0[2], s[3] * inv - u0[3]);
        o.z = pk2(s[4] * inv - u0[4], s[5] * inv - u0[5]); o.w = pk2(s[6] * inv - u0[6], s[7] * inv - u0[7]);
        *(v4u*)(MIX + (size_t)t * 1024 + ch * 8) = o;
    }
}

__device__ __forceinline__ int list_off(int b) { return 256 * (63 * b - (b * (b - 1)) / 2); }
__device__ __forceinline__ void sel_phase(Frame& F) {
    const bf16* Qb = WSP(bf16, WS_Q); const float* KM = WSP(float, WS_KMEAN); unsigned* LIST = WSP(unsigned, WS_LIST);
    LAS float* km = (LAS float*)F.lds;
    for (int unit = F.bx; unit < NHEAD * (M / 512); unit += F.G) {
        const int h = unit & 7, chunk = unit >> 3, t = chunk * 512 + F.tid, own = t >> 8, nb = 2 * chunk + 1;
        wg_sync();
        for (int i = F.tid; i < nb * 64; i += NWAVES * 64) km[i] = KM[(size_t)h * 4096 + i];
        wg_sync();
        float q[64];
#pragma unroll
        for (int i = 0; i < 8; ++i) { const v4u v = *(const v4u*)(Qb + (size_t)t * 512 + h * 64 + i * 8);
            q[8 * i + 0] = bf2f(v.x & 0xffffu); q[8 * i + 1] = bf2f(v.x >> 16); q[8 * i + 2] = bf2f(v.y & 0xffffu); q[8 * i + 3] = bf2f(v.y >> 16);
            q[8 * i + 4] = bf2f(v.z & 0xffffu); q[8 * i + 5] = bf2f(v.z >> 16); q[8 * i + 6] = bf2f(v.w & 0xffffu); q[8 * i + 7] = bf2f(v.w >> 16); }
        float v0 = -INFINITY, v1 = -INFINITY, v2 = -INFINITY; int i0 = 0, i1 = 0, i2 = 0;
        for (int b = 0; b < nb; ++b) {
            float g = 0.f;
#pragma unroll
            for (int d4 = 0; d4 < 16; ++d4) { const f32x4 kv = *(const LAS f32x4*)(km + b * 64 + 4 * d4); g += (q[4 * d4] * kv[0] + q[4 * d4 + 1] * kv[1]) + (q[4 * d4 + 2] * kv[2] + q[4 * d4 + 3] * kv[3]); }
            if (b < own) {
                if (g > v0) { v2 = v1; i2 = i1; v1 = v0; i1 = i0; v0 = g; i0 = b; }
                else if (g > v1) { v2 = v1; i2 = i1; v1 = g; i1 = b; }
                else if (g > v2) { v2 = g; i2 = b; }
            }
        }
        const int nsel = own < 3 ? own : 3;
        if (nsel > 0) { const unsigned p = atomicAdd((unsigned*)F.ctl + CW_CUR + h * 64 + i0, 1u); LIST[(size_t)h * LIST_PER_HEAD + list_off(i0) + p] = (unsigned)t; }
        if (nsel > 1) { const unsigned p = atomicAdd((unsigned*)F.ctl + CW_CUR + h * 64 + i1, 1u); LIST[(size_t)h * LIST_PER_HEAD + list_off(i1) + p] = (unsigned)t | (1u << 16); }
        if (nsel > 2) { const unsigned p = atomicAdd((unsigned*)F.ctl + CW_CUR + h * 64 + i2, 1u); LIST[(size_t)h * LIST_PER_HEAD + list_off(i2) + p] = (unsigned)t | (2u << 16); }
    }
}

namespace att {
typedef short s16x4 __attribute__((ext_vector_type(4)));
typedef float f32x16 __attribute__((ext_vector_type(16)));
typedef short v4i16_t __attribute__((ext_vector_type(4)));
typedef float f32x2_t __attribute__((ext_vector_type(2)));
typedef __bf16 bf16x2_t __attribute__((ext_vector_type(2)));
constexpr int KOFF = 0, VOFF = 32768, WSF_OFF = 65536, QL_OFF = WSF_OFF + 2048, COEF_OFF = QL_OFF + 1024, SCAN_OFF = COEF_OFF + 4096, ATT_LDS_END = SCAN_OFF + 2048;
__device__ __forceinline__ int crow(int r, int hi) { return (r & 3) + 8 * (r >> 2) + 4 * hi; }
__device__ __forceinline__ unsigned cvtpk(float lo, float hi) { f32x2_t v = {lo, hi}; bf16x2_t b = __builtin_convertvector(v, bf16x2_t); return __builtin_bit_cast(unsigned, b); }
__device__ __forceinline__ s16x4 vtr(const LAS unsigned char* p) { return __builtin_bit_cast(s16x4, __builtin_amdgcn_ds_read_tr16_b64_v4i16((LAS v4i16_t*)p)); }
#define ATT_MFMA(a, b, c) __builtin_amdgcn_mfma_f32_32x32x16_bf16(a, b, c, 0, 0, 0)

__device__ __forceinline__ void load_kv(LAS unsigned char* lds, const bf16* Kb, const bf16* Vb, int b, int h, int wave, int lane) {
    const bf16* ks = Kb + (size_t)(b * 256 + lane) * 512 + h * 64 + wave * 8;
    const int vkey = 16 * (wave & 3) + (lane >> 2);
    const bf16* vs = Vb + (size_t)(b * 256 + vkey) * 512 + h * 64 + (wave >> 2) * 32 + (lane & 3) * 8;
    v4u kq[4], vq[4];
#pragma unroll
    for (int i = 0; i < 4; ++i) { kq[i] = *(const v4u*)(ks + (size_t)i * 64 * 512); vq[i] = *(const v4u*)(vs + (size_t)i * 64 * 512); }
#pragma unroll
    for (int i = 0; i < 4; ++i) { *(LAS v4u*)(lds + KOFF + i * 8192 + wave * 1024 + lane * 16) = kq[i];
                                  *(LAS v4u*)(lds + VOFF + i * 8192 + (wave >> 2) * 4096 + vkey * 64 + (lane & 3) * 16) = vq[i]; }
}

template <bool OWN>
__device__ __forceinline__ void item(Frame& F, int h, int b, const unsigned* list, int nrows) {
    LAS unsigned char* lds = F.lds;
    const int lane = F.lane, wave = F.wave, r32 = lane & 31, hi = lane >> 5;
    LAS float* wsf = (LAS float*)(lds + WSF_OFF) + wave * 64;
    LAS unsigned* QL = (LAS unsigned*)(lds + QL_OFF);
    LAS float* coef = (LAS float*)(lds + COEF_OFF) + wave * 128;
    const bf16* Qb = WSP(bf16, WS_Q);
    wg_sync();
    load_kv(lds, WSP(bf16, WS_K), WSP(bf16, WS_V), b, h, wave, lane);
    if (F.tid < 256) { unsigned e;
        if (OWN) e = (unsigned)(b * 256 + F.tid);
        else { const int rr = F.tid < nrows ? F.tid : nrows - 1; e = list[rr] | (F.tid < nrows ? 0u : 0x80000000u); }
        QL[F.tid] = e; }
    wg_sync();
    const unsigned ent = QL[wave * 32 + r32];
    const int t = (int)(ent & 0x3fffu);
    bf16x8 qr[4];
#pragma unroll
    for (int d0 = 0; d0 < 4; ++d0) qr[d0] = *(const bf16x8*)(Qb + (size_t)t * 512 + h * 64 + d0 * 16 + hi * 8);
    const float slope2 = LOG2E / (float)(2 << h);
    float m = -INFINITY, l = 0.f; f32x16 o[2]; o[0] = f32x16{}; o[1] = f32x16{};
    const int ntile = OWN ? ((wave * 32 + 31) >> 6) + 1 : 4;
#pragma unroll 1
    for (int tile = 0; tile < ntile; ++tile) {
        const float base = slope2 * (float)(b * 256 + tile * 64 + 4 * hi - t);
        f32x16 p0, p1;
#pragma unroll
        for (int r = 0; r < 16; ++r) { p0[r] = base + slope2 * (float)((r & 3) + 8 * (r >> 2)); p1[r] = p0[r] + 32.0f * slope2; }
        const LAS unsigned char* kb = lds + KOFF + tile * 8192 + hi * 1024 + r32 * 16;
#pragma unroll
        for (int d0 = 0; d0 < 4; ++d0) { const bf16x8 k0 = *(const LAS bf16x8*)(kb + d0 * 2048), k1 = *(const LAS bf16x8*)(kb + d0 * 2048 + 512);
            p0 = ATT_MFMA(k0, qr[d0], p0); p1 = ATT_MFMA(k1, qr[d0], p1); }
        if (OWN) { const int qo = t - b * 256, kk = tile * 64 + 4 * hi;
#pragma unroll
            for (int r = 0; r < 16; ++r) { const int kv = kk + (r & 3) + 8 * (r >> 2); if (kv > qo) p0[r] = -INFINITY; if (kv + 32 > qo) p1[r] = -INFINITY; } }
        float rm = fmaxf(p0[0], p1[0]);
#pragma unroll
        for (int r = 1; r < 16; ++r) rm = fmaxf(rm, fmaxf(p0[r], p1[r]));
        rm = fmaxf(rm, __shfl_xor(rm, 32));
        const float mn = fmaxf(m, rm), alpha = __builtin_amdgcn_exp2f(m - mn);
        m = mn;
        float ls = 0.f;
#pragma unroll
        for (int r = 0; r < 16; ++r) { p0[r] = __builtin_amdgcn_exp2f(p0[r] - mn); p1[r] = __builtin_amdgcn_exp2f(p1[r] - mn); ls += p0[r] + p1[r]; }
        l = l * alpha + ls;
        if (tile > 0) {
            if (hi == 0) wsf[r32] = alpha;
            asm volatile("s_waitcnt lgkmcnt(0)" ::: "memory");
#pragma unroll
            for (int r = 0; r < 16; ++r) { const float a = wsf[crow(r, hi)]; o[0][r] *= a; o[1][r] *= a; }
        }
        bf16x8 pa[4];
        { v4u w0 = {cvtpk(p0[0], p0[1]), cvtpk(p0[2], p0[3]), cvtpk(p0[4], p0[5]), cvtpk(p0[6], p0[7])};
          v4u w1 = {cvtpk(p0[8], p0[9]), cvtpk(p0[10], p0[11]), cvtpk(p0[12], p0[13]), cvtpk(p0[14], p0[15])};
          v4u w2 = {cvtpk(p1[0], p1[1]), cvtpk(p1[2], p1[3]), cvtpk(p1[4], p1[5]), cvtpk(p1[6], p1[7])};
          v4u w3 = {cvtpk(p1[8], p1[9]), cvtpk(p1[10], p1[11]), cvtpk(p1[12], p1[13]), cvtpk(p1[14], p1[15])};
          pa[0] = __builtin_bit_cast(bf16x8, w0); pa[1] = __builtin_bit_cast(bf16x8, w1); pa[2] = __builtin_bit_cast(bf16x8, w2); pa[3] = __builtin_bit_cast(bf16x8, w3); }
        const LAS unsigned char* vb = lds + VOFF + tile * 8192 + ((lane >> 4) & 1) * 32 + (lane & 3) * 8 + (4 * hi + ((lane & 15) >> 2)) * 64;
#pragma unroll
        for (int d0 = 0; d0 < 2; ++d0)
#pragma unroll
            for (int ks = 0; ks < 4; ++ks) { const s16x4 lo = vtr(vb + d0 * 4096 + ks * 1024), hh = vtr(vb + d0 * 4096 + ks * 1024 + 512);
                const bf16x8 vf = {lo[0], lo[1], lo[2], lo[3], hh[0], hh[1], hh[2], hh[3]};
                o[d0] = ATT_MFMA(pa[ks], vf, o[d0]); }
    }
    l += __shfl_xor(l, 32);
    if (!OWN) {
        if (hi == 0) wsf[32 + r32] = l;
        asm volatile("s_waitcnt lgkmcnt(0)" ::: "memory");
        bf16* PO = WSP(bf16, WS_PO); float* ML = WSP(float, WS_ML);
#pragma unroll
        for (int r = 0; r < 16; ++r) { const int q = crow(r, hi); const unsigned e = QL[wave * 32 + q]; const float rl = 1.0f / wsf[32 + q];
            if (!(e & 0x80000000u)) { const int tq = (int)(e & 0x3fffu), j = (int)((e >> 16) & 3u); bf16* op = PO + ((size_t)j * M + tq) * 512 + h * 64 + r32;
                op[0] = (bf16)f2bf(o[0][r] * rl); op[32] = (bf16)f2bf(o[1][r] * rl); } }
        if (hi == 0 && !(ent & 0x80000000u)) { const int j = (int)((ent >> 16) & 3u); f32x2_t ml = {m, l}; *(f32x2_t*)(ML + (((size_t)j * M + t) * 8 + h) * 2) = ml; }
    } else {
        const int nsel = b < 3 ? b : 3;
        if (hi == 0) { const float* ML = WSP(float, WS_ML); float mj[3], lj[3]; float mx = m;
#pragma unroll
            for (int j = 0; j < 3; ++j) { if (j < nsel) { const f32x2_t ml = *(const f32x2_t*)(ML + (((size_t)j * M + t) * 8 + h) * 2); mj[j] = ml[0]; lj[j] = ml[1]; mx = fmaxf(mx, mj[j]); } else { mj[j] = -INFINITY; lj[j] = 0.f; } }
            const float ao = __builtin_amdgcn_exp2f(m - mx); float wj[3]; float den = ao * l;
#pragma unroll
            for (int j = 0; j < 3; ++j) { wj[j] = j < nsel ? lj[j] * __builtin_amdgcn_exp2f(mj[j] - mx) : 0.f; den += wj[j]; }
            const float inv = 1.0f / den; f32x4 cf = {ao * inv, wj[0] * inv, wj[1] * inv, wj[2] * inv};
            *(LAS f32x4*)(coef + r32 * 4) = cf; }
        asm volatile("s_waitcnt lgkmcnt(0)" ::: "memory");
        const bf16* PO = WSP(bf16, WS_PO); bf16* MIX = WSP(bf16, WS_MIX);
#pragma unroll
        for (int r = 0; r < 16; ++r) { const int q = crow(r, hi), tq = b * 256 + wave * 32 + q; const f32x4 cf = *(const LAS f32x4*)(coef + q * 4);
            float a0 = cf[0] * o[0][r], a1 = cf[0] * o[1][r];
#pragma unroll
            for (int j = 0; j < 3; ++j) if (j < nsel) { const bf16* pp = PO + ((size_t)j * M + tq) * 512 + h * 64 + r32; a0 += cf[1 + j] * bf2f(pp[0]); a1 += cf[1 + j] * bf2f(pp[32]); }
            bf16* op = MIX + (size_t)tq * 1024 + 512 + h * 64 + r32; op[0] = (bf16)f2bf(a0); op[32] = (bf16)f2bf(a1); }
    }
}
}

__device__ __forceinline__ void atta_phase(Frame& F) {
    LAS unsigned* SC = (LAS unsigned*)(F.lds + att::SCAN_OFF);
    const unsigned* cur = (const unsigned*)F.ctl + CW_CUR;
    { const unsigned cn = __hip_atomic_load(cur + F.tid, __ATOMIC_RELAXED, __HIP_MEMORY_SCOPE_AGENT); SC[F.tid] = (cn + 255u) >> 8; }
    wg_sync();
    for (int off = 1; off < 512; off <<= 1) { const unsigned v = SC[F.tid] + (F.tid >= off ? SC[F.tid - off] : 0u); wg_sync(); SC[F.tid] = v; wg_sync(); }
    const int total = (int)SC[511];
    for (int idx = F.bx; idx < total; idx += F.G) {
        int lo = 0, hi = 511;
        while (lo < hi) { const int mid = (lo + hi) >> 1; if ((int)SC[mid] > idx) hi = mid; else lo = mid + 1; }
        const int i = lo, h = i >> 6, b = i & 63, before = i ? (int)SC[i - 1] : 0, chunk = idx - before;
        const int cn = (int)__hip_atomic_load(cur + i, __ATOMIC_RELAXED, __HIP_MEMORY_SCOPE_AGENT);
        const int nrows = (cn - chunk * 256) < 256 ? (cn - chunk * 256) : 256;
        att::item<false>(F, h, b, WSP(unsigned, WS_LIST) + (size_t)h * LIST_PER_HEAD + list_off(b) + chunk * 256, nrows);
    }
}
__device__ __forceinline__ void attb_phase(Frame& F) {
    for (int idx = F.bx; idx < NHEAD * NBLK; idx += F.G) att::item<true>(F, idx & 7, idx >> 3, nullptr, 256);
}

__device__ __forceinline__ void final_phase(Frame& F) {
    const int gw = F.bx * NWAVES + F.wave, NGW = F.G * NWAVES; const float* SSQ = WSP(float, WS_SSQ);
    f32x4 g[4]; const float* fnorm = inptr(IN_FINAL_NORM);
#pragma unroll
    for (int j = 0; j < 4; ++j) g[j] = ((const f32x4*)fnorm)[F.lane + 64 * j];
    for (int m = gw; m < M; m += NGW) {
        const float s = ((SSQ[m] + SSQ[M + m]) + SSQ[2 * M + m]) + SSQ[3 * M + m];
        const float ri = 1.0f / sqrtf(s * (1.0f / 1024.0f) + EPS);
        f32x4* xr = (f32x4*)(F.out + (size_t)m * D) + F.lane;
#pragma unroll
        for (int j = 0; j < 4; ++j) { const f32x4 v = xr[64 * j]; xr[64 * j] = v * ri * g[j]; }
    }
}

struct Args { const float* in[22]; float* out; unsigned char* ws; int ph_lo, ph_hi; };
__global__ void __launch_bounds__(NWAVES * 64, 2) skel_fwd(Args args) {
    extern __shared__ __attribute__((aligned(16))) unsigned char lds[];
    Frame F;
    F.lds = (LAS unsigned char*)lds;
    F.MISC = (volatile LAS unsigned*)(F.lds + MISC_OFF);
    F.tid = threadIdx.x; F.lane = F.tid & 63; F.wave = __builtin_amdgcn_readfirstlane(F.tid >> 6);
    F.G = gridDim.x; F.bx = blockIdx.x;
    F.ws = args.ws; F.ctl = (gu32*)(args.ws + WS_CTL); F.out = args.out;
    for (int u = F.tid; u < (LDS_BYTES - LDSCTL_OFF) / 4; u += NWAVES * 64) ((LAS unsigned*)(F.lds + LDSCTL_OFF))[u] = 0u;
    __syncthreads();
    XcdBarrier bar; bar.bar = (unsigned*)(F.ctl + CW_BAR); bar.x = 0; bar.st = nullptr;
    if (N_LAUNCHES == 1) bar = xcd_barrier_post((unsigned*)(F.ctl + CW_BAR), F.MISC + 8);
    const int lo = args.ph_lo, hi = args.ph_hi;
#ifndef DBG_ONLY
#define DBG_ONLY -1
#endif
#define IN(k) (lo <= (k) && (k) < hi && (DBG_ONLY < 0 || (k) == DBG_ONLY))
#define SEAM(k) do { if (IN(k) && IN((k) + 1)) xcd_barrier(bar); asm volatile("" : "+v"(F.tid), "+v"(F.lane)); } while (0)
    const pg8::bf16_t* XB = (const pg8::bf16_t*)(args.ws + WS_XB); const float* SSQ = (const float*)(args.ws + WS_SSQ);

    if (IN(PH_P0)) { p0_phase(F); } SEAM(PH_P0);
    if (IN(PH_P1)) { p1_phase(F); } SEAM(PH_P1);
#pragma unroll 1
    for (int layer = 0; layer < 2; ++layer) {
#pragma unroll 1
        for (int sub = 0; sub < 3; ++sub) {
            if (sub != 1) {
                const int f = layer * 2 + (sub == 2 ? 1 : 0);
                const int ph_gu = layer == 0 ? (sub == 0 ? PH_L0_GU1 : PH_L0_GU2) : (sub == 0 ? PH_L1_GU1 : PH_L1_GU2);
                if (IN(ph_gu)) {
                    pg8::Gemm g{XB, (const pg8::bf16_t*)(args.ws + WS_WGU) + (size_t)f * NGU * 1024, M, NGU, D}; pg8::StaticOrder S; S.init(M, NGU, F.G, F.bx);
                    pg8::EpiGU E{(pg8::bf16_t*)(args.ws + WS_R1), (const float*)(args.ws + WS_BGU) + f * NGU, SSQ};
                    pg8::gemm_phase<pg8::EpiGU, pg8::StaticOrder, true, true>(F.lds + RING_OFF, g, S, E);
                }
                SEAM(ph_gu);
                if (IN(ph_gu + 1)) {
                    pg8::Gemm g{(const pg8::bf16_t*)(args.ws + WS_R1), (const pg8::bf16_t*)(args.ws + WS_WDN) + (size_t)f * 1024 * DFF, M, D, DFF}; pg8::StaticOrder S; S.init(M, D, F.G, F.bx);
                    pg8::EpiRes E{(layer == 0 && sub == 0) ? inptr(IN_X) : F.out, F.out, (pg8::bf16_t*)(args.ws + WS_XB), nullptr, (float*)(args.ws + WS_SSQ)};
                    pg8::gemm_phase<pg8::EpiRes, pg8::StaticOrder, false, true>(F.lds + RING_OFF, g, S, E);
                }
                SEAM(ph_gu + 1);
            } else if (layer == 0) {
                if (IN(PH_L0_CIN)) {
                    pg8::Gemm g{XB, (const pg8::bf16_t*)(args.ws + WS_WCIN), M, NCIN, D}; pg8::StaticOrder S; S.init(M, NCIN, F.G, F.bx);
                    pg8::EpiCin E{(pg8::bf16_t*)(args.ws + WS_R1), (const float*)(args.ws + WS_BCIN), SSQ};
                    pg8::gemm_phase<pg8::EpiCin, pg8::StaticOrder, true, true>(F.lds + RING_OFF, g, S, E);
                }
                SEAM(PH_L0_CIN);
                if (IN(PH_L0_CONV)) conv_phase(F);
                SEAM(PH_L0_CONV);
                if (IN(PH_L0_COUT)) {
                    pg8::Gemm g{(const pg8::bf16_t*)(args.ws + WS_MIX), (const pg8::bf16_t*)(args.ws + WS_WCOUT), M, D, D}; pg8::StaticOrder S; S.init(M, D, F.G, F.bx);
                    pg8::EpiRes E{F.out, F.out, (pg8::bf16_t*)(args.ws + WS_XB), nullptr, (float*)(args.ws + WS_SSQ)};
                    pg8::gemm_phase<pg8::EpiRes, pg8::StaticOrder, false, true>(F.lds + RING_OFF, g, S, E);
                }
                SEAM(PH_L0_COUT);
            } else {
                if (IN(PH_L1_PIN)) {
                    pg8::Gemm g{XB, (const pg8::bf16_t*)(args.ws + WS_WPIN), M, NPIN, D}; pg8::StaticOrder S; S.init(M, NPIN, F.G, F.bx);
                    pg8::EpiPin E{(pg8::bf16_t*)(args.ws + WS_Q), (const float*)(args.ws + WS_BPIN), SSQ};
                    pg8::gemm_phase<pg8::EpiPin, pg8::StaticOrder, true, true>(F.lds + RING_OFF, g, S, E);
                }
                SEAM(PH_L1_PIN);
                if (IN(PH_L1_PRE)) pre_phase(F);
                SEAM(PH_L1_PRE);
                if (IN(PH_L1_SEL)) sel_phase(F);
                SEAM(PH_L1_SEL);
                if (IN(PH_L1_ATTA)) atta_phase(F);
                SEAM(PH_L1_ATTA);
                if (IN(PH_L1_ATTB)) attb_phase(F);
                SEAM(PH_L1_ATTB);
                if (IN(PH_L1_POUT)) {
                    pg8::Gemm g{(const pg8::bf16_t*)(args.ws + WS_MIX), (const pg8::bf16_t*)(args.ws + WS_WPOUT), M, D, D}; pg8::StaticOrder S; S.init(M, D, F.G, F.bx);
                    pg8::EpiRes E{F.out, F.out, (pg8::bf16_t*)(args.ws + WS_XB), (const float*)(args.ws + WS_BPOUT), (float*)(args.ws + WS_SSQ)};
                    pg8::gemm_phase<pg8::EpiRes, pg8::StaticOrder, false, true>(F.lds + RING_OFF, g, S, E);
                }
                SEAM(PH_L1_POUT);
            }
        }
    }
    if (IN(PH_FINAL)) final_phase(F);
#undef IN
#undef SEAM
}

extern "C" void kernel_launch(void* const* d_in, const int* in_sizes, int n_in, void* d_out, int out_size, void* d_ws, size_t ws_size, hipStream_t stream) {
    static int grid = 0;
    if (grid == 0) {
        if (n_in != 22 || in_sizes[0] != M * D || out_size != M * D || ws_size < WS_END) { fprintf(stderr, "kernel_launch: unexpected shapes/workspace (n_in %d, ws %zu < %zu); nothing launched\n", n_in, ws_size, (size_t)WS_END); grid = -1; return; }
        int dev = 0, cus = 0;
        if (hipGetDevice(&dev) != hipSuccess || hipDeviceGetAttribute(&cus, hipDeviceAttributeMultiprocessorCount, dev) != hipSuccess) { grid = -1; return; }
        if (hipFuncSetAttribute((const void*)skel_fwd, hipFuncAttributeMaxDynamicSharedMemorySize, LDS_BYTES) != hipSuccess) { fprintf(stderr, "kernel_launch: hipFuncSetAttribute failed\n"); grid = -1; return; }
        (void)hipGetLastError();
        grid = cus;
        if (grid != 256) fprintf(stderr, "kernel_launch: %d CUs; this kernel is laid out for 256\n", grid);
    }
    if (grid < 0) return;
    if (hipMemsetAsync((char*)d_ws + WS_CTL, 0, CTL_ZERO_BYTES, stream) != hipSuccess) return;
    Args a{};
    for (int i = 0; i < 22; ++i) a.in[i] = (const float*)d_in[i];
    a.out = (float*)d_out; a.ws = (unsigned char*)d_ws;
    for (int li = 0; li < N_LAUNCHES; ++li) {
        a.ph_lo = (N_LAUNCHES == 1) ? 0 : li; a.ph_hi = (N_LAUNCHES == 1) ? (int)NPHASE : li + 1;
        hipLaunchKernelGGL(skel_fwd, dim3(grid), dim3(NWAVES * 64), LDS_BYTES, stream, a);
        if (hipPeekAtLastError() != hipSuccess) { fprintf(stderr, "kernel_launch: launch %d failed\n", li); break; }
    }
}
```

```cpp
#include <hip/hip_runtime.h>
#include <hip/hip_bf16.h>
#include <cstdio>
#include <cstdint>
#include <cmath>

#ifndef MK_N_LAUNCHES
#define MK_N_LAUNCHES 1
#endif

constexpr int M = 16384, D = 1024, DFF = 2816, NGU = 2 * DFF, NCIN = 2560, NPIN = 2048;
constexpr int NHEAD = 8, HD = 64, MBLK = 256, NBLK = M / MBLK;
constexpr float EPS = 1e-6f;
constexpr float LOG2E = 1.4426950408889634f;
constexpr float QSCALE = 0.125f * LOG2E;

namespace pg8 {
#define PG8_LAS __attribute__((address_space(3)))
typedef unsigned short bf16_t;
typedef short bf16x8 __attribute__((ext_vector_type(8)));
typedef float f32x4 __attribute__((ext_vector_type(4)));
typedef unsigned u32x4 __attribute__((ext_vector_type(4)));
constexpr int BM = 256, BK = 64, HALF = 128, HTB = HALF * BK * 2  , STAGE_BYTES = 8 * HTB, NXCD = 8, WGM = 8;

__host__ __device__ __forceinline__ int lds_byte(int r, int c) { const int st = (r >> 4) * 2 + (c >> 5), rr = r & 15, cc = c & 31, ob = rr * 64 + cc * 2; return st * 1024 + (ob ^ (((ob >> 9) & 1) << 5)); }
__host__ __device__ __forceinline__ void stage_rc(int b, int& R, int& C) { const int st = b / 1024, sb = b % 1024, swz = sb ^ (((sb >> 9) & 1) << 5); R = (st >> 1) * 16 + swz / 64; C = (st & 1) * 32 + (swz % 64) / 2; }
__host__ __device__ __forceinline__ int perm32(int rho) { const int n = rho >> 4, i = rho & 15; return 8 * (i >> 2) + 4 * n + (i & 3); }

struct Unit { int pm, pn, idx; };
struct Gemm { const bf16_t* A; const bf16_t* Bt; int M, N, K; };

struct StaticOrder {
    int nM, nN, nwg, G, c;
    __host__ __device__ void init(int M, int N, int G_, int c_) { nM = M / BM; nN = N / BM; nwg = nM * nN; G = G_; c = c_; }
    __host__ __device__ bool next(int i, Unit& u) const {
        const long L = (long)i * G + c; if (L >= nwg) return false;
        int wgid = (int)L; { const int q = nwg / NXCD, r = nwg % NXCD, xcd = wgid % NXCD, off = wgid / NXCD; wgid = (xcd < r ? xcd * (q + 1) : r * (q + 1) + (xcd - r) * q) + off; }
        const int nig = WGM * nN, gid = wgid / nig, fm = gid * WGM, gsz = (nM - fm) < WGM ? (nM - fm) : WGM;
        u.pm = fm + ((wgid % nig) % gsz); u.pn = (wgid % nig) / gsz; u.idx = i; return true;
    }
    __device__ __forceinline__ void a_ready(const Unit&) const {}
    __device__ __forceinline__ void done(const Unit&) const {}
};

__device__ __forceinline__ unsigned cvt_pk_bf16(float lo, float hi) { unsigned r; asm volatile("v_cvt_pk_bf16_f32 %0, %1, %2" : "=v"(r) : "v"(lo), "v"(hi)); return r; }

typedef unsigned u32x2 __attribute__((ext_vector_type(2)));
constexpr int TAB_UNITS = 6;
__device__ __forceinline__ void tab_rinv(const PG8_LAS float* tab, const Unit& u, int wr, int fr, float (&rinv)[2][4]) {
#pragma unroll
    for (int ai = 0; ai < 2; ++ai)
#pragma unroll
        for (int m = 0; m < 4; ++m) rinv[ai][m] = tab[u.idx * 256 + ai * HALF + wr * 64 + m * 16 + fr];
}
__device__ __forceinline__ void tab_bias(const PG8_LAS float* tab, const Unit& u, int wc, int fq, f32x4 (&bv)[2][2]) {
#pragma unroll
    for (int bj = 0; bj < 2; ++bj)
#pragma unroll
        for (int n = 0; n < 2; ++n) bv[bj][n] = *(const PG8_LAS f32x4*)(tab + (TAB_UNITS + u.idx) * 256 + bj * HALF + wc * 32 + 8 * fq + 4 * n);
}
template <class Sched> __device__ __forceinline__ void fill_tables(PG8_LAS float* tab, const Sched& S, const float* ssq, const float* bias) {
    int tid = threadIdx.x; asm volatile("" : "+v"(tid));
    Unit u;
    for (int i = 0; i < TAB_UNITS && S.next(i, u); ++i) {
        if (tid < 256) { const int r = u.pm * BM + tid; const float s = ((ssq[r] + ssq[M + r]) + ssq[2 * M + r]) + ssq[3 * M + r]; tab[i * 256 + tid] = 1.0f / sqrtf(s * (1.0f / 1024.0f) + EPS); }
        else tab[(TAB_UNITS + i) * 256 + (tid - 256)] = bias[u.pn * BM + (tid - 256)];
    }
    __syncthreads();
}
__device__ __forceinline__ float sigm(float z) { return __builtin_amdgcn_rcpf(1.0f + __builtin_amdgcn_exp2f(-LOG2E * z)); }
__device__ __forceinline__ u32x4 pack8(const f32x4 a, const f32x4 b) { u32x4 w; w.x = cvt_pk_bf16(a[0], a[1]); w.y = cvt_pk_bf16(a[2], a[3]); w.z = cvt_pk_bf16(b[0], b[1]); w.w = cvt_pk_bf16(b[2], b[3]); return w; }

struct EpiGU {
    static constexpr bool PERM = true, AFTER_DRAIN = false, INIT_ACC = false;
    bf16_t* O; const PG8_LAS float* tab;
    __device__ __forceinline__ void operator()(const f32x4 (&acc)[2][2][4][2], const Unit& u, int wr, int wc, int fr, int fq) const {
        asm volatile("" : "+v"(fr), "+v"(fq));
        const int row0 = u.pm * BM + wr * 64 + fr, bcol0 = u.pn * BM + wc * 32 + 8 * fq, ocol0 = u.pn * HALF + wc * 32 + 8 * fq;
        f32x4 bv[2][2]; tab_bias(tab, u, wc, fq, bv);
        float rinv[2][4]; tab_rinv(tab, u, wr, fr, rinv);
#pragma unroll
        for (int ai = 0; ai < 2; ++ai)
#pragma unroll
            for (int m = 0; m < 4; ++m) { const float ri = rinv[ai][m]; bf16_t* rowp = O + (size_t)(row0 + ai * HALF + m * 16) * DFF + ocol0;
                f32x4 hv[2];
#pragma unroll
                for (int n = 0; n < 2; ++n) { const f32x4 g = acc[ai][0][m][n] * ri + bv[0][n], up = acc[ai][1][m][n] * ri + bv[1][n];
#pragma unroll
                    for (int e = 0; e < 4; ++e) hv[n][e] = g[e] * up[e] * sigm(g[e]); }
                *(u32x4*)rowp = pack8(hv[0], hv[1]);
                if (m & 1) asm volatile("" ::: "memory"); }
    }
};
struct EpiCin {
    static constexpr bool PERM = true, AFTER_DRAIN = false, INIT_ACC = false;
    bf16_t* O; const PG8_LAS float* tab;
    template <int KIND> __device__ __forceinline__ void run(const f32x4 (&acc)[2][2][4][2], const f32x4 (&bv)[2][2], const float (&rinv)[2][4], bf16_t* base) const {
#pragma unroll
        for (int ai = 0; ai < 2; ++ai)
#pragma unroll
            for (int m = 0; m < 4; ++m) { const float ri = rinv[ai][m]; bf16_t* rowp = base + (size_t)(ai * HALF + m * 16) * 1536;
                f32x4 z0[2], z1[2];
#pragma unroll
                for (int n = 0; n < 2; ++n) { z0[n] = acc[ai][0][m][n] * ri + bv[0][n]; z1[n] = acc[ai][1][m][n] * ri + bv[1][n]; }
                if (KIND == 2) { *(u32x4*)rowp = pack8(z0[0], z0[1]); *(u32x4*)(rowp + HALF) = pack8(z1[0], z1[1]); }
                else { f32x4 o[2];
#pragma unroll
                    for (int n = 0; n < 2; ++n)
#pragma unroll
                        for (int e = 0; e < 4; ++e) o[n][e] = KIND == 0 ? z0[n][e] * sigm(z1[n][e]) : z0[n][e] * z1[n][e];
                    *(u32x4*)rowp = pack8(o[0], o[1]); }
                asm volatile("" ::: "memory"); }
    }
    __device__ __forceinline__ void operator()(const f32x4 (&acc)[2][2][4][2], const Unit& u, int wr, int wc, int fr, int fq) const {
        asm volatile("" : "+v"(fr), "+v"(fq));
        const int row0 = u.pm * BM + wr * 64 + fr, bcol0 = u.pn * BM + wc * 32 + 8 * fq;
        f32x4 bv[2][2]; tab_bias(tab, u, wc, fq, bv);
        float rinv[2][4]; tab_rinv(tab, u, wr, fr, rinv);
        const int ocol0 = (u.pn >= 8 ? 1024 + 256 * (u.pn - 8) : 128 * u.pn) + wc * 32 + 8 * fq;
        bf16_t* base = O + (size_t)row0 * 1536 + ocol0;
        if (u.pn < 4) run<0>(acc, bv, rinv, base); else if (u.pn < 8) run<1>(acc, bv, rinv, base); else run<2>(acc, bv, rinv, base);
    }
};
struct EpiPin {
    static constexpr bool PERM = true, AFTER_DRAIN = false, INIT_ACC = false;
    bf16_t* O; const PG8_LAS float* tab;
    __device__ __forceinline__ void operator()(const f32x4 (&acc)[2][2][4][2], const Unit& u, int wr, int wc, int fr, int fq) const {
        asm volatile("" : "+v"(fr), "+v"(fq));
        const int row0 = u.pm * BM + wr * 64 + fr, bcol0 = u.pn * BM + wc * 32 + 8 * fq;
        f32x4 bv[2][2]; tab_bias(tab, u, wc, fq, bv);
        float rinv[2][4]; tab_rinv(tab, u, wr, fr, rinv);
        const int t = u.pn >> 1; const int slot = t == 0 ? 3 : t - 1;
        const float sc = t == 1 ? QSCALE : 1.0f;
        bf16_t* base = O + (size_t)slot * ((size_t)M * 512) + (size_t)row0 * 512 + 256 * (u.pn & 1) + wc * 32 + 8 * fq;
#pragma unroll
        for (int ai = 0; ai < 2; ++ai)
#pragma unroll
            for (int m = 0; m < 4; ++m) { const float ri = rinv[ai][m] * sc; bf16_t* rowp = base + (size_t)(ai * HALF + m * 16) * 512;
#pragma unroll
                for (int bj = 0; bj < 2; ++bj) { const f32x4 z0 = acc[ai][bj][m][0] * ri + bv[bj][0] * sc, z1 = acc[ai][bj][m][1] * ri + bv[bj][1] * sc;
                    *(u32x4*)(rowp + bj * HALF) = pack8(z0, z1); }
                asm volatile("" ::: "memory"); }
    }
};
struct EpiRes {
    static constexpr bool PERM = false, AFTER_DRAIN = true, INIT_ACC = true;
    const float* xin; float* xout; bf16_t* xb; const float* bias; float* ssq;
    __device__ __forceinline__ void init(f32x4 (&acc)[2][2][4][2], const Unit& u, int wr, int wc, int fr, int fq) const {
        const int col0 = u.pn * BM + wc * 32 + 4 * fq;
#pragma unroll
        for (int ai = 0; ai < 2; ++ai)
#pragma unroll
            for (int m = 0; m < 4; ++m) { const size_t off = (size_t)(u.pm * BM + ai * HALF + wr * 64 + m * 16 + fr) * D + col0;
#pragma unroll
                for (int bj = 0; bj < 2; ++bj)
#pragma unroll
                    for (int n = 0; n < 2; ++n) acc[ai][bj][m][n] = *(const f32x4*)(xin + off + bj * HALF + n * 16); }
        if (bias) {
#pragma unroll
            for (int bj = 0; bj < 2; ++bj)
#pragma unroll
                for (int n = 0; n < 2; ++n) { const f32x4 bv = *(const f32x4*)(bias + col0 + bj * HALF + n * 16);
#pragma unroll
                    for (int ai = 0; ai < 2; ++ai)
#pragma unroll
                        for (int m = 0; m < 4; ++m) acc[ai][bj][m][n] += bv; }
        }
    }
    __device__ __forceinline__ void fused(f32x4 (&acc)[2][2][4][2], const Unit& u, int wr, int wc, int fr, int fq, PG8_LAS unsigned char* lds, int wid, int lane) const {
        PG8_LAS float* P = (PG8_LAS float*)lds;
        asm volatile("" : "+v"(fr), "+v"(fq));
        const int col0 = u.pn * BM + wc * 32 + 4 * fq;
#pragma unroll
        for (int ai = 0; ai < 2; ++ai)
#pragma unroll
            for (int m = 0; m < 4; ++m) { const int rt = ai * HALF + wr * 64 + m * 16 + fr; const size_t off = (size_t)(u.pm * BM + rt) * D + col0; float ss = 0.f;
#pragma unroll
                for (int bj = 0; bj < 2; ++bj)
#pragma unroll
                    for (int n = 0; n < 2; ++n) { const int c = bj * HALF + n * 16; const f32x4 v = acc[ai][bj][m][n];
                        *(f32x4*)(xout + off + c) = v; ss += (v[0] * v[0] + v[1] * v[1]) + (v[2] * v[2] + v[3] * v[3]);
                        u32x2 w; w.x = cvt_pk_bf16(v[0], v[1]); w.y = cvt_pk_bf16(v[2], v[3]); *(u32x2*)(xb + off + c) = w; }
                ss += __shfl_xor(ss, 16); ss += __shfl_xor(ss, 32);
                if (fq == 0) P[rt * 4 + wc] = ss; }
        asm volatile("s_waitcnt lgkmcnt(0)" ::: "memory"); __builtin_amdgcn_s_barrier(); asm volatile("" ::: "memory");
        const int tid = wid * 64 + lane;
        if (tid < 256) { const float s = ((P[tid * 4 + 0] + P[tid * 4 + 1]) + P[tid * 4 + 2]) + P[tid * 4 + 3]; ssq[(size_t)u.pn * M + u.pm * BM + tid] = s; }
        asm volatile("s_waitcnt lgkmcnt(0)" ::: "memory"); __builtin_amdgcn_s_barrier(); asm volatile("" ::: "memory");
    }
};

template <class Epi, class Sched, bool ALIGN_EPI = false, bool SP2 = false>
__device__ __forceinline__ void gemm_phase(PG8_LAS unsigned char* lds, const Gemm g, const Sched& S, const Epi& E) {
    int tid = threadIdx.x; asm volatile("" : "+v"(tid));
    const int wid = __builtin_amdgcn_readfirstlane(tid >> 6), lane = tid & 63, wr = wid >> 2, wc = wid & 3, fr = lane & 15, fq = lane >> 4;
    const int K = g.K, nt = K / BK;
    unsigned voffA[2], voffB[2];
#pragma unroll
    for (int i = 0; i < 2; ++i) { int R, C; stage_rc(tid * 16 + i * 8192, R, C); const int Rb = Epi::PERM ? ((R & ~31) + perm32(R & 31)) : R;
        voffA[i] = (unsigned)(R * K + C) * 2u; voffB[i] = (unsigned)(Rb * K + C) * 2u; }
    const size_t kstep = (size_t)(BK * 2);
    const size_t hstep = (size_t)HALF * K * 2;
    const size_t tstep = 2 * hstep;
    const unsigned ldsw = (unsigned)wid * 1024u;
    const int aoff = lds_byte(wr * 64 + fr, fq * 8), boff = lds_byte(wc * 32 + fr, fq * 8);
#define PG8_SA(b, h) (((b) * 2 + (h)) * HTB)
#define PG8_SB(b, h) ((4 + (b) * 2 + (h)) * HTB)
#define PG8_STAGE(bufoff, gbase, voff) do { _Pragma("unroll") for (int _i = 0; _i < 2; ++_i) \
        __builtin_amdgcn_global_load_lds((const unsigned*)((const char*)(gbase) + (voff)[_i]), (PG8_LAS unsigned*)(lds + (bufoff) + ldsw + _i * 8192), 16, 0, 0); } while (0)
#define PG8_LDA(dst, b, h) do { _Pragma("unroll") for (int m = 0; m < 4; ++m) _Pragma("unroll") for (int k = 0; k < 2; ++k) dst[m][k] = *(const PG8_LAS bf16x8*)(lds + PG8_SA(b, h) + aoff + m * 2048 + k * 1024); } while (0)
#define PG8_LDB(dst, b, h) do { _Pragma("unroll") for (int n = 0; n < 2; ++n) _Pragma("unroll") for (int k = 0; k < 2; ++k) dst[n][k] = *(const PG8_LAS bf16x8*)(lds + PG8_SB(b, h) + boff + n * 2048 + k * 1024); } while (0)
#define PG8_MMA(ai, bj, At, Bt) do { __builtin_amdgcn_s_setprio(1); _Pragma("unroll") for (int m = 0; m < 4; ++m) _Pragma("unroll") for (int n = 0; n < 2; ++n) _Pragma("unroll") for (int k = 0; k < 2; ++k) \
        acc[ai][bj][m][n] = __builtin_amdgcn_mfma_f32_16x16x32_bf16(Bt[n][k], At[m][k], acc[ai][bj][m][n], 0, 0, 0); __builtin_amdgcn_s_setprio(0); } while (0)
#define PG8_WAIT_V(n) asm volatile("s_waitcnt vmcnt(" #n ")" ::: "memory")
#define PG8_WAIT_L(n) asm volatile("s_waitcnt lgkmcnt(" #n ")" ::: "memory")
#define PG8_BAR __builtin_amdgcn_s_barrier()
#define PG8_SCHED __builtin_amdgcn_sched_barrier(0)
    Unit cur, nxt; int ui = 0;
    if (!S.next(0, cur)) return;
    f32x4 acc[2][2][4][2];
    if constexpr (Epi::INIT_ACC) { E.init(acc, cur, wr, wc, fr, fq); }
    else {
#pragma unroll
    for (int a = 0; a < 2; ++a)
#pragma unroll
        for (int b = 0; b < 2; ++b)
#pragma unroll
            for (int m = 0; m < 4; ++m)
#pragma unroll
                for (int n = 0; n < 2; ++n) acc[a][b][m][n] = (f32x4){0.f, 0.f, 0.f, 0.f};
    }
    bf16x8 At[4][2], B0[2][2], B1[2][2];
    const char* cA = (const char*)g.A + (size_t)cur.pm * tstep; const char* cB = (const char*)g.Bt + (size_t)cur.pn * tstep;
    S.a_ready(cur);
    if constexpr (SP2) {
        PG8_STAGE(PG8_SB(0, 0), cB, voffB); PG8_STAGE(PG8_SB(0, 1), cB + hstep, voffB); PG8_STAGE(PG8_SA(0, 0), cA, voffA); PG8_STAGE(PG8_SA(0, 1), cA + hstep, voffA);
        if (wr == 1) PG8_BAR;
        PG8_WAIT_V(2); PG8_BAR;
        PG8_STAGE(PG8_SB(1, 0), cB + kstep, voffB); PG8_STAGE(PG8_SA(1, 0), cA + kstep, voffA); PG8_STAGE(PG8_SB(1, 1), cB + hstep + kstep, voffB);
        PG8_WAIT_V(6); PG8_BAR;
    } else {
        PG8_STAGE(PG8_SB(0, 0), cB, voffB); PG8_STAGE(PG8_SA(0, 0), cA, voffA); PG8_STAGE(PG8_SB(0, 1), cB + hstep, voffB); PG8_STAGE(PG8_SA(0, 1), cA + hstep, voffA);
        if (wr == 1) PG8_BAR;
        PG8_WAIT_V(4); PG8_BAR;
        PG8_STAGE(PG8_SB(1, 0), cB + kstep, voffB); PG8_STAGE(PG8_SA(1, 0), cA + kstep, voffA); PG8_STAGE(PG8_SB(1, 1), cB + hstep + kstep, voffB);
        PG8_WAIT_V(6); PG8_BAR;
    }
    for (;;) {
        const bool has_next = S.next(ui + 1, nxt);
        const char* nA = has_next ? (const char*)g.A + (size_t)nxt.pm * tstep : cA; const char* nB = has_next ? (const char*)g.Bt + (size_t)nxt.pn * tstep : cB;
#if defined(PROBE_KREP)
        const int ntr = Epi::INIT_ACC ? nt : nt * PROBE_KREP;
        for (int tq = 0; tq < ntr; tq += 2) {
            const int t = tq % nt;
            const bool last = (tq == ntr - 2);
            const char* a1 = cA + (size_t)(t + 1) * kstep;
            const char* a2 = last ? nA : cA + (size_t)((t + 2) % nt) * kstep; const char* b2 = last ? nB : cB + (size_t)((t + 2) % nt) * kstep;
#else
        for (int t = 0; t < nt; t += 2) {
            const bool last = (t == nt - 2);
            const char* a1 = cA + (size_t)(t + 1) * kstep;
            const char* a2 = last ? nA : cA + (size_t)(t + 2) * kstep; const char* b2 = last ? nB : cB + (size_t)(t + 2) * kstep;
#endif
            const char* a3 = a2 + kstep; const char* b3 = b2 + kstep;
            if (last && has_next) S.a_ready(nxt);
            if constexpr (SP2) {
            PG8_LDB(B0, 0, 0); PG8_LDB(B1, 0, 1); PG8_SCHED; PG8_LDA(At, 0, 0); PG8_STAGE(PG8_SA(1, 1), a1 + hstep, voffA);
            PG8_WAIT_V(8); PG8_WAIT_L(0); PG8_BAR; PG8_MMA(0, 0, At, B0); PG8_MMA(0, 1, At, B1); PG8_BAR; PG8_SCHED;
            PG8_LDA(At, 0, 1); PG8_STAGE(PG8_SB(0, 0), b2, voffB); PG8_STAGE(PG8_SB(0, 1), b2 + hstep, voffB); PG8_STAGE(PG8_SA(0, 0), a2, voffA);
            PG8_WAIT_V(8); PG8_WAIT_L(0); PG8_BAR; PG8_MMA(1, 0, At, B0); PG8_MMA(1, 1, At, B1); PG8_BAR; PG8_SCHED;
            PG8_LDB(B0, 1, 0); PG8_LDB(B1, 1, 1); PG8_SCHED; PG8_LDA(At, 1, 0); PG8_STAGE(PG8_SA(0, 1), a2 + hstep, voffA);
            PG8_WAIT_V(8); PG8_WAIT_L(0); PG8_BAR; PG8_MMA(0, 0, At, B0); PG8_MMA(0, 1, At, B1); PG8_BAR; PG8_SCHED;
            PG8_LDA(At, 1, 1); PG8_STAGE(PG8_SB(1, 0), b3, voffB); PG8_STAGE(PG8_SB(1, 1), b3 + hstep, voffB); PG8_STAGE(PG8_SA(1, 0), a3, voffA);
            PG8_WAIT_V(8); PG8_WAIT_L(0); PG8_BAR; PG8_MMA(1, 0, At, B0); PG8_MMA(1, 1, At, B1); PG8_BAR; PG8_SCHED;
            } else {
            PG8_LDB(B0, 0, 0); PG8_SCHED; PG8_LDA(At, 0, 0); PG8_STAGE(PG8_SA(1, 1), a1 + hstep, voffA);
            PG8_WAIT_L(8); PG8_BAR; PG8_WAIT_L(0); PG8_MMA(0, 0, At, B0); PG8_BAR; PG8_SCHED;
            PG8_LDB(B1, 0, 1); PG8_STAGE(PG8_SB(0, 0), b2, voffB);
            PG8_BAR; PG8_WAIT_L(0); PG8_MMA(0, 1, At, B1); PG8_BAR;
            PG8_LDA(At, 0, 1); PG8_STAGE(PG8_SA(0, 0), a2, voffA);
            PG8_BAR; PG8_WAIT_L(0); PG8_MMA(1, 0, At, B0); PG8_BAR; PG8_SCHED;
            PG8_STAGE(PG8_SB(0, 1), b2 + hstep, voffB);
            PG8_WAIT_V(6); PG8_BAR; PG8_MMA(1, 1, At, B1); PG8_BAR;
            PG8_LDB(B0, 1, 0); PG8_SCHED; PG8_LDA(At, 1, 0); PG8_STAGE(PG8_SA(0, 1), a2 + hstep, voffA);
            PG8_WAIT_L(8); PG8_BAR; PG8_WAIT_L(0); PG8_MMA(0, 0, At, B0); PG8_BAR; PG8_SCHED;
            PG8_LDB(B1, 1, 1); PG8_STAGE(PG8_SB(1, 0), b3, voffB);
            PG8_BAR; PG8_WAIT_L(0); PG8_MMA(0, 1, At, B1); PG8_BAR;
            PG8_LDA(At, 1, 1); PG8_STAGE(PG8_SA(1, 0), a3, voffA);
            PG8_BAR; PG8_WAIT_L(0); PG8_MMA(1, 0, At, B0); PG8_BAR; PG8_SCHED;
            PG8_STAGE(PG8_SB(1, 1), b3 + hstep, voffB);
            PG8_WAIT_V(6); PG8_BAR; PG8_MMA(1, 1, At, B1); PG8_BAR;
            }
        }
        if constexpr (ALIGN_EPI) { if (wr == 0) PG8_BAR; }
#if defined(PROBE_KREP)
        if constexpr (!Epi::INIT_ACC) {
#pragma unroll
            for (int a = 0; a < 2; ++a)
#pragma unroll
                for (int b = 0; b < 2; ++b)
#pragma unroll
                    for (int m = 0; m < 4; ++m)
#pragma unroll
                        for (int n = 0; n < 2; ++n) acc[a][b][m][n] = acc[a][b][m][n] * (1.0f / PROBE_KREP); }
#endif
        if constexpr (!Epi::AFTER_DRAIN) { E(acc, cur, wr, wc, fr, fq); S.done(cur);
#ifdef PROBE_EPI2
            for (int pe_ = 0; pe_ < PROBE_EPI2; ++pe_) { asm volatile("" ::: "memory"); E(acc, cur, wr, wc, fr, fq); }
#endif
        }
        if (!has_next) break;
#pragma unroll
        for (int a = 0; a < 2; ++a)
#pragma unroll
            for (int b = 0; b < 2; ++b)
#pragma unroll
                for (int m = 0; m < 4; ++m)
#pragma unroll
                    for (int n = 0; n < 2; ++n) acc[a][b][m][n] = (f32x4){0.f, 0.f, 0.f, 0.f};
        cur = nxt; cA = nA; cB = nB; ++ui;
        if constexpr (ALIGN_EPI) { if (wr == 1) PG8_BAR; }
    }
    PG8_WAIT_V(0);
    if constexpr (!ALIGN_EPI) { if (wr == 0) PG8_BAR; }
    PG8_BAR;
    if constexpr (Epi::AFTER_DRAIN) { E.fused(acc, cur, wr, wc, fr, fq, lds, wid, lane); S.done(cur); }
#undef PG8_SA
#undef PG8_SB
#undef PG8_STAGE
#undef PG8_LDA
#undef PG8_LDB
#undef PG8_MMA
#undef PG8_WAIT_V
#undef PG8_WAIT_L
#undef PG8_BAR
#undef PG8_SCHED
}
}
#define GAS __attribute__((address_space(1)))
#define LAS __attribute__((address_space(3)))
typedef unsigned short bf16;
typedef unsigned v4u __attribute__((ext_vector_type(4)));
typedef float f32x4 __attribute__((ext_vector_type(4)));
typedef short bf16x8 __attribute__((ext_vector_type(8)));
typedef GAS unsigned gu32;
typedef GAS unsigned long long gu64;
#define RLX_AGENT __ATOMIC_RELAXED, __HIP_MEMORY_SCOPE_AGENT
#define LDS_WAIT() asm volatile("s_waitcnt lgkmcnt(0)" ::: "memory")
#define VM_WAIT() asm volatile("s_waitcnt vmcnt(0)" ::: "memory")
__device__ __forceinline__ unsigned long long rt() { return __builtin_amdgcn_s_memrealtime(); }
__device__ __forceinline__ unsigned f2bf(float f) { unsigned u = __builtin_bit_cast(unsigned, f); return (u + 0x7fffu + ((u >> 16) & 1u)) >> 16; }
__device__ __forceinline__ unsigned pk2(float lo, float hi) { return f2bf(lo) | (f2bf(hi) << 16); }

#define XB_TMO      128
#define XB_XCNT(j)  (256  + 64 * (j))
#define XB_XSUB(j)  (1280 + 64 * (j))
#define XB_XGEN(j)  (2304 + 64 * (j))
#define XB_TOP      3328
#define XB_TOPGEN   3392
#define XCD_BAR_WORDS 3456
#define XB_SPIN_CAP (1u << 18)

__device__ __forceinline__ unsigned xb_ld(unsigned* p)              { return __hip_atomic_load(p, __ATOMIC_RELAXED, __HIP_MEMORY_SCOPE_AGENT); }
__device__ __forceinline__ unsigned xb_add(unsigned* p, unsigned v) { return __hip_atomic_fetch_add(p, v, __ATOMIC_RELAXED, __HIP_MEMORY_SCOPE_AGENT); }
__device__ __forceinline__ unsigned xb_xcc_id() { return (unsigned)__builtin_amdgcn_s_getreg((3 << 11) | 20) & 0xFu; }
#define XB_SPIN(cond, bar) do { unsigned _sp = 0; while (cond) { __builtin_amdgcn_s_sleep(1); \
    if ((++_sp & 255u) == 0u) { if (xb_ld(&(bar)[XB_TMO])) break; if (_sp > XB_SPIN_CAP) { atomicAdd(&(bar)[XB_TMO], 1u); break; } } } } while (0)

struct XcdBarrier {
    unsigned* bar; unsigned x;
    volatile LAS unsigned* st;
};

__device__ __forceinline__ XcdBarrier xcd_barrier_post(unsigned* bar, volatile LAS unsigned* st) {
    XcdBarrier b; b.bar = bar; b.x = xb_xcc_id(); b.st = st;
    if (threadIdx.x == 0) st[2] = xb_add(&bar[XB_XCNT(b.x)], 1u);
    return b;
}
__device__ __forceinline__ void xcd_barrier_complete(unsigned* bar, unsigned x, unsigned& nloc, unsigned& nx) {
    const unsigned G = gridDim.x * gridDim.y * gridDim.z;
    unsigned sum, cnt, mine, sp = 0u;
    for (;;) {
        sum = 0u; cnt = 0u; mine = 0u;
#pragma unroll
        for (unsigned j = 0; j < 16; ++j) { const unsigned c = xb_ld(&bar[XB_XCNT(j)]); sum += c; cnt += (c > 0u) ? 1u : 0u; mine = (j == x) ? c : mine; }
        if (sum == G) break;
        __builtin_amdgcn_s_sleep(1);
        if ((++sp & 255u) == 0u) { if (xb_ld(&bar[XB_TMO])) break; if (sp > XB_SPIN_CAP) { atomicAdd(&bar[XB_TMO], 1u); break; } }
    }
    nloc = mine > 0u ? mine : 1u; nx = cnt > 0u ? cnt : 1u;
}

__device__ __forceinline__ void xcd_barrier(const XcdBarrier& b) {
    asm volatile("s_waitcnt vmcnt(0)" ::: "memory");
    __syncthreads();
    if (threadIdx.x == 0) {
        unsigned* bar = b.bar;
        __builtin_amdgcn_s_waitcnt(0);
        unsigned nloc = b.st[0], nx = b.st[1];
        if (nloc == 0u) { xcd_barrier_complete(bar, b.x, nloc, nx); b.st[0] = nloc; b.st[1] = nx; }
        const unsigned old = xb_add(&bar[XB_XSUB(b.x)], 1u);
        const unsigned gen = old / nloc;
        if (old + 1u == (gen + 1u) * nloc) {
            __builtin_amdgcn_fence(__ATOMIC_RELEASE, "agent");
            asm volatile("s_waitcnt vmcnt(0)" ::: "memory");
            const unsigned og = xb_add(&bar[XB_TOP], 1u);
            const unsigned tg = og / nx;
            if (og + 1u == (tg + 1u) * nx) xb_add(&bar[XB_TOPGEN], 1u);
            else XB_SPIN(xb_ld(&bar[XB_TOPGEN]) == tg, bar);
            __builtin_amdgcn_fence(__ATOMIC_ACQUIRE, "agent");
            xb_add(&bar[XB_XGEN(b.x)], 1u);
            asm volatile("s_waitcnt vmcnt(0)" ::: "memory");
        } else {
            XB_SPIN(xb_ld(&bar[XB_XGEN(b.x)]) == gen, bar);
            __builtin_amdgcn_fence(__ATOMIC_ACQUIRE, "agent");
            asm volatile("s_waitcnt vmcnt(0)" ::: "memory");
        }
    }
    __syncthreads();
}

constexpr size_t MiB = 1u << 20;
constexpr size_t WS_CTL = 0, CTL_ZERO_BYTES = 1 * MiB;
constexpr size_t WS_MOD = 1 * MiB;
constexpr size_t WS_BGU = WS_MOD + 128 * 1024;
constexpr size_t WS_BCIN = WS_MOD + 256 * 1024;
constexpr size_t WS_BPIN = WS_MOD + 272 * 1024;
constexpr size_t WS_BEFF = WS_MOD + 288 * 1024;
constexpr size_t WS_BPOUT = WS_MOD + 296 * 1024;
constexpr size_t WS_KMEAN = WS_MOD + 512 * 1024;
constexpr size_t WS_SSQ = 2 * MiB;
constexpr size_t WS_ML = 3 * MiB;
constexpr size_t WS_WEFF = 6 * MiB;
constexpr size_t WS_WGU = 8 * MiB;
constexpr size_t WS_WDN = 52 * MiB;
constexpr size_t WS_WCIN = 74 * MiB, WS_WCOUT = 79 * MiB, WS_WPIN = 81 * MiB, WS_WPOUT = 85 * MiB;
constexpr size_t WS_XB = 88 * MiB;
constexpr size_t WS_R1 = 120 * MiB;
constexpr size_t WS_Q = WS_R1, WS_K = WS_R1 + 16 * MiB, WS_V = WS_R1 + 32 * MiB, WS_U = WS_R1 + 48 * MiB, WS_LIST = WS_R1 + 64 * MiB;
constexpr size_t WS_MIX = 208 * MiB;
constexpr size_t WS_PO = 240 * MiB;
constexpr size_t WS_END = 288 * MiB;
constexpr int LIST_PER_HEAD = 256 * 2016;
static_assert(WS_R1 + (size_t)M * DFF * 2 <= WS_MIX && WS_LIST + (size_t)8 * LIST_PER_HEAD * 4 <= WS_MIX && WS_PO + (size_t)3 * M * 512 * 2 <= WS_END, "d_ws map");
constexpr int CW_TMO = 0, CW_CODE = 1, CW_BAR = 4096, CW_CUR = 8192, CUR_STRIDE = 16;

constexpr int RING_OFF = 0, RING_BYTES = 131072;
constexpr int LDSCTL_OFF = RING_BYTES, MISC_OFF = LDSCTL_OFF + 320;
constexpr int TAB_OFF = LDSCTL_OFF + 1024;
constexpr int LDS_BYTES = 147456;
static_assert(TAB_OFF + 2 * 6 * 256 * 4 <= LDS_BYTES, "LDS map");

enum Phase { PH_P0 = 0, PH_P1, PH_L0_GU1, PH_L0_DN1, PH_L0_CIN, PH_L0_CONV, PH_L0_COUT, PH_L0_GU2, PH_L0_DN2,
             PH_L1_GU1, PH_L1_DN1, PH_L1_PIN, PH_L1_PRE, PH_L1_SEL, PH_L1_ATTA, PH_L1_ATTB, PH_L1_POUT, PH_L1_GU2, PH_L1_DN2, PH_FINAL, NPHASE };
constexpr int NWAVES = 8;
constexpr int N_LAUNCHES = MK_N_LAUNCHES;

struct Frame {
    LAS unsigned char* lds;
    volatile LAS unsigned* MISC;
    gu32* ctl;
    int tid, lane, wave, G, bx;
    float* out;
    unsigned char* ws;
};
enum InIdx { IN_X = 0, IN_C, IN_ADA_W, IN_ADA_B, IN_FFN_NORM, IN_W_GATE, IN_W_UP, IN_W_DOWN, IN_MIX_NORM, IN_CONV_W_IN, IN_CONV_A_W, IN_CONV_A_B, IN_LN_A_G, IN_LN_A_B, IN_CONV_B_W,
             IN_CONV_W_OUT, IN_PM_W_IN, IN_POOL_W, IN_POOL_B, IN_POOL_SCALE, IN_PM_W_OUT, IN_FINAL_NORM };
typedef __attribute__((address_space(4))) const unsigned char* kptr_t;
__device__ __forceinline__ const float* inptr(int i) {
    kptr_t p = (kptr_t)__builtin_amdgcn_kernarg_segment_ptr(); asm volatile("" : "+s"(p));
    return *(const float* const __attribute__((address_space(4)))*)(p + 8 * i);
}
#define WSP(T, off) ((T*)(F.ws + (off)))

__device__ __forceinline__ float wave_sum(float v) {
#pragma unroll
    for (int o = 1; o < 64; o <<= 1) v += __shfl_xor(v, o);
    return v;
}
__device__ __forceinline__ float bf2f(unsigned h) { return __uint_as_float(h << 16); }
__device__ __forceinline__ void wg_sync() { __syncthreads(); }

__device__ __forceinline__ void p0_phase(Frame& F) {
    LAS float* sm = (LAS float*)F.lds;
    LAS float* red = sm + 1024;
    const float* cvec = inptr(IN_C); const float* ada_w = inptr(IN_ADA_W); const float* ada_b = inptr(IN_ADA_B);
    for (int k = F.tid; k < 1024; k += NWAVES * 64) { const float v = cvec[k]; sm[k] = v / (1.0f + expf(-v)); }
    wg_sync();
    for (int wg = F.bx; wg < 256; wg += F.G) {
        const int layer = wg >> 7, cbase = (wg & 127) * 72;
        const float* W = ada_w + (size_t)layer * 1024 * 9216 + cbase;
        const int rr = F.lane / 18, cc = F.lane - rr * 18;
        f32x4 acc = {0.f, 0.f, 0.f, 0.f};
        if (rr < 3) {
            const int kb = 128 * F.wave;
#pragma unroll 8
            for (int it = 0; it < 43; ++it) { const int kk = 3 * it + rr; if (kk < 128) { const int k = kb + kk; const f32x4 w = *(const f32x4*)(W + (size_t)k * 9216 + 4 * cc); acc += w * sm[k]; } }
#pragma unroll
            for (int e = 0; e < 4; ++e) red[(F.wave * 3 + rr) * 72 + 4 * cc + e] = acc[e];
        }
        wg_sync();
        if (F.tid < 72) { float s = ada_b[layer * 9216 + cbase + F.tid];
            for (int j = 0; j < 24; ++j) s += red[j * 72 + F.tid];
            WSP(float, WS_MOD)[layer * 9216 + cbase + F.tid] = s; }
        wg_sync();
    }
    { const int gw = F.bx * NWAVES + F.wave, NGW = F.G * NWAVES; bf16* XB = WSP(bf16, WS_XB); float* SSQ = WSP(float, WS_SSQ); const float* xin = inptr(IN_X);
      for (int m = gw; m < M; m += NGW) {
          const f32x4* xr = (const f32x4*)(xin + (size_t)m * D) + F.lane; f32x4 v[4]; float s = 0.f;
#pragma unroll
          for (int j = 0; j < 4; ++j) { v[j] = xr[64 * j]; s += (v[j][0] * v[j][0] + v[j][1] * v[j][1]) + (v[j][2] * v[j][2] + v[j][3] * v[j][3]); }
          s = wave_sum(s);
          unsigned long long* o8 = (unsigned long long*)(XB + (size_t)m * D) + F.lane;
#pragma unroll
          for (int j = 0; j < 4; ++j) o8[64 * j] = (unsigned long long)pk2(v[j][0], v[j][1]) | ((unsigned long long)pk2(v[j][2], v[j][3]) << 32);
          if (F.lane < 4) SSQ[(size_t)F.lane * M + m] = F.lane == 0 ? s : 0.f;
      } }
    const float* pool_w = inptr(IN_POOL_W); const float* pool_scale = inptr(IN_POOL_SCALE); const float* pm_w_out = inptr(IN_PM_W_OUT); const float* pool_b = inptr(IN_POOL_B);
    for (int gid = F.bx * NWAVES * 64 + F.tid; gid < 512 * 256; gid += F.G * NWAVES * 64) {
        const int krow = gid >> 8, n4 = (gid & 255) * 4, g = krow >> 7;
        const float* pw = pool_w + (size_t)krow * 128; const float* ps = pool_scale + g * 128; const float* wo = pm_w_out + (size_t)(g * 128) * 1024 + n4;
        f32x4 acc = {0.f, 0.f, 0.f, 0.f};
#pragma unroll 8
        for (int d = 0; d < 128; ++d) { const float a = pw[d] * ps[d]; acc += *(const f32x4*)(wo + (size_t)d * 1024) * a; }
        *(f32x4*)(WSP(float, WS_WEFF) + (size_t)krow * 1024 + n4) = acc;
    }
    for (int n = F.bx * NWAVES * 64 + F.tid; n < 1024; n += F.G * NWAVES * 64) {
        float s = 0.f;
        for (int k = 0; k < 512; ++k) s += pool_b[k] * pool_scale[k] * pm_w_out[(size_t)k * 1024 + n];
        WSP(float, WS_BEFF)[n] = s;
    }
}

__device__ __forceinline__ void prep_strip(Frame& F, const float* src, int ldn, const float* src2, int ksplit, int kbeg, int ktiles,
                                           bf16* dst, int ldk, bool useG, const LAS float* Gs, const LAS float* Ss, const float* rsc, float rs_mul, float* bias_out, LAS float* red) {
    const int r = F.lane >> 4, c16 = F.lane & 15;
    f32x4 rs = {rs_mul, rs_mul, rs_mul, rs_mul};
    if (rsc) { const f32x4 g = *(const f32x4*)(rsc + 4 * c16); rs = g * rs_mul; }
    f32x4 bacc = {0.f, 0.f, 0.f, 0.f};
    for (int t = F.wave; t < ktiles; t += NWAVES) {
        const int k0 = kbeg + 64 * t + 16 * r;
        f32x4 v[16];
#pragma unroll
        for (int i = 0; i < 16; ++i) { const int k = k0 + i; const float* p = (src2 && k >= ksplit) ? src2 + (size_t)k * ldn : src + (size_t)k * ldn; v[i] = *(const f32x4*)(p + 4 * c16); }
        if (useG) {
#pragma unroll
            for (int i = 0; i < 16; ++i) { bacc += v[i] * Ss[k0 + i]; v[i] = v[i] * Gs[k0 + i]; }
        }
#pragma unroll
        for (int e = 0; e < 4; ++e) {
            v4u lo, hi; const float s = rs[e];
            lo.x = pk2(v[0][e] * s, v[1][e] * s);   lo.y = pk2(v[2][e] * s, v[3][e] * s);   lo.z = pk2(v[4][e] * s, v[5][e] * s);   lo.w = pk2(v[6][e] * s, v[7][e] * s);
            hi.x = pk2(v[8][e] * s, v[9][e] * s);   hi.y = pk2(v[10][e] * s, v[11][e] * s); hi.z = pk2(v[12][e] * s, v[13][e] * s); hi.w = pk2(v[14][e] * s, v[15][e] * s);
            bf16* o = dst + (size_t)(4 * c16 + e) * ldk + k0;
            *(v4u*)o = lo; *(v4u*)(o + 8) = hi;
        }
    }
    if (bias_out) {
#pragma unroll
        for (int e = 0; e < 4; ++e) { float s = bacc[e]; s += __shfl_xor(s, 16); s += __shfl_xor(s, 32); bacc[e] = s; }
        if (r == 0) {
#pragma unroll
            for (int e = 0; e < 4; ++e) red[F.wave * 64 + 4 * c16 + e] = bacc[e];
        }
        wg_sync();
        if (F.tid < 64) { float s = 0.f;
#pragma unroll
            for (int w = 0; w < NWAVES; ++w) s += red[w * 64 + F.tid];
            bias_out[F.tid] = s; }
        wg_sync();
    }
}
__device__ __forceinline__ void p1_phase(Frame& F) {
    LAS float* Gs = (LAS float*)F.lds;
    LAS float* Ss = Gs + 1024;
    LAS float* red = Ss + 1024;
    const float* MOD = WSP(float, WS_MOD);
    constexpr int N_GU = 352, N_CIN = 40, N_PIN = 32, N_COUT = 16, N_POUT = 16, N_DN = 256;
    constexpr int NITEMS = N_GU + N_CIN + N_PIN + N_COUT + N_POUT + N_DN;
    for (int it = F.bx; it < NITEMS; it += F.G) {
        int s = it;
        if (s < N_GU + N_CIN + N_PIN) {
            const float *nrm, *md; const float* src; int ldn; bf16* dst; float* bias; int n0, drow;
            if (s < N_GU) { const int f = s / 88, r = s % 88, isup = r / 44; n0 = (r % 44) * 64;
                src = inptr(isup ? IN_W_UP : IN_W_GATE) + (size_t)f * 1024 * DFF + n0; ldn = DFF;
                drow = 256 * (n0 / 128) + 128 * isup + (n0 % 128); dst = WSP(bf16, WS_WGU) + (size_t)f * NGU * 1024 + (size_t)drow * 1024; bias = WSP(float, WS_BGU) + f * NGU + drow;
                nrm = inptr(IN_FFN_NORM) + f * 1024; md = MOD + (f >> 1) * 9216 + ((f & 1) ? 6 : 0) * 1024; }
            else if (s < N_GU + N_CIN) { s -= N_GU; n0 = s * 64; const int seg = n0 / 512, c = n0 % 512, t2 = 256 * (c / 128) + (c % 128);
                drow = seg == 0 ? t2 : seg == 1 ? t2 + 128 : seg == 2 ? 2048 + c : seg == 3 ? 1024 + t2 : 1024 + t2 + 128;
                src = inptr(IN_CONV_W_IN) + n0; ldn = NCIN; dst = WSP(bf16, WS_WCIN) + (size_t)drow * 1024; bias = WSP(float, WS_BCIN) + drow;
                nrm = inptr(IN_MIX_NORM); md = MOD + 3 * 1024; }
            else { s -= N_GU + N_CIN; n0 = s * 64; drow = n0;
                src = inptr(IN_PM_W_IN) + n0; ldn = NPIN; dst = WSP(bf16, WS_WPIN) + (size_t)drow * 1024; bias = WSP(float, WS_BPIN) + drow;
                nrm = inptr(IN_MIX_NORM) + 1024; md = MOD + 9216 + 3 * 1024; }
            for (int k = F.tid; k < 1024; k += NWAVES * 64) { Gs[k] = nrm[k] * (1.0f + md[1024 + k]); Ss[k] = md[k]; }
            wg_sync();
            prep_strip(F, src, ldn, nullptr, 0, 0, 16, dst, 1024, true, Gs, Ss, nullptr, 1.0f, bias, red);
            continue;
        }
        s -= N_GU + N_CIN + N_PIN;
        if (s < N_COUT) { const int n0 = s * 64;
            prep_strip(F, inptr(IN_CONV_W_OUT) + n0, 1024, nullptr, 0, 0, 16, WSP(bf16, WS_WCOUT) + (size_t)n0 * 1024, 1024, false, Gs, Ss, MOD + 5 * 1024 + n0, 1.0f, nullptr, red);
            continue; }
        s -= N_COUT;
        if (s < N_POUT) { const int n0 = s * 64; const float* gate = MOD + 9216 + 5 * 1024 + n0;
            prep_strip(F, WSP(float, WS_WEFF) + n0, 1024, inptr(IN_PM_W_OUT) + n0, 512, 0, 16, WSP(bf16, WS_WPOUT) + (size_t)n0 * 1024, 1024, false, Gs, Ss, gate, 1.0f, nullptr, red);
            if (F.tid < 64) WSP(float, WS_BPOUT)[n0 + F.tid] = gate[F.tid] * WSP(float, WS_BEFF)[n0 + F.tid];
            continue; }
        s -= N_POUT;
        { const int f = s / 64, r = s % 64, n0 = (r >> 2) * 64, kq = r & 3;
          const float* gate = MOD + (f >> 1) * 9216 + (((f & 1) ? 6 : 0) + 2) * 1024 + n0;
          prep_strip(F, inptr(IN_W_DOWN) + (size_t)f * DFF * 1024 + n0, 1024, nullptr, 0, 704 * kq, 11, WSP(bf16, WS_WDN) + (size_t)f * 1024 * DFF + (size_t)n0 * DFF, DFF, false, Gs, Ss, gate, 0.5f, nullptr, red); }
    }
}

__device__ __forceinline__ void conv_phase(Frame& F) {
    const bf16* ZC = WSP(bf16, WS_R1); bf16* MIX = WSP(bf16, WS_MIX);
    const int c = F.wave * 64 + F.lane;
    const float* conv_a_w = inptr(IN_CONV_A_W); const float* conv_b_w = inptr(IN_CONV_B_W);
    float w[31];
#pragma unroll
    for (int k = 0; k < 31; ++k) w[k] = conv_a_w[k * 512 + c];
    const float cb = inptr(IN_CONV_A_B)[c], lg = inptr(IN_LN_A_G)[c], lb = inptr(IN_LN_A_B)[c];
    const float w0 = conv_b_w[c], w1 = conv_b_w[512 + c], w2 = conv_b_w[1024 + c];
    for (int unit = F.bx; unit < M / 64; unit += F.G) {
        const int t0 = unit * 64;
        float win[31];
#pragma unroll
        for (int k = 0; k < 31; ++k) win[k] = 0.f;
        for (int jj = 0; jj < 4; ++jj) {
            float nx[31];
#pragma unroll
            for (int i = 0; i < 31; ++i) { const int tt = jj * 31 + i, t = t0 - 30 + tt; nx[i] = (tt < 94 && t >= 0) ? bf2f(ZC[(size_t)t * 1536 + c]) : 0.f; }
#pragma unroll
            for (int i = 0; i < 31; ++i) { const int tt = jj * 31 + i;
                win[i] = nx[i];
                if (tt >= 30 && tt < 94) {
                    float y = cb;
#pragma unroll
                    for (int k = 0; k < 31; ++k) y += w[k] * win[(i + 1 + k) % 31];
                    const float mean = wave_sum(y) * (1.0f / 64.0f), d = y - mean, var = wave_sum(d * d) * (1.0f / 64.0f);
                    const float yn = d * (1.0f / sqrtf(var + EPS)) * lg + lb;
                    const float sv = yn / (1.0f + __builtin_amdgcn_exp2f(-LOG2E * yn));
                    MIX[(size_t)(t0 - 30 + tt) * 1024 + c] = (bf16)f2bf(sv);
                }
                __builtin_amdgcn_sched_barrier(0); }
        }
        float p2 = t0 >= 2 ? bf2f(ZC[(size_t)(t0 - 2) * 1536 + 512 + c]) : 0.f, p1 = t0 >= 1 ? bf2f(ZC[(size_t)(t0 - 1) * 1536 + 512 + c]) : 0.f;
#pragma unroll 8
        for (int tt = 0; tt < 64; ++tt) { const int t = t0 + tt; const float cur = bf2f(ZC[(size_t)t * 1536 + 512 + c]), bg = bf2f(ZC[(size_t)t * 1536 + 1024 + c]);
            MIX[(size_t)t * 1024 + 512 + c] = (bf16)f2bf(bg * (w0 * p2 + w1 * p1 + w2 * cur)); p2 = p1; p1 = cur; }
    }
}

__device__ __forceinline__ void pre_phase(Frame& F) {
    const bf16* Kb = WSP(bf16, WS_K); const bf16* U = WSP(bf16, WS_U); bf16* MIX = WSP(bf16, WS_MIX); float* KM = WSP(float, WS_KMEAN);
    LAS float* part = (LAS float*)F.lds;
    for (int unit = F.bx; unit < NBLK * NHEAD; unit += F.G) {
        const int b = unit >> 3, h = unit & 7, key = F.tid >> 3, ch = F.tid & 7;
        float s[8];
#pragma unroll
        for (int e = 0; e < 8; ++e) s[e] = 0.f;
#pragma unroll
        for (int i = 0; i < 4; ++i) { const v4u q = *(const v4u*)(Kb + (size_t)(b * 256 + 64 * i + key) * 512 + h * 64 + ch * 8);
            s[0] += bf2f(q.x & 0xffffu); s[1] += bf2f(q.x >> 16); s[2] += bf2f(q.y & 0xffffu); s[3] += bf2f(q.y >> 16);
            s[4] += bf2f(q.z & 0xffffu); s[5] += bf2f(q.z >> 16); s[6] += bf2f(q.w & 0xffffu); s[7] += bf2f(q.w >> 16); }
#pragma unroll
        for (int e = 0; e < 8; ++e) part[F.tid * 8 + e] = s[e];
        wg_sync();
        if (F.tid < 64) { const int cq = F.tid >> 3, e = F.tid & 7; float t = 0.f;
            for (int kk = 0; kk < 64; ++kk) t += part[(kk * 8 + cq) * 8 + e];
            KM[(size_t)(h * 64 + b) * 64 + F.tid] = t * (1.0f / 256.0f); }
        wg_sync();
    }
    for (int idx = F.bx * NWAVES * 64 + F.tid; idx < M * 64; idx += F.G * NWAVES * 64) {
        const int t = idx >> 6, ch = idx & 63, w = 2 << (ch >> 4), n = (t + 1) < w ? (t + 1) : w;
        float s[8], u0[8];
#pragma unroll
        for (int e = 0; e < 8; ++e) s[e] = 0.f;
        for (int j = 0; j < n; ++j) { const v4u q = *(const v4u*)(U + (size_t)(t - j) * 512 + ch * 8);
            float v[8] = {bf2f(q.x & 0xffffu), bf2f(q.x >> 16), bf2f(q.y & 0xffffu), bf2f(q.y >> 16), bf2f(q.z & 0xffffu), bf2f(q.z >> 16), bf2f(q.w & 0xffffu), bf2f(q.w >> 16)};
#pragma unroll
            for (int e = 0; e < 8; ++e) { s[e] += v[e]; if (j == 0) u0[e] = v[e]; } }
        const float inv = 1.0f / (float)n; v4u o;
        o.x = pk2(s[0] * inv - u0[0], s[1] * inv - u0[1]); o.y = pk2(s[2] * inv - u0[2], s[3] * inv - u0[3]);
        o.z = pk2(s[4] * inv - u0[4], s[5] * inv - u0[5]); o.w = pk2(s[6] * inv - u0[6], s[7] * inv - u0[7]);
        *(v4u*)(MIX + (size_t)t * 1024 + ch * 8) = o;
    }
}

__device__ __forceinline__ int list_off(int b) { return 256 * (63 * b - (b * (b - 1)) / 2); }
__device__ __forceinline__ void sel_phase(Frame& F) {
    const bf16* Qb = WSP(bf16, WS_Q); const float* KM = WSP(float, WS_KMEAN); unsigned* LIST = WSP(unsigned, WS_LIST);
    LAS float* km = (LAS float*)F.lds;
    LAS unsigned* lcnt = (LAS unsigned*)(F.lds + 16384);
    LAS unsigned* lbase = lcnt + 64;
    for (int unit = F.bx; unit < NHEAD * (M / 512); unit += F.G) {
        const int h = unit & 7, chunk = unit >> 3, t = chunk * 512 + F.tid, own = t >> 8, nb = 2 * chunk + 1;
        wg_sync();
        for (int i = F.tid; i < nb * 64; i += NWAVES * 64) km[i] = KM[(size_t)h * 4096 + i];
        if (F.tid < 64) lcnt[F.tid] = 0u;
        wg_sync();
        float q[64];
#pragma unroll
        for (int i = 0; i < 8; ++i) { const v4u v = *(const v4u*)(Qb + (size_t)t * 512 + h * 64 + i * 8);
            q[8 * i + 0] = bf2f(v.x & 0xffffu); q[8 * i + 1] = bf2f(v.x >> 16); q[8 * i + 2] = bf2f(v.y & 0xffffu); q[8 * i + 3] = bf2f(v.y >> 16);
            q[8 * i + 4] = bf2f(v.z & 0xffffu); q[8 * i + 5] = bf2f(v.z >> 16); q[8 * i + 6] = bf2f(v.w & 0xffffu); q[8 * i + 7] = bf2f(v.w >> 16); }
        float v0 = -INFINITY, v1 = -INFINITY, v2 = -INFINITY; int i0 = 0, i1 = 0, i2 = 0;
        for (int b = 0; b < nb; ++b) {
            float g = 0.f;
#pragma unroll
            for (int d4 = 0; d4 < 16; ++d4) { const f32x4 kv = *(const LAS f32x4*)(km + b * 64 + 4 * d4); g += (q[4 * d4] * kv[0] + q[4 * d4 + 1] * kv[1]) + (q[4 * d4 + 2] * kv[2] + q[4 * d4 + 3] * kv[3]); }
            if (b < own) {
                if (g > v0) { v2 = v1; i2 = i1; v1 = v0; i1 = i0; v0 = g; i0 = b; }
                else if (g > v1) { v2 = v1; i2 = i1; v1 = g; i1 = b; }
                else if (g > v2) { v2 = g; i2 = b; }
            }
        }
        const int nsel = own < 3 ? own : 3;
        unsigned p0 = 0, p1 = 0, p2 = 0;
        if (nsel > 0) p0 = __hip_atomic_fetch_add(lcnt + i0, 1u, __ATOMIC_RELAXED, __HIP_MEMORY_SCOPE_WORKGROUP);
        if (nsel > 1) p1 = __hip_atomic_fetch_add(lcnt + i1, 1u, __ATOMIC_RELAXED, __HIP_MEMORY_SCOPE_WORKGROUP);
        if (nsel > 2) p2 = __hip_atomic_fetch_add(lcnt + i2, 1u, __ATOMIC_RELAXED, __HIP_MEMORY_SCOPE_WORKGROUP);
        wg_sync();
        if (F.tid < 64) { const unsigned cn = lcnt[F.tid]; lbase[F.tid] = cn ? atomicAdd((unsigned*)F.ctl + CW_CUR + (h * 64 + F.tid) * CUR_STRIDE, cn) : 0u; }
        wg_sync();
        if (nsel > 0) LIST[(size_t)h * LIST_PER_HEAD + list_off(i0) + lbase[i0] + p0] = (unsigned)t;
        if (nsel > 1) LIST[(size_t)h * LIST_PER_HEAD + list_off(i1) + lbase[i1] + p1] = (unsigned)t | (1u << 16);
        if (nsel > 2) LIST[(size_t)h * LIST_PER_HEAD + list_off(i2) + lbase[i2] + p2] = (unsigned)t | (2u << 16);
    }
}

namespace att {
typedef short s16x4 __attribute__((ext_vector_type(4)));
typedef float f32x16 __attribute__((ext_vector_type(16)));
typedef short v4i16_t __attribute__((ext_vector_type(4)));
typedef float f32x2_t __attribute__((ext_vector_type(2)));
typedef __bf16 bf16x2_t __attribute__((ext_vector_type(2)));
constexpr int KOFF = 0, VOFF = 32768, WSF_OFF = 65536, QL_OFF = WSF_OFF + 2048, COEF_OFF = QL_OFF + 1024, SCAN_OFF = COEF_OFF + 4096, ATT_LDS_END = SCAN_OFF + 2048;
__device__ __forceinline__ int crow(int r, int hi) { return (r & 3) + 8 * (r >> 2) + 4 * hi; }
__device__ __forceinline__ unsigned cvtpk(float lo, float hi) { f32x2_t v = {lo, hi}; bf16x2_t b = __builtin_convertvector(v, bf16x2_t); return __builtin_bit_cast(unsigned, b); }
__device__ __forceinline__ s16x4 vtr(const LAS unsigned char* p) { return __builtin_bit_cast(s16x4, __builtin_amdgcn_ds_read_tr16_b64_v4i16((LAS v4i16_t*)p)); }
#define ATT_MFMA(a, b, c) __builtin_amdgcn_mfma_f32_32x32x16_bf16(a, b, c, 0, 0, 0)

__device__ __forceinline__ void load_kv(LAS unsigned char* lds, const bf16* Kb, const bf16* Vb, int b, int h, int wave, int lane) {
    const bf16* ks = Kb + (size_t)(b * 256 + lane) * 512 + h * 64 + wave * 8;
    const int vkey = 16 * (wave & 3) + (lane >> 2);
    const bf16* vs = Vb + (size_t)(b * 256 + vkey) * 512 + h * 64 + (wave >> 2) * 32 + (lane & 3) * 8;
    v4u kq[4], vq[4];
#pragma unroll
    for (int i = 0; i < 4; ++i) { kq[i] = *(const v4u*)(ks + (size_t)i * 64 * 512); vq[i] = *(const v4u*)(vs + (size_t)i * 64 * 512); }
#pragma unroll
    for (int i = 0; i < 4; ++i) { *(LAS v4u*)(lds + KOFF + i * 8192 + wave * 1024 + lane * 16) = kq[i];
                                  *(LAS v4u*)(lds + VOFF + i * 8192 + (wave >> 2) * 4096 + vkey * 64 + (lane & 3) * 16) = vq[i]; }
}

template <bool OWN>
__device__ __forceinline__ void item(Frame& F, int h, int b, const unsigned* list, int nrows) {
    LAS unsigned char* lds = F.lds;
    const int lane = F.lane, wave = F.wave, r32 = lane & 31, hi = lane >> 5;
    LAS float* wsf = (LAS float*)(lds + WSF_OFF) + wave * 64;
    LAS unsigned* QL = (LAS unsigned*)(lds + QL_OFF);
    LAS float* coef = (LAS float*)(lds + COEF_OFF) + wave * 128;
    const bf16* Qb = WSP(bf16, WS_Q);
    wg_sync();
    load_kv(lds, WSP(bf16, WS_K), WSP(bf16, WS_V), b, h, wave, lane);
    if (F.tid < 256) { unsigned e;
        if (OWN) e = (unsigned)(b * 256 + F.tid);
        else { const int rr = F.tid < nrows ? F.tid : nrows - 1; e = list[rr] | (F.tid < nrows ? 0u : 0x80000000u); }
        QL[F.tid] = e; }
    wg_sync();
    const unsigned ent = QL[wave * 32 + r32];
    const int t = (int)(ent & 0x3fffu);
    bf16x8 qr[4];
#pragma unroll
    for (int d0 = 0; d0 < 4; ++d0) qr[d0] = *(const bf16x8*)(Qb + (size_t)t * 512 + h * 64 + d0 * 16 + hi * 8);
    const float slope2 = LOG2E / (float)(2 << h);
    float m = -INFINITY, l = 0.f; f32x16 o[2]; o[0] = f32x16{}; o[1] = f32x16{};
    const int ntile = OWN ? ((wave * 32 + 31) >> 6) + 1 : 4;
#pragma unroll 1
    for (int tile = 0; tile < ntile; ++tile) {
        const float base = slope2 * (float)(b * 256 + tile * 64 + 4 * hi - t);
        f32x16 p0, p1;
#pragma unroll
        for (int r = 0; r < 16; ++r) { p0[r] = base + slope2 * (float)((r & 3) + 8 * (r >> 2)); p1[r] = p0[r] + 32.0f * slope2; }
        const LAS unsigned char* kb = lds + KOFF + tile * 8192 + hi * 1024 + r32 * 16;
#pragma unroll
        for (int d0 = 0; d0 < 4; ++d0) { const bf16x8 k0 = *(const LAS bf16x8*)(kb + d0 * 2048), k1 = *(const LAS bf16x8*)(kb + d0 * 2048 + 512);
            p0 = ATT_MFMA(k0, qr[d0], p0); p1 = ATT_MFMA(k1, qr[d0], p1); }
        if (OWN) { const int qo = t - b * 256, kk = tile * 64 + 4 * hi;
#pragma unroll
            for (int r = 0; r < 16; ++r) { const int kv = kk + (r & 3) + 8 * (r >> 2); if (kv > qo) p0[r] = -INFINITY; if (kv + 32 > qo) p1[r] = -INFINITY; } }
        float rm = fmaxf(p0[0], p1[0]);
#pragma unroll
        for (int r = 1; r < 16; ++r) rm = fmaxf(rm, fmaxf(p0[r], p1[r]));
        rm = fmaxf(rm, __shfl_xor(rm, 32));
        const float mn = fmaxf(m, rm), alpha = __builtin_amdgcn_exp2f(m - mn);
        m = mn;
        float ls = 0.f;
#pragma unroll
        for (int r = 0; r < 16; ++r) { p0[r] = __builtin_amdgcn_exp2f(p0[r] - mn); p1[r] = __builtin_amdgcn_exp2f(p1[r] - mn); ls += p0[r] + p1[r]; }
        l = l * alpha + ls;
        if (tile > 0) {
            if (hi == 0) wsf[r32] = alpha;
            asm volatile("s_waitcnt lgkmcnt(0)" ::: "memory");
#pragma unroll
            for (int r = 0; r < 16; ++r) { const float a = wsf[crow(r, hi)]; o[0][r] *= a; o[1][r] *= a; }
        }
        bf16x8 pa[4];
        { v4u w0 = {cvtpk(p0[0], p0[1]), cvtpk(p0[2], p0[3]), cvtpk(p0[4], p0[5]), cvtpk(p0[6], p0[7])};
          v4u w1 = {cvtpk(p0[8], p0[9]), cvtpk(p0[10], p0[11]), cvtpk(p0[12], p0[13]), cvtpk(p0[14], p0[15])};
          v4u w2 = {cvtpk(p1[0], p1[1]), cvtpk(p1[2], p1[3]), cvtpk(p1[4], p1[5]), cvtpk(p1[6], p1[7])};
          v4u w3 = {cvtpk(p1[8], p1[9]), cvtpk(p1[10], p1[11]), cvtpk(p1[12], p1[13]), cvtpk(p1[14], p1[15])};
          pa[0] = __builtin_bit_cast(bf16x8, w0); pa[1] = __builtin_bit_cast(bf16x8, w1); pa[2] = __builtin_bit_cast(bf16x8, w2); pa[3] = __builtin_bit_cast(bf16x8, w3); }
        const LAS unsigned char* vb = lds + VOFF + tile * 8192 + ((lane >> 4) & 1) * 32 + (lane & 3) * 8 + (4 * hi + ((lane & 15) >> 2)) * 64;
#pragma unroll
        for (int d0 = 0; d0 < 2; ++d0)
#pragma unroll
            for (int ks = 0; ks < 4; ++ks) { const s16x4 lo = vtr(vb + d0 * 4096 + ks * 1024), hh = vtr(vb + d0 * 4096 + ks * 1024 + 512);
                const bf16x8 vf = {lo[0], lo[1], lo[2], lo[3], hh[0], hh[1], hh[2], hh[3]};
                o[d0] = ATT_MFMA(pa[ks], vf, o[d0]); }
    }
    l += __shfl_xor(l, 32);
    if (!OWN) {
        if (hi == 0) wsf[32 + r32] = l;
        asm volatile("s_waitcnt lgkmcnt(0)" ::: "memory");
        bf16* PO = WSP(bf16, WS_PO); float* ML = WSP(float, WS_ML);
#pragma unroll
        for (int r = 0; r < 16; ++r) { const int q = crow(r, hi); const unsigned e = QL[wave * 32 + q]; const float rl = 1.0f / wsf[32 + q];
            if (!(e & 0x80000000u)) { const int tq = (int)(e & 0x3fffu), j = (int)((e >> 16) & 3u); bf16* op = PO + ((size_t)j * M + tq) * 512 + h * 64 + r32;
                op[0] = (bf16)f2bf(o[0][r] * rl); op[32] = (bf16)f2bf(o[1][r] * rl); } }
        if (hi == 0 && !(ent & 0x80000000u)) { const int j = (int)((ent >> 16) & 3u); f32x2_t ml = {m, l}; *(f32x2_t*)(ML + (((size_t)j * M + t) * 8 + h) * 2) = ml; }
    } else {
        const int nsel = b < 3 ? b : 3;
        if (hi == 0) { const float* ML = WSP(float, WS_ML); float mj[3], lj[3]; float mx = m;
#pragma unroll
            for (int j = 0; j < 3; ++j) { if (j < nsel) { const f32x2_t ml = *(const f32x2_t*)(ML + (((size_t)j * M + t) * 8 + h) * 2); mj[j] = ml[0]; lj[j] = ml[1]; mx = fmaxf(mx, mj[j]); } else { mj[j] = -INFINITY; lj[j] = 0.f; } }
            const float ao = __builtin_amdgcn_exp2f(m - mx); float wj[3]; float den = ao * l;
#pragma unroll
            for (int j = 0; j < 3; ++j) { wj[j] = j < nsel ? lj[j] * __builtin_amdgcn_exp2f(mj[j] - mx) : 0.f; den += wj[j]; }
            const float inv = 1.0f / den; f32x4 cf = {ao * inv, wj[0] * inv, wj[1] * inv, wj[2] * inv};
            *(LAS f32x4*)(coef + r32 * 4) = cf; }
        asm volatile("s_waitcnt lgkmcnt(0)" ::: "memory");
        const bf16* PO = WSP(bf16, WS_PO); bf16* MIX = WSP(bf16, WS_MIX);
#pragma unroll
        for (int r = 0; r < 16; ++r) { const int q = crow(r, hi), tq = b * 256 + wave * 32 + q; const f32x4 cf = *(const LAS f32x4*)(coef + q * 4);
            float a0 = cf[0] * o[0][r], a1 = cf[0] * o[1][r];
#pragma unroll
            for (int j = 0; j < 3; ++j) if (j < nsel) { const bf16* pp = PO + ((size_t)j * M + tq) * 512 + h * 64 + r32; a0 += cf[1 + j] * bf2f(pp[0]); a1 += cf[1 + j] * bf2f(pp[32]); }
            bf16* op = MIX + (size_t)tq * 1024 + 512 + h * 64 + r32; op[0] = (bf16)f2bf(a0); op[32] = (bf16)f2bf(a1); }
    }
}
}

__device__ __forceinline__ void atta_phase(Frame& F) {
    LAS unsigned* SC = (LAS unsigned*)(F.lds + att::SCAN_OFF);
    const unsigned* cur = (const unsigned*)F.ctl + CW_CUR;
    { const unsigned cn = __hip_atomic_load(cur + F.tid * CUR_STRIDE, __ATOMIC_RELAXED, __HIP_MEMORY_SCOPE_AGENT); SC[F.tid] = (cn + 255u) >> 8; }
    wg_sync();
    for (int off = 1; off < 512; off <<= 1) { const unsigned v = SC[F.tid] + (F.tid >= off ? SC[F.tid - off] : 0u); wg_sync(); SC[F.tid] = v; wg_sync(); }
    const int total = (int)SC[511];
    for (int idx = F.bx; idx < total; idx += F.G) {
        int lo = 0, hi = 511;
        while (lo < hi) { const int mid = (lo + hi) >> 1; if ((int)SC[mid] > idx) hi = mid; else lo = mid + 1; }
        const int i = lo, h = i >> 6, b = i & 63, before = i ? (int)SC[i - 1] : 0, chunk = idx - before;
        const int cn = (int)__hip_atomic_load(cur + i * CUR_STRIDE, __ATOMIC_RELAXED, __HIP_MEMORY_SCOPE_AGENT);
        const int nrows = (cn - chunk * 256) < 256 ? (cn - chunk * 256) : 256;
        att::item<false>(F, h, b, WSP(unsigned, WS_LIST) + (size_t)h * LIST_PER_HEAD + list_off(b) + chunk * 256, nrows);
    }
}
__device__ __forceinline__ void attb_phase(Frame& F) {
    for (int idx = F.bx; idx < NHEAD * NBLK; idx += F.G) att::item<true>(F, idx & 7, idx >> 3, nullptr, 256);
}

__device__ __forceinline__ void final_phase(Frame& F) {
    const int gw = F.bx * NWAVES + F.wave, NGW = F.G * NWAVES; const float* SSQ = WSP(float, WS_SSQ);
    f32x4 g[4]; const float* fnorm = inptr(IN_FINAL_NORM);
#pragma unroll
    for (int j = 0; j < 4; ++j) g[j] = ((const f32x4*)fnorm)[F.lane + 64 * j];
    for (int m = gw; m < M; m += NGW) {
        const float s = ((SSQ[m] + SSQ[M + m]) + SSQ[2 * M + m]) + SSQ[3 * M + m];
        const float ri = 1.0f / sqrtf(s * (1.0f / 1024.0f) + EPS);
        f32x4* xr = (f32x4*)(F.out + (size_t)m * D) + F.lane;
#pragma unroll
        for (int j = 0; j < 4; ++j) { const f32x4 v = xr[64 * j]; xr[64 * j] = v * ri * g[j]; }
    }
}

struct Args { const float* in[22]; float* out; unsigned char* ws; int ph_lo, ph_hi; };
__global__ void __launch_bounds__(NWAVES * 64, 2) skel_fwd(Args args) {
    extern __shared__ __attribute__((aligned(16))) unsigned char lds[];
    Frame F;
    F.lds = (LAS unsigned char*)lds;
    F.MISC = (volatile LAS unsigned*)(F.lds + MISC_OFF);
    F.tid = threadIdx.x; F.lane = F.tid & 63; F.wave = __builtin_amdgcn_readfirstlane(F.tid >> 6);
    F.G = gridDim.x; F.bx = blockIdx.x;
    F.ws = args.ws; F.ctl = (gu32*)(args.ws + WS_CTL); F.out = args.out;
    for (int u = F.tid; u < (LDS_BYTES - LDSCTL_OFF) / 4; u += NWAVES * 64) ((LAS unsigned*)(F.lds + LDSCTL_OFF))[u] = 0u;
    __syncthreads();
    XcdBarrier bar; bar.bar = (unsigned*)(F.ctl + CW_BAR); bar.x = 0; bar.st = nullptr;
    if (N_LAUNCHES == 1) bar = xcd_barrier_post((unsigned*)(F.ctl + CW_BAR), F.MISC + 8);
    const int lo = args.ph_lo, hi = args.ph_hi;
    unsigned char* ws = F.ws;
#define XB ((const pg8::bf16_t*)(ws + WS_XB))
#define SSQ ((const float*)(ws + WS_SSQ))
#ifndef DBG_ONLY
#define DBG_ONLY -1
#endif
#define IN(k) (lo <= (k) && (k) < hi && (DBG_ONLY < 0 || (k) == DBG_ONLY))
#ifndef PROBE_REPS
#define REPS(k) 1
#else
    constexpr int probe_reps[NPHASE] = PROBE_REPS;
#define REPS(k) probe_reps[k]
#endif
#define REPLOOP(k) for (int rep_ = 0; rep_ < REPS(k); ++rep_, (rep_ < REPS(k) ? xcd_barrier(bar) : (void)0))
#ifdef PROBE_AMP
    unsigned long long ts_prev = __builtin_amdgcn_s_memrealtime(), ts_amp = 0;
#define STAMP(k) do { const unsigned long long now_ = __builtin_amdgcn_s_memrealtime(); if ((k) == PROBE_AMP) ts_amp = now_ - ts_prev; ts_prev = now_; } while (0)
#else
#define STAMP(k) do { } while (0)
#endif
#define SEAM(k) do { if (IN(k) && IN((k) + 1)) xcd_barrier(bar); STAMP(k); asm volatile("" : "+v"(F.tid), "+v"(F.lane)); asm volatile("" : "+s"(F.ws), "+s"(F.out), "+s"(F.G), "+s"(F.bx), "+s"(F.wave)); ws = F.ws; } while (0)
    LAS float* TAB = (LAS float*)(F.lds + TAB_OFF);

    if (IN(PH_P0)) REPLOOP(PH_P0) { p0_phase(F); } SEAM(PH_P0);
    if (IN(PH_P1)) REPLOOP(PH_P1) { p1_phase(F); } SEAM(PH_P1);
#define FFN_PHASES(f, PH_GU, XIN) \
    if (IN(PH_GU)) REPLOOP(PH_GU) { \
        pg8::Gemm g{XB, (const pg8::bf16_t*)(ws + WS_WGU) + (size_t)(f) * NGU * 1024, M, NGU, D}; pg8::StaticOrder S; S.init(M, NGU, F.G, vbx); \
        pg8::fill_tables(TAB, S, SSQ, (const float*)(ws + WS_BGU) + (f) * NGU); pg8::EpiGU E{(pg8::bf16_t*)(ws + WS_R1), TAB}; \
        pg8::gemm_phase<pg8::EpiGU, pg8::StaticOrder, true, true>(F.lds + RING_OFF, g, S, E); } \
    SEAM(PH_GU); \
    if (IN(PH_GU + 1)) REPLOOP(PH_GU + 1) { \
        pg8::Gemm g{(const pg8::bf16_t*)(ws + WS_R1), (const pg8::bf16_t*)(ws + WS_WDN) + (size_t)(f) * 1024 * DFF, M, D, DFF}; pg8::StaticOrder S; S.init(M, D, F.G, vbx); \
        pg8::EpiRes E{XIN, F.out, (pg8::bf16_t*)(ws + WS_XB), nullptr, (float*)(ws + WS_SSQ)}; \
        pg8::gemm_phase<pg8::EpiRes, pg8::StaticOrder, false, true>(F.lds + RING_OFF, g, S, E); } \
    SEAM(PH_GU + 1);
#define OUT_PHASE(PH, WOFF, BIAS) \
    if (IN(PH)) REPLOOP(PH) { \
        pg8::Gemm g{(const pg8::bf16_t*)(ws + WS_MIX), (const pg8::bf16_t*)(ws + WOFF), M, D, D}; pg8::StaticOrder S; S.init(M, D, F.G, vbx); \
        pg8::EpiRes E{F.out, F.out, (pg8::bf16_t*)(ws + WS_XB), BIAS, (float*)(ws + WS_SSQ)}; \
        pg8::gemm_phase<pg8::EpiRes, pg8::StaticOrder, false, true>(F.lds + RING_OFF, g, S, E); } \
    SEAM(PH);

    int vbx = F.bx;
    if (N_LAUNCHES == 1 && lo == 0 && F.G == 256) { bool ok = true;
        for (int j = 0; j < 16; ++j) { const unsigned cn = xb_ld(&bar.bar[XB_XCNT(j)]); ok = ok && (cn == (j < 8 ? 32u : 0u)); }
        if (ok) vbx = (int)F.MISC[10] * 8 + (int)bar.x; }
    vbx = __builtin_amdgcn_readfirstlane(vbx);
    FFN_PHASES(0, PH_L0_GU1, inptr(IN_X))
    if (IN(PH_L0_CIN)) REPLOOP(PH_L0_CIN) {
        pg8::Gemm g{XB, (const pg8::bf16_t*)(ws + WS_WCIN), M, NCIN, D}; pg8::StaticOrder S; S.init(M, NCIN, F.G, vbx);
        pg8::fill_tables(TAB, S, SSQ, (const float*)(ws + WS_BCIN)); pg8::EpiCin E{(pg8::bf16_t*)(ws + WS_R1), TAB};
        pg8::gemm_phase<pg8::EpiCin, pg8::StaticOrder, true, true>(F.lds + RING_OFF, g, S, E); }
    SEAM(PH_L0_CIN);
    if (IN(PH_L0_CONV)) REPLOOP(PH_L0_CONV) conv_phase(F);
    SEAM(PH_L0_CONV);
    OUT_PHASE(PH_L0_COUT, WS_WCOUT, nullptr)
    FFN_PHASES(1, PH_L0_GU2, F.out)
    FFN_PHASES(2, PH_L1_GU1, F.out)
    if (IN(PH_L1_PIN)) REPLOOP(PH_L1_PIN) {
        pg8::Gemm g{XB, (const pg8::bf16_t*)(ws + WS_WPIN), M, NPIN, D}; pg8::StaticOrder S; S.init(M, NPIN, F.G, vbx);
        pg8::fill_tables(TAB, S, SSQ, (const float*)(ws + WS_BPIN)); pg8::EpiPin E{(pg8::bf16_t*)(ws + WS_Q), TAB};
        pg8::gemm_phase<pg8::EpiPin, pg8::StaticOrder, true, true>(F.lds + RING_OFF, g, S, E); }
    SEAM(PH_L1_PIN);
    if (IN(PH_L1_PRE)) REPLOOP(PH_L1_PRE) pre_phase(F);
    SEAM(PH_L1_PRE);
    if (IN(PH_L1_SEL)) REPLOOP(PH_L1_SEL) sel_phase(F);
    SEAM(PH_L1_SEL);
    if (IN(PH_L1_ATTA)) REPLOOP(PH_L1_ATTA) atta_phase(F);
    SEAM(PH_L1_ATTA);
    if (IN(PH_L1_ATTB)) REPLOOP(PH_L1_ATTB) attb_phase(F);
    SEAM(PH_L1_ATTB);
    OUT_PHASE(PH_L1_POUT, WS_WPOUT, (const float*)(ws + WS_BPOUT))
    FFN_PHASES(3, PH_L1_GU2, F.out)
    if (IN(PH_FINAL)) REPLOOP(PH_FINAL) final_phase(F);
#ifdef PROBE_AMP
    STAMP(PH_FINAL);
    if (F.bx == 0) { const unsigned long long t0_ = __builtin_amdgcn_s_memrealtime(); while (__builtin_amdgcn_s_memrealtime() - t0_ < 8ull * ts_amp) __builtin_amdgcn_s_sleep(8); }
#endif
#undef IN
#undef SEAM
}

extern "C" void kernel_launch(void* const* d_in, const int* in_sizes, int n_in, void* d_out, int out_size, void* d_ws, size_t ws_size, hipStream_t stream) {
    static int grid = 0;
    if (grid == 0) {
        if (n_in != 22 || in_sizes[0] != M * D || out_size != M * D || ws_size < WS_END) { fprintf(stderr, "kernel_launch: unexpected shapes/workspace (n_in %d, ws %zu < %zu); nothing launched\n", n_in, ws_size, (size_t)WS_END); grid = -1; return; }
        int dev = 0, cus = 0;
        if (hipGetDevice(&dev) != hipSuccess || hipDeviceGetAttribute(&cus, hipDeviceAttributeMultiprocessorCount, dev) != hipSuccess) { grid = -1; return; }
        if (hipFuncSetAttribute((const void*)skel_fwd, hipFuncAttributeMaxDynamicSharedMemorySize, LDS_BYTES) != hipSuccess) { fprintf(stderr, "kernel_launch: hipFuncSetAttribute failed\n"); grid = -1; return; }
        (void)hipGetLastError();
        grid = cus;
        if (grid != 256) fprintf(stderr, "kernel_launch: %d CUs; this kernel is laid out for 256\n", grid);
    }
    if (grid < 0) return;
    if (hipMemsetAsync((char*)d_ws + WS_CTL, 0, CTL_ZERO_BYTES, stream) != hipSuccess) return;
    Args a{};
    for (int i = 0; i < 22; ++i) a.in[i] = (const float*)d_in[i];
    a.out = (float*)d_out; a.ws = (unsigned char*)d_ws;
    for (int li = 0; li < N_LAUNCHES; ++li) {
        a.ph_lo = (N_LAUNCHES == 1) ? 0 : li; a.ph_hi = (N_LAUNCHES == 1) ? (int)NPHASE : li + 1;
        hipLaunchKernelGGL(skel_fwd, dim3(grid), dim3(NWAVES * 64), LDS_BYTES, stream, a);
        if (hipPeekAtLastError() != hipSuccess) { fprintf(stderr, "kernel_launch: launch %d failed\n", li); break; }
    }
}
```

```cpp
#include <hip/hip_runtime.h>
#include <hip/hip_bf16.h>
#include <cstdio>
#include <cstdint>
#include <cmath>

#ifndef MK_N_LAUNCHES
#define MK_N_LAUNCHES 1
#endif

constexpr int M = 16384, D = 1024, DFF = 2816, NGU = 2 * DFF, NCIN = 2560, NPIN = 2048;
constexpr int NHEAD = 8, HD = 64, MBLK = 256, NBLK = M / MBLK;
constexpr float EPS = 1e-6f;
constexpr float LOG2E = 1.4426950408889634f;
constexpr float QSCALE = 0.125f * LOG2E;

namespace pg8 {
#define PG8_LAS __attribute__((address_space(3)))
typedef unsigned short bf16_t;
typedef short bf16x8 __attribute__((ext_vector_type(8)));
typedef float f32x4 __attribute__((ext_vector_type(4)));
typedef unsigned u32x4 __attribute__((ext_vector_type(4)));
constexpr int BM = 256, BK = 64, HALF = 128, HTB = HALF * BK * 2  , STAGE_BYTES = 8 * HTB, NXCD = 8, WGM = 8;

__host__ __device__ __forceinline__ int lds_byte(int r, int c) { const int st = (r >> 4) * 2 + (c >> 5), rr = r & 15, cc = c & 31, ob = rr * 64 + cc * 2; return st * 1024 + (ob ^ (((ob >> 9) & 1) << 5)); }
__host__ __device__ __forceinline__ void stage_rc(int b, int& R, int& C) { const int st = b / 1024, sb = b % 1024, swz = sb ^ (((sb >> 9) & 1) << 5); R = (st >> 1) * 16 + swz / 64; C = (st & 1) * 32 + (swz % 64) / 2; }
__host__ __device__ __forceinline__ int perm32(int rho) { const int n = rho >> 4, i = rho & 15; return 8 * (i >> 2) + 4 * n + (i & 3); }

struct Unit { int pm, pn, idx; };
struct Gemm { const bf16_t* A; const bf16_t* Bt; int M, N, K; };

struct StaticOrder {
    int nM, nN, nwg, G, c;
    __host__ __device__ void init(int M, int N, int G_, int c_) { nM = M / BM; nN = N / BM; nwg = nM * nN; G = G_; c = c_; }
    __host__ __device__ bool next(int i, Unit& u) const {
        const long L = (long)i * G + c; if (L >= nwg) return false;
        int wgid = (int)L; { const int q = nwg / NXCD, r = nwg % NXCD, xcd = wgid % NXCD, off = wgid / NXCD; wgid = (xcd < r ? xcd * (q + 1) : r * (q + 1) + (xcd - r) * q) + off; }
        const int nig = WGM * nN, gid = wgid / nig, fm = gid * WGM, gsz = (nM - fm) < WGM ? (nM - fm) : WGM;
        u.pm = fm + ((wgid % nig) % gsz); u.pn = (wgid % nig) / gsz; u.idx = i; return true;
    }
    __device__ __forceinline__ void a_ready(const Unit&) const {}
    __device__ __forceinline__ void done(const Unit&) const {}
};

__device__ __forceinline__ unsigned cvt_pk_bf16(float lo, float hi) { unsigned r; asm volatile("v_cvt_pk_bf16_f32 %0, %1, %2" : "=v"(r) : "v"(lo), "v"(hi)); return r; }

typedef unsigned u32x2 __attribute__((ext_vector_type(2)));
constexpr int TAB_UNITS = 6;
__device__ __forceinline__ void tab_rinv(const PG8_LAS float* tab, const Unit& u, int wr, int fr, float (&rinv)[2][4]) {
#pragma unroll
    for (int ai = 0; ai < 2; ++ai)
#pragma unroll
        for (int m = 0; m < 4; ++m) rinv[ai][m] = tab[u.idx * 256 + ai * HALF + wr * 64 + m * 16 + fr];
}
__device__ __forceinline__ void tab_bias(const PG8_LAS float* tab, const Unit& u, int wc, int fq, f32x4 (&bv)[2][2]) {
#pragma unroll
    for (int bj = 0; bj < 2; ++bj)
#pragma unroll
        for (int n = 0; n < 2; ++n) bv[bj][n] = *(const PG8_LAS f32x4*)(tab + (TAB_UNITS + u.idx) * 256 + bj * HALF + wc * 32 + 8 * fq + 4 * n);
}
template <class Sched> __device__ __forceinline__ void fill_tables(PG8_LAS float* tab, const Sched& S, const float* ssq, const float* bias) {
    int tid = threadIdx.x; asm volatile("" : "+v"(tid));
    Unit u;
    for (int i = 0; i < TAB_UNITS && S.next(i, u); ++i) {
        if (tid < 256) { const int r = u.pm * BM + tid; const float s = ((ssq[r] + ssq[M + r]) + ssq[2 * M + r]) + ssq[3 * M + r]; tab[i * 256 + tid] = 1.0f / sqrtf(s * (1.0f / 1024.0f) + EPS); }
        else tab[(TAB_UNITS + i) * 256 + (tid - 256)] = bias[u.pn * BM + (tid - 256)];
    }
    __syncthreads();
}
__device__ __forceinline__ float sigm(float z) { return __builtin_amdgcn_rcpf(1.0f + __builtin_amdgcn_exp2f(-LOG2E * z)); }
__device__ __forceinline__ u32x4 pack8(const f32x4 a, const f32x4 b) { u32x4 w; w.x = cvt_pk_bf16(a[0], a[1]); w.y = cvt_pk_bf16(a[2], a[3]); w.z = cvt_pk_bf16(b[0], b[1]); w.w = cvt_pk_bf16(b[2], b[3]); return w; }

struct EpiGU {
    static constexpr bool PERM = true, AFTER_DRAIN = false, INIT_ACC = false;
    bf16_t* O; const PG8_LAS float* tab;
    __device__ __forceinline__ void operator()(const f32x4 (&acc)[2][2][4][2], const Unit& u, int wr, int wc, int fr, int fq) const {
        asm volatile("" : "+v"(fr), "+v"(fq));
        const int row0 = u.pm * BM + wr * 64 + fr, bcol0 = u.pn * BM + wc * 32 + 8 * fq, ocol0 = u.pn * HALF + wc * 32 + 8 * fq;
        f32x4 bv[2][2]; tab_bias(tab, u, wc, fq, bv);
        float rinv[2][4]; tab_rinv(tab, u, wr, fr, rinv);
#pragma unroll
        for (int ai = 0; ai < 2; ++ai)
#pragma unroll
            for (int m = 0; m < 4; ++m) { const float ri = rinv[ai][m]; bf16_t* rowp = O + (size_t)(row0 + ai * HALF + m * 16) * DFF + ocol0;
                f32x4 hv[2];
#pragma unroll
                for (int n = 0; n < 2; ++n) { const f32x4 g = acc[ai][0][m][n] * ri + bv[0][n], up = acc[ai][1][m][n] * ri + bv[1][n];
#pragma unroll
                    for (int e = 0; e < 4; ++e) hv[n][e] = g[e] * up[e] * sigm(g[e]); }
                *(u32x4*)rowp = pack8(hv[0], hv[1]);
                if (m & 1) asm volatile("" ::: "memory"); }
    }
};
struct EpiCin {
    static constexpr bool PERM = true, AFTER_DRAIN = false, INIT_ACC = false;
    bf16_t* O; const PG8_LAS float* tab;
    template <int KIND> __device__ __forceinline__ void run(const f32x4 (&acc)[2][2][4][2], const f32x4 (&bv)[2][2], const float (&rinv)[2][4], bf16_t* base) const {
#pragma unroll
        for (int ai = 0; ai < 2; ++ai)
#pragma unroll
            for (int m = 0; m < 4; ++m) { const float ri = rinv[ai][m]; bf16_t* rowp = base + (size_t)(ai * HALF + m * 16) * 1536;
                f32x4 z0[2], z1[2];
#pragma unroll
                for (int n = 0; n < 2; ++n) { z0[n] = acc[ai][0][m][n] * ri + bv[0][n]; z1[n] = acc[ai][1][m][n] * ri + bv[1][n]; }
                if (KIND == 2) { *(u32x4*)rowp = pack8(z0[0], z0[1]); *(u32x4*)(rowp + HALF) = pack8(z1[0], z1[1]); }
                else { f32x4 o[2];
#pragma unroll
                    for (int n = 0; n < 2; ++n)
#pragma unroll
                        for (int e = 0; e < 4; ++e) o[n][e] = KIND == 0 ? z0[n][e] * sigm(z1[n][e]) : z0[n][e] * z1[n][e];
                    *(u32x4*)rowp = pack8(o[0], o[1]); }
                asm volatile("" ::: "memory"); }
    }
    __device__ __forceinline__ void operator()(const f32x4 (&acc)[2][2][4][2], const Unit& u, int wr, int wc, int fr, int fq) const {
        asm volatile("" : "+v"(fr), "+v"(fq));
        const int row0 = u.pm * BM + wr * 64 + fr, bcol0 = u.pn * BM + wc * 32 + 8 * fq;
        f32x4 bv[2][2]; tab_bias(tab, u, wc, fq, bv);
        float rinv[2][4]; tab_rinv(tab, u, wr, fr, rinv);
        const int ocol0 = (u.pn >= 8 ? 1024 + 256 * (u.pn - 8) : 128 * u.pn) + wc * 32 + 8 * fq;
        bf16_t* base = O + (size_t)row0 * 1536 + ocol0;
        if (u.pn < 4) run<0>(acc, bv, rinv, base); else if (u.pn < 8) run<1>(acc, bv, rinv, base); else run<2>(acc, bv, rinv, base);
    }
};
struct EpiPin {
    static constexpr bool PERM = true, AFTER_DRAIN = false, INIT_ACC = false;
    bf16_t* O; const PG8_LAS float* tab;
    __device__ __forceinline__ void operator()(const f32x4 (&acc)[2][2][4][2], const Unit& u, int wr, int wc, int fr, int fq) const {
        asm volatile("" : "+v"(fr), "+v"(fq));
        const int row0 = u.pm * BM + wr * 64 + fr, bcol0 = u.pn * BM + wc * 32 + 8 * fq;
        f32x4 bv[2][2]; tab_bias(tab, u, wc, fq, bv);
        float rinv[2][4]; tab_rinv(tab, u, wr, fr, rinv);
        const int t = u.pn >> 1; const int slot = t == 0 ? 3 : t - 1;
        const float sc = t == 1 ? QSCALE : 1.0f;
        bf16_t* base = O + (size_t)slot * ((size_t)M * 512) + (size_t)row0 * 512 + 256 * (u.pn & 1) + wc * 32 + 8 * fq;
#pragma unroll
        for (int ai = 0; ai < 2; ++ai)
#pragma unroll
            for (int m = 0; m < 4; ++m) { const float ri = rinv[ai][m] * sc; bf16_t* rowp = base + (size_t)(ai * HALF + m * 16) * 512;
#pragma unroll
                for (int bj = 0; bj < 2; ++bj) { const f32x4 z0 = acc[ai][bj][m][0] * ri + bv[bj][0] * sc, z1 = acc[ai][bj][m][1] * ri + bv[bj][1] * sc;
                    *(u32x4*)(rowp + bj * HALF) = pack8(z0, z1); }
                asm volatile("" ::: "memory"); }
    }
};
struct EpiRes {
    static constexpr bool PERM = false, AFTER_DRAIN = true, INIT_ACC = true;
    const float* xin; float* xout; bf16_t* xb; const float* bias; float* ssq;
    __device__ __forceinline__ void init(f32x4 (&acc)[2][2][4][2], const Unit& u, int wr, int wc, int fr, int fq) const {
        const int col0 = u.pn * BM + wc * 32 + 4 * fq;
#pragma unroll
        for (int ai = 0; ai < 2; ++ai)
#pragma unroll
            for (int m = 0; m < 4; ++m) { const size_t off = (size_t)(u.pm * BM + ai * HALF + wr * 64 + m * 16 + fr) * D + col0;
#pragma unroll
                for (int bj = 0; bj < 2; ++bj)
#pragma unroll
                    for (int n = 0; n < 2; ++n) acc[ai][bj][m][n] = *(const f32x4*)(xin + off + bj * HALF + n * 16); }
        if (bias) {
#pragma unroll
            for (int bj = 0; bj < 2; ++bj)
#pragma unroll
                for (int n = 0; n < 2; ++n) { const f32x4 bv = *(const f32x4*)(bias + col0 + bj * HALF + n * 16);
#pragma unroll
                    for (int ai = 0; ai < 2; ++ai)
#pragma unroll
                        for (int m = 0; m < 4; ++m) acc[ai][bj][m][n] += bv; }
        }
    }
    __device__ __forceinline__ void fused(f32x4 (&acc)[2][2][4][2], const Unit& u, int wr, int wc, int fr, int fq, PG8_LAS unsigned char* lds, int wid, int lane) const {
        PG8_LAS float* P = (PG8_LAS float*)lds;
        asm volatile("" : "+v"(fr), "+v"(fq));
        const int col0 = u.pn * BM + wc * 32 + 4 * fq;
#pragma unroll
        for (int ai = 0; ai < 2; ++ai)
#pragma unroll
            for (int m = 0; m < 4; ++m) { const int rt = ai * HALF + wr * 64 + m * 16 + fr; const size_t off = (size_t)(u.pm * BM + rt) * D + col0; float ss = 0.f;
#pragma unroll
                for (int bj = 0; bj < 2; ++bj)
#pragma unroll
                    for (int n = 0; n < 2; ++n) { const int c = bj * HALF + n * 16; const f32x4 v = acc[ai][bj][m][n];
                        *(f32x4*)(xout + off + c) = v; ss += (v[0] * v[0] + v[1] * v[1]) + (v[2] * v[2] + v[3] * v[3]);
                        u32x2 w; w.x = cvt_pk_bf16(v[0], v[1]); w.y = cvt_pk_bf16(v[2], v[3]); *(u32x2*)(xb + off + c) = w; }
                ss += __shfl_xor(ss, 16); ss += __shfl_xor(ss, 32);
                if (fq == 0) P[rt * 4 + wc] = ss; }
        asm volatile("s_waitcnt lgkmcnt(0)" ::: "memory"); __builtin_amdgcn_s_barrier(); asm volatile("" ::: "memory");
        const int tid = wid * 64 + lane;
        if (tid < 256) { const float s = ((P[tid * 4 + 0] + P[tid * 4 + 1]) + P[tid * 4 + 2]) + P[tid * 4 + 3]; ssq[(size_t)u.pn * M + u.pm * BM + tid] = s; }
        asm volatile("s_waitcnt lgkmcnt(0)" ::: "memory"); __builtin_amdgcn_s_barrier(); asm volatile("" ::: "memory");
    }
};

template <class Epi, class Sched, bool ALIGN_EPI = false, bool SP2 = false>
__device__ __forceinline__ void gemm_phase(PG8_LAS unsigned char* lds, const Gemm g, const Sched& S, const Epi& E) {
    int tid = threadIdx.x; asm volatile("" : "+v"(tid));
    const int wid = __builtin_amdgcn_readfirstlane(tid >> 6), lane = tid & 63, wr = wid >> 2, wc = wid & 3, fr = lane & 15, fq = lane >> 4;
    const int K = g.K, nt = K / BK;
    unsigned voffA[2], voffB[2];
#pragma unroll
    for (int i = 0; i < 2; ++i) { int R, C; stage_rc(tid * 16 + i * 8192, R, C); const int Rb = Epi::PERM ? ((R & ~31) + perm32(R & 31)) : R;
        voffA[i] = (unsigned)(R * K + C) * 2u; voffB[i] = (unsigned)(Rb * K + C) * 2u; }
    const size_t kstep = (size_t)(BK * 2);
    const size_t hstep = (size_t)HALF * K * 2;
    const size_t tstep = 2 * hstep;
    const unsigned ldsw = (unsigned)wid * 1024u;
    const int aoff = lds_byte(wr * 64 + fr, fq * 8), boff = lds_byte(wc * 32 + fr, fq * 8);
#define PG8_SA(b, h) (((b) * 2 + (h)) * HTB)
#define PG8_SB(b, h) ((4 + (b) * 2 + (h)) * HTB)
#define PG8_STAGE(bufoff, gbase, voff) do { _Pragma("unroll") for (int _i = 0; _i < 2; ++_i) \
        __builtin_amdgcn_global_load_lds((const unsigned*)((const char*)(gbase) + (voff)[_i]), (PG8_LAS unsigned*)(lds + (bufoff) + ldsw + _i * 8192), 16, 0, 0); } while (0)
#define PG8_LDA(dst, b, h) do { _Pragma("unroll") for (int m = 0; m < 4; ++m) _Pragma("unroll") for (int k = 0; k < 2; ++k) dst[m][k] = *(const PG8_LAS bf16x8*)(lds + PG8_SA(b, h) + aoff + m * 2048 + k * 1024); } while (0)
#define PG8_LDB(dst, b, h) do { _Pragma("unroll") for (int n = 0; n < 2; ++n) _Pragma("unroll") for (int k = 0; k < 2; ++k) dst[n][k] = *(const PG8_LAS bf16x8*)(lds + PG8_SB(b, h) + boff + n * 2048 + k * 1024); } while (0)
#define PG8_MMA(ai, bj, At, Bt) do { __builtin_amdgcn_s_setprio(1); _Pragma("unroll") for (int m = 0; m < 4; ++m) _Pragma("unroll") for (int n = 0; n < 2; ++n) _Pragma("unroll") for (int k = 0; k < 2; ++k) \
        acc[ai][bj][m][n] = __builtin_amdgcn_mfma_f32_16x16x32_bf16(Bt[n][k], At[m][k], acc[ai][bj][m][n], 0, 0, 0); __builtin_amdgcn_s_setprio(0); } while (0)
#define PG8_WAIT_V(n) asm volatile("s_waitcnt vmcnt(" #n ")" ::: "memory")
#define PG8_WAIT_L(n) asm volatile("s_waitcnt lgkmcnt(" #n ")" ::: "memory")
#define PG8_BAR __builtin_amdgcn_s_barrier()
#define PG8_SCHED __builtin_amdgcn_sched_barrier(0)
    Unit cur, nxt; int ui = 0;
    if (!S.next(0, cur)) return;
    f32x4 acc[2][2][4][2];
    if constexpr (Epi::INIT_ACC) { E.init(acc, cur, wr, wc, fr, fq); }
    else {
#pragma unroll
    for (int a = 0; a < 2; ++a)
#pragma unroll
        for (int b = 0; b < 2; ++b)
#pragma unroll
            for (int m = 0; m < 4; ++m)
#pragma unroll
                for (int n = 0; n < 2; ++n) acc[a][b][m][n] = (f32x4){0.f, 0.f, 0.f, 0.f};
    }
    bf16x8 At[4][2], B0[2][2], B1[2][2];
    const char* cA = (const char*)g.A + (size_t)cur.pm * tstep; const char* cB = (const char*)g.Bt + (size_t)cur.pn * tstep;
    S.a_ready(cur);
    if constexpr (SP2) {
        PG8_STAGE(PG8_SB(0, 0), cB, voffB); PG8_STAGE(PG8_SB(0, 1), cB + hstep, voffB); PG8_STAGE(PG8_SA(0, 0), cA, voffA); PG8_STAGE(PG8_SA(0, 1), cA + hstep, voffA);
        if (wr == 1) PG8_BAR;
        PG8_WAIT_V(2); PG8_BAR;
        PG8_STAGE(PG8_SB(1, 0), cB + kstep, voffB); PG8_STAGE(PG8_SA(1, 0), cA + kstep, voffA); PG8_STAGE(PG8_SB(1, 1), cB + hstep + kstep, voffB);
        PG8_WAIT_V(6); PG8_BAR;
    } else {
        PG8_STAGE(PG8_SB(0, 0), cB, voffB); PG8_STAGE(PG8_SA(0, 0), cA, voffA); PG8_STAGE(PG8_SB(0, 1), cB + hstep, voffB); PG8_STAGE(PG8_SA(0, 1), cA + hstep, voffA);
        if (wr == 1) PG8_BAR;
        PG8_WAIT_V(4); PG8_BAR;
        PG8_STAGE(PG8_SB(1, 0), cB + kstep, voffB); PG8_STAGE(PG8_SA(1, 0), cA + kstep, voffA); PG8_STAGE(PG8_SB(1, 1), cB + hstep + kstep, voffB);
        PG8_WAIT_V(6); PG8_BAR;
    }
    for (;;) {
        const bool has_next = S.next(ui + 1, nxt);
        const char* nA = has_next ? (const char*)g.A + (size_t)nxt.pm * tstep : cA; const char* nB = has_next ? (const char*)g.Bt + (size_t)nxt.pn * tstep : cB;
#if defined(PROBE_KREP)
        const int ntr = Epi::INIT_ACC ? nt : nt * PROBE_KREP;
        for (int tq = 0; tq < ntr; tq += 2) {
            const int t = tq % nt;
            const bool last = (tq == ntr - 2);
            const char* a1 = cA + (size_t)(t + 1) * kstep;
            const char* a2 = last ? nA : cA + (size_t)((t + 2) % nt) * kstep; const char* b2 = last ? nB : cB + (size_t)((t + 2) % nt) * kstep;
#else
        for (int t = 0; t < nt; t += 2) {
            const bool last = (t == nt - 2);
            const char* a1 = cA + (size_t)(t + 1) * kstep;
            const char* a2 = last ? nA : cA + (size_t)(t + 2) * kstep; const char* b2 = last ? nB : cB + (size_t)(t + 2) * kstep;
#endif
            const char* a3 = a2 + kstep; const char* b3 = b2 + kstep;
            if (last && has_next) S.a_ready(nxt);
            if constexpr (SP2) {
            PG8_LDB(B0, 0, 0); PG8_LDB(B1, 0, 1); PG8_SCHED; PG8_LDA(At, 0, 0); PG8_STAGE(PG8_SA(1, 1), a1 + hstep, voffA);
            PG8_WAIT_V(8); PG8_WAIT_L(0); PG8_BAR; PG8_MMA(0, 0, At, B0); PG8_MMA(0, 1, At, B1); PG8_BAR; PG8_SCHED;
            PG8_LDA(At, 0, 1); PG8_STAGE(PG8_SB(0, 0), b2, voffB); PG8_STAGE(PG8_SB(0, 1), b2 + hstep, voffB); PG8_STAGE(PG8_SA(0, 0), a2, voffA);
            PG8_WAIT_V(8); PG8_WAIT_L(0); PG8_BAR; PG8_MMA(1, 0, At, B0); PG8_MMA(1, 1, At, B1); PG8_BAR; PG8_SCHED;
            PG8_LDB(B0, 1, 0); PG8_LDB(B1, 1, 1); PG8_SCHED; PG8_LDA(At, 1, 0); PG8_STAGE(PG8_SA(0, 1), a2 + hstep, voffA);
            PG8_WAIT_V(8); PG8_WAIT_L(0); PG8_BAR; PG8_MMA(0, 0, At, B0); PG8_MMA(0, 1, At, B1); PG8_BAR; PG8_SCHED;
            PG8_LDA(At, 1, 1); PG8_STAGE(PG8_SB(1, 0), b3, voffB); PG8_STAGE(PG8_SB(1, 1), b3 + hstep, voffB); PG8_STAGE(PG8_SA(1, 0), a3, voffA);
            PG8_WAIT_V(8); PG8_WAIT_L(0); PG8_BAR; PG8_MMA(1, 0, At, B0); PG8_MMA(1, 1, At, B1); PG8_BAR; PG8_SCHED;
            } else {
            PG8_LDB(B0, 0, 0); PG8_SCHED; PG8_LDA(At, 0, 0); PG8_STAGE(PG8_SA(1, 1), a1 + hstep, voffA);
            PG8_WAIT_L(8); PG8_BAR; PG8_WAIT_L(0); PG8_MMA(0, 0, At, B0); PG8_BAR; PG8_SCHED;
            PG8_LDB(B1, 0, 1); PG8_STAGE(PG8_SB(0, 0), b2, voffB);
            PG8_BAR; PG8_WAIT_L(0); PG8_MMA(0, 1, At, B1); PG8_BAR;
            PG8_LDA(At, 0, 1); PG8_STAGE(PG8_SA(0, 0), a2, voffA);
            PG8_BAR; PG8_WAIT_L(0); PG8_MMA(1, 0, At, B0); PG8_BAR; PG8_SCHED;
            PG8_STAGE(PG8_SB(0, 1), b2 + hstep, voffB);
            PG8_WAIT_V(6); PG8_BAR; PG8_MMA(1, 1, At, B1); PG8_BAR;
            PG8_LDB(B0, 1, 0); PG8_SCHED; PG8_LDA(At, 1, 0); PG8_STAGE(PG8_SA(0, 1), a2 + hstep, voffA);
            PG8_WAIT_L(8); PG8_BAR; PG8_WAIT_L(0); PG8_MMA(0, 0, At, B0); PG8_BAR; PG8_SCHED;
            PG8_LDB(B1, 1, 1); PG8_STAGE(PG8_SB(1, 0), b3, voffB);
            PG8_BAR; PG8_WAIT_L(0); PG8_MMA(0, 1, At, B1); PG8_BAR;
            PG8_LDA(At, 1, 1); PG8_STAGE(PG8_SA(1, 0), a3, voffA);
            PG8_BAR; PG8_WAIT_L(0); PG8_MMA(1, 0, At, B0); PG8_BAR; PG8_SCHED;
            PG8_STAGE(PG8_SB(1, 1), b3 + hstep, voffB);
            PG8_WAIT_V(6); PG8_BAR; PG8_MMA(1, 1, At, B1); PG8_BAR;
            }
        }
        if constexpr (ALIGN_EPI) { if (wr == 0) PG8_BAR; }
#if defined(PROBE_KREP)
        if constexpr (!Epi::INIT_ACC) {
#pragma unroll
            for (int a = 0; a < 2; ++a)
#pragma unroll
                for (int b = 0; b < 2; ++b)
#pragma unroll
                    for (int m = 0; m < 4; ++m)
#pragma unroll
                        for (int n = 0; n < 2; ++n) acc[a][b][m][n] = acc[a][b][m][n] * (1.0f / PROBE_KREP); }
#endif
        if constexpr (!Epi::AFTER_DRAIN) { E(acc, cur, wr, wc, fr, fq); S.done(cur);
#ifdef PROBE_EPI2
            for (int pe_ = 0; pe_ < PROBE_EPI2; ++pe_) { asm volatile("" ::: "memory"); E(acc, cur, wr, wc, fr, fq); }
#endif
        }
        if (!has_next) break;
#pragma unroll
        for (int a = 0; a < 2; ++a)
#pragma unroll
            for (int b = 0; b < 2; ++b)
#pragma unroll
                for (int m = 0; m < 4; ++m)
#pragma unroll
                    for (int n = 0; n < 2; ++n) acc[a][b][m][n] = (f32x4){0.f, 0.f, 0.f, 0.f};
        cur = nxt; cA = nA; cB = nB; ++ui;
        if constexpr (ALIGN_EPI) { if (wr == 1) PG8_BAR; }
    }
    PG8_WAIT_V(0);
    if constexpr (!ALIGN_EPI) { if (wr == 0) PG8_BAR; }
    PG8_BAR;
    if constexpr (Epi::AFTER_DRAIN) { E.fused(acc, cur, wr, wc, fr, fq, lds, wid, lane); S.done(cur); }
#undef PG8_SA
#undef PG8_SB
#undef PG8_STAGE
#undef PG8_LDA
#undef PG8_LDB
#undef PG8_MMA
#undef PG8_WAIT_V
#undef PG8_WAIT_L
#undef PG8_BAR
#undef PG8_SCHED
}
}
#define GAS __attribute__((address_space(1)))
#define LAS __attribute__((address_space(3)))
typedef unsigned short bf16;
typedef unsigned v4u __attribute__((ext_vector_type(4)));
typedef float f32x4 __attribute__((ext_vector_type(4)));
typedef short bf16x8 __attribute__((ext_vector_type(8)));
typedef GAS unsigned gu32;
typedef GAS unsigned long long gu64;
#define RLX_AGENT __ATOMIC_RELAXED, __HIP_MEMORY_SCOPE_AGENT
#define LDS_WAIT() asm volatile("s_waitcnt lgkmcnt(0)" ::: "memory")
#define VM_WAIT() asm volatile("s_waitcnt vmcnt(0)" ::: "memory")
__device__ __forceinline__ unsigned long long rt() { return __builtin_amdgcn_s_memrealtime(); }
__device__ __forceinline__ unsigned f2bf(float f) { unsigned u = __builtin_bit_cast(unsigned, f); return (u + 0x7fffu + ((u >> 16) & 1u)) >> 16; }
__device__ __forceinline__ unsigned pk2(float lo, float hi) { return f2bf(lo) | (f2bf(hi) << 16); }

#define XB_TMO      128
#define XB_XCNT(j)  (256  + 64 * (j))
#define XB_XSUB(j)  (1280 + 64 * (j))
#define XB_XGEN(j)  (2304 + 64 * (j))
#define XB_TOP      3328
#define XB_TOPGEN   3392
#define XCD_BAR_WORDS 3456
#define XB_SPIN_CAP (1u << 18)

__device__ __forceinline__ unsigned xb_ld(unsigned* p)              { return __hip_atomic_load(p, __ATOMIC_RELAXED, __HIP_MEMORY_SCOPE_AGENT); }
__device__ __forceinline__ unsigned xb_add(unsigned* p, unsigned v) { return __hip_atomic_fetch_add(p, v, __ATOMIC_RELAXED, __HIP_MEMORY_SCOPE_AGENT); }
__device__ __forceinline__ unsigned xb_xcc_id() { return (unsigned)__builtin_amdgcn_s_getreg((3 << 11) | 20) & 0xFu; }
#define XB_SPIN(cond, bar) do { unsigned _sp = 0; while (cond) { __builtin_amdgcn_s_sleep(1); \
    if ((++_sp & 255u) == 0u) { if (xb_ld(&(bar)[XB_TMO])) break; if (_sp > XB_SPIN_CAP) { atomicAdd(&(bar)[XB_TMO], 1u); break; } } } } while (0)

struct XcdBarrier {
    unsigned* bar; unsigned x;
    volatile LAS unsigned* st;
};

__device__ __forceinline__ XcdBarrier xcd_barrier_post(unsigned* bar, volatile LAS unsigned* st) {
    XcdBarrier b; b.bar = bar; b.x = xb_xcc_id(); b.st = st;
    if (threadIdx.x == 0) st[2] = xb_add(&bar[XB_XCNT(b.x)], 1u);
    return b;
}
__device__ __forceinline__ void xcd_barrier_complete(unsigned* bar, unsigned x, unsigned& nloc, unsigned& nx) {
    const unsigned G = gridDim.x * gridDim.y * gridDim.z;
    unsigned sum, cnt, mine, sp = 0u;
    for (;;) {
        sum = 0u; cnt = 0u; mine = 0u;
#pragma unroll
        for (unsigned j = 0; j < 16; ++j) { const unsigned c = xb_ld(&bar[XB_XCNT(j)]); sum += c; cnt += (c > 0u) ? 1u : 0u; mine = (j == x) ? c : mine; }
        if (sum == G) break;
        __builtin_amdgcn_s_sleep(1);
        if ((++sp & 255u) == 0u) { if (xb_ld(&bar[XB_TMO])) break; if (sp > XB_SPIN_CAP) { atomicAdd(&bar[XB_TMO], 1u); break; } }
    }
    nloc = mine > 0u ? mine : 1u; nx = cnt > 0u ? cnt : 1u;
}

__device__ __forceinline__ void xcd_barrier(const XcdBarrier& b) {
    asm volatile("s_waitcnt vmcnt(0)" ::: "memory");
    __syncthreads();
    if (threadIdx.x == 0) {
        unsigned* bar = b.bar;
        __builtin_amdgcn_s_waitcnt(0);
        unsigned nloc = b.st[0], nx = b.st[1];
        if (nloc == 0u) { xcd_barrier_complete(bar, b.x, nloc, nx); b.st[0] = nloc; b.st[1] = nx; }
        const unsigned old = xb_add(&bar[XB_XSUB(b.x)], 1u);
        const unsigned gen = old / nloc;
        if (old + 1u == (gen + 1u) * nloc) {
            __builtin_amdgcn_fence(__ATOMIC_RELEASE, "agent");
            asm volatile("s_waitcnt vmcnt(0)" ::: "memory");
            const unsigned og = xb_add(&bar[XB_TOP], 1u);
            const unsigned tg = og / nx;
            if (og + 1u == (tg + 1u) * nx) xb_add(&bar[XB_TOPGEN], 1u);
            else XB_SPIN(xb_ld(&bar[XB_TOPGEN]) == tg, bar);
            __builtin_amdgcn_fence(__ATOMIC_ACQUIRE, "agent");
            xb_add(&bar[XB_XGEN(b.x)], 1u);
            asm volatile("s_waitcnt vmcnt(0)" ::: "memory");
        } else {
            XB_SPIN(xb_ld(&bar[XB_XGEN(b.x)]) == gen, bar);
            __builtin_amdgcn_fence(__ATOMIC_ACQUIRE, "agent");
            asm volatile("s_waitcnt vmcnt(0)" ::: "memory");
        }
    }
    __syncthreads();
}

constexpr size_t MiB = 1u << 20;
constexpr size_t WS_CTL = 0, CTL_ZERO_BYTES = 1 * MiB;
constexpr size_t WS_MOD = 1 * MiB;
constexpr size_t WS_BGU = WS_MOD + 128 * 1024;
constexpr size_t WS_BCIN = WS_MOD + 256 * 1024;
constexpr size_t WS_BPIN = WS_MOD + 272 * 1024;
constexpr size_t WS_BEFF = WS_MOD + 288 * 1024;
constexpr size_t WS_BPOUT = WS_MOD + 296 * 1024;
constexpr size_t WS_KMEAN = WS_MOD + 512 * 1024;
constexpr size_t WS_SSQ = 2 * MiB;
constexpr size_t WS_ML = 3 * MiB;
constexpr size_t WS_WEFF = 6 * MiB;
constexpr size_t WS_WGU = 8 * MiB;
constexpr size_t WS_WDN = 52 * MiB;
constexpr size_t WS_WCIN = 74 * MiB, WS_WCOUT = 79 * MiB, WS_WPIN = 81 * MiB, WS_WPOUT = 85 * MiB;
constexpr size_t WS_XB = 88 * MiB;
constexpr size_t WS_R1 = 120 * MiB;
constexpr size_t WS_Q = WS_R1, WS_K = WS_R1 + 16 * MiB, WS_V = WS_R1 + 32 * MiB, WS_U = WS_R1 + 48 * MiB, WS_LIST = WS_R1 + 64 * MiB;
constexpr size_t WS_MIX = 208 * MiB;
constexpr size_t WS_PO = 240 * MiB;
constexpr size_t WS_END = 288 * MiB;
constexpr int LIST_PER_HEAD = 256 * 2016;
static_assert(WS_R1 + (size_t)M * DFF * 2 <= WS_MIX && WS_LIST + (size_t)8 * LIST_PER_HEAD * 4 <= WS_MIX && WS_PO + (size_t)3 * M * 512 * 2 <= WS_END, "d_ws map");
constexpr int CW_TMO = 0, CW_CODE = 1, CW_BAR = 4096, CW_CUR = 8192, CUR_STRIDE = 16;

constexpr int RING_OFF = 0, RING_BYTES = 131072;
constexpr int LDSCTL_OFF = RING_BYTES, MISC_OFF = LDSCTL_OFF + 320;
constexpr int TAB_OFF = LDSCTL_OFF + 1024;
constexpr int LDS_BYTES = 147456;
static_assert(TAB_OFF + 2 * 6 * 256 * 4 <= LDS_BYTES, "LDS map");

enum Phase { PH_P0 = 0, PH_P1, PH_L0_GU1, PH_L0_DN1, PH_L0_CIN, PH_L0_CONV, PH_L0_COUT, PH_L0_GU2, PH_L0_DN2,
             PH_L1_GU1, PH_L1_DN1, PH_L1_PIN, PH_L1_PRE, PH_L1_SEL, PH_L1_ATTA, PH_L1_ATTB, PH_L1_POUT, PH_L1_GU2, PH_L1_DN2, PH_FINAL, NPHASE };
constexpr int NWAVES = 8;
constexpr int N_LAUNCHES = MK_N_LAUNCHES;

struct Frame {
    LAS unsigned char* lds;
    volatile LAS unsigned* MISC;
    gu32* ctl;
    int tid, lane, wave, G, bx;
    float* out;
    unsigned char* ws;
};
enum InIdx { IN_X = 0, IN_C, IN_ADA_W, IN_ADA_B, IN_FFN_NORM, IN_W_GATE, IN_W_UP, IN_W_DOWN, IN_MIX_NORM, IN_CONV_W_IN, IN_CONV_A_W, IN_CONV_A_B, IN_LN_A_G, IN_LN_A_B, IN_CONV_B_W,
             IN_CONV_W_OUT, IN_PM_W_IN, IN_POOL_W, IN_POOL_B, IN_POOL_SCALE, IN_PM_W_OUT, IN_FINAL_NORM };
typedef __attribute__((address_space(4))) const unsigned char* kptr_t;
__device__ __forceinline__ const float* inptr(int i) {
    kptr_t p = (kptr_t)__builtin_amdgcn_kernarg_segment_ptr(); asm volatile("" : "+s"(p));
    return *(const float* const __attribute__((address_space(4)))*)(p + 8 * i);
}
#define WSP(T, off) ((T*)(F.ws + (off)))

__device__ __forceinline__ float wave_sum(float v) {
#pragma unroll
    for (int o = 1; o < 64; o <<= 1) v += __shfl_xor(v, o);
    return v;
}
__device__ __forceinline__ float bf2f(unsigned h) { return __uint_as_float(h << 16); }
__device__ __forceinline__ void wg_sync() { __syncthreads(); }

__device__ __forceinline__ void p0_phase(Frame& F) {
    LAS float* sm = (LAS float*)F.lds;
    LAS float* red = sm + 1024;
    const float* cvec = inptr(IN_C); const float* ada_w = inptr(IN_ADA_W); const float* ada_b = inptr(IN_ADA_B);
    for (int k = F.tid; k < 1024; k += NWAVES * 64) { const float v = cvec[k]; sm[k] = v / (1.0f + expf(-v)); }
    wg_sync();
    for (int wg = F.bx; wg < 256; wg += F.G) {
        const int layer = wg >> 7, cbase = (wg & 127) * 72;
        const float* W = ada_w + (size_t)layer * 1024 * 9216 + cbase;
        const int rr = F.lane / 18, cc = F.lane - rr * 18;
        f32x4 acc = {0.f, 0.f, 0.f, 0.f};
        if (rr < 3) {
            const int kb = 128 * F.wave;
#pragma unroll 8
            for (int it = 0; it < 43; ++it) { const int kk = 3 * it + rr; if (kk < 128) { const int k = kb + kk; const f32x4 w = *(const f32x4*)(W + (size_t)k * 9216 + 4 * cc); acc += w * sm[k]; } }
#pragma unroll
            for (int e = 0; e < 4; ++e) red[(F.wave * 3 + rr) * 72 + 4 * cc + e] = acc[e];
        }
        wg_sync();
        if (F.tid < 72) { float s = ada_b[layer * 9216 + cbase + F.tid];
            for (int j = 0; j < 24; ++j) s += red[j * 72 + F.tid];
            WSP(float, WS_MOD)[layer * 9216 + cbase + F.tid] = s; }
        wg_sync();
    }
    { const int gw = F.bx * NWAVES + F.wave, NGW = F.G * NWAVES; bf16* XB = WSP(bf16, WS_XB); float* SSQ = WSP(float, WS_SSQ); const float* xin = inptr(IN_X);
      for (int m0 = gw * 8; m0 < M; m0 += NGW * 8) {
          f32x4 v[8][4];
#pragma unroll
          for (int rr = 0; rr < 8; ++rr)
#pragma unroll
              for (int j = 0; j < 4; ++j) v[rr][j] = ((const f32x4*)(xin + (size_t)(m0 + rr) * D))[F.lane + 64 * j];
#pragma unroll
          for (int rr = 0; rr < 8; ++rr) { float s = 0.f;
#pragma unroll
              for (int j = 0; j < 4; ++j) s += (v[rr][j][0] * v[rr][j][0] + v[rr][j][1] * v[rr][j][1]) + (v[rr][j][2] * v[rr][j][2] + v[rr][j][3] * v[rr][j][3]);
              s = wave_sum(s);
              unsigned long long* o8 = (unsigned long long*)(XB + (size_t)(m0 + rr) * D) + F.lane;
#pragma unroll
              for (int j = 0; j < 4; ++j) o8[64 * j] = (unsigned long long)pk2(v[rr][j][0], v[rr][j][1]) | ((unsigned long long)pk2(v[rr][j][2], v[rr][j][3]) << 32);
              if (F.lane < 4) SSQ[(size_t)F.lane * M + m0 + rr] = F.lane == 0 ? s : 0.f; }
      } }
    const float* pool_w = inptr(IN_POOL_W); const float* pool_scale = inptr(IN_POOL_SCALE); const float* pm_w_out = inptr(IN_PM_W_OUT); const float* pool_b = inptr(IN_POOL_B);
    for (int gid = F.bx * NWAVES * 64 + F.tid; gid < 512 * 256; gid += F.G * NWAVES * 64) {
        const int krow = gid >> 8, n4 = (gid & 255) * 4, g = krow >> 7;
        const float* pw = pool_w + (size_t)krow * 128; const float* ps = pool_scale + g * 128; const float* wo = pm_w_out + (size_t)(g * 128) * 1024 + n4;
        f32x4 acc = {0.f, 0.f, 0.f, 0.f};
#pragma unroll 8
        for (int d = 0; d < 128; ++d) { const float a = pw[d] * ps[d]; acc += *(const f32x4*)(wo + (size_t)d * 1024) * a; }
        *(f32x4*)(WSP(float, WS_WEFF) + (size_t)krow * 1024 + n4) = acc;
    }
    for (int wg = F.bx; wg < 16; wg += F.G) {
        const int n = wg * 64 + F.lane; float sacc = 0.f;
#pragma unroll 16
        for (int kk = 0; kk < 64; ++kk) { const int k = F.wave * 64 + kk; sacc += pool_b[k] * pool_scale[k] * pm_w_out[(size_t)k * 1024 + n]; }
        wg_sync();
        red[F.wave * 64 + F.lane] = sacc;
        wg_sync();
        if (F.tid < 64) { float t = 0.f;
#pragma unroll
            for (int w = 0; w < NWAVES; ++w) t += red[w * 64 + F.tid];
            WSP(float, WS_BEFF)[wg * 64 + F.tid] = t; }
    }
}

__device__ __forceinline__ void prep_strip(Frame& F, const float* src, int ldn, const float* src2, int ksplit, int kbeg, int ktiles,
                                           bf16* dst, int ldk, bool useG, const LAS float* Gs, const LAS float* Ss, const float* rsc, float rs_mul, float* bias_out, LAS float* red) {
    const int r = F.lane >> 4, c16 = F.lane & 15;
    f32x4 rs = {rs_mul, rs_mul, rs_mul, rs_mul};
    if (rsc) { const f32x4 g = *(const f32x4*)(rsc + 4 * c16); rs = g * rs_mul; }
    f32x4 bacc = {0.f, 0.f, 0.f, 0.f};
    for (int t = F.wave; t < ktiles; t += NWAVES) {
        const int k0 = kbeg + 64 * t + 16 * r;
        f32x4 v[16];
#pragma unroll
        for (int i = 0; i < 16; ++i) { const int k = k0 + i; const float* p = (src2 && k >= ksplit) ? src2 + (size_t)k * ldn : src + (size_t)k * ldn; v[i] = *(const f32x4*)(p + 4 * c16); }
        if (useG) {
#pragma unroll
            for (int i = 0; i < 16; ++i) { bacc += v[i] * Ss[k0 + i]; v[i] = v[i] * Gs[k0 + i]; }
        }
#pragma unroll
        for (int e = 0; e < 4; ++e) {
            v4u lo, hi; const float s = rs[e];
            lo.x = pk2(v[0][e] * s, v[1][e] * s);   lo.y = pk2(v[2][e] * s, v[3][e] * s);   lo.z = pk2(v[4][e] * s, v[5][e] * s);   lo.w = pk2(v[6][e] * s, v[7][e] * s);
            hi.x = pk2(v[8][e] * s, v[9][e] * s);   hi.y = pk2(v[10][e] * s, v[11][e] * s); hi.z = pk2(v[12][e] * s, v[13][e] * s); hi.w = pk2(v[14][e] * s, v[15][e] * s);
            bf16* o = dst + (size_t)(4 * c16 + e) * ldk + k0;
            *(v4u*)o = lo; *(v4u*)(o + 8) = hi;
        }
    }
    if (bias_out) {
#pragma unroll
        for (int e = 0; e < 4; ++e) { float s = bacc[e]; s += __shfl_xor(s, 16); s += __shfl_xor(s, 32); bacc[e] = s; }
        if (r == 0) {
#pragma unroll
            for (int e = 0; e < 4; ++e) red[F.wave * 64 + 4 * c16 + e] = bacc[e];
        }
        wg_sync();
        if (F.tid < 64) { float s = 0.f;
#pragma unroll
            for (int w = 0; w < NWAVES; ++w) s += red[w * 64 + F.tid];
            bias_out[F.tid] = s; }
        wg_sync();
    }
}
__device__ __forceinline__ void p1_phase(Frame& F) {
    LAS float* Gs = (LAS float*)F.lds;
    LAS float* Ss = Gs + 1024;
    LAS float* red = Ss + 1024;
    const float* MOD = WSP(float, WS_MOD);
    constexpr int N_GU = 352, N_CIN = 40, N_PIN = 32, N_COUT = 16, N_POUT = 16, N_DN = 256;
    constexpr int NITEMS = N_GU + N_CIN + N_PIN + N_COUT + N_POUT + N_DN;
    for (int it = F.bx; it < NITEMS; it += F.G) {
        int s = it;
        if (s < N_GU + N_CIN + N_PIN) {
            const float *nrm, *md; const float* src; int ldn; bf16* dst; float* bias; int n0, drow;
            if (s < N_GU) { const int f = s / 88, r = s % 88, isup = r / 44; n0 = (r % 44) * 64;
                src = inptr(isup ? IN_W_UP : IN_W_GATE) + (size_t)f * 1024 * DFF + n0; ldn = DFF;
                drow = 256 * (n0 / 128) + 128 * isup + (n0 % 128); dst = WSP(bf16, WS_WGU) + (size_t)f * NGU * 1024 + (size_t)drow * 1024; bias = WSP(float, WS_BGU) + f * NGU + drow;
                nrm = inptr(IN_FFN_NORM) + f * 1024; md = MOD + (f >> 1) * 9216 + ((f & 1) ? 6 : 0) * 1024; }
            else if (s < N_GU + N_CIN) { s -= N_GU; n0 = s * 64; const int seg = n0 / 512, c = n0 % 512, t2 = 256 * (c / 128) + (c % 128);
                drow = seg == 0 ? t2 : seg == 1 ? t2 + 128 : seg == 2 ? 2048 + c : seg == 3 ? 1024 + t2 : 1024 + t2 + 128;
                src = inptr(IN_CONV_W_IN) + n0; ldn = NCIN; dst = WSP(bf16, WS_WCIN) + (size_t)drow * 1024; bias = WSP(float, WS_BCIN) + drow;
                nrm = inptr(IN_MIX_NORM); md = MOD + 3 * 1024; }
            else { s -= N_GU + N_CIN; n0 = s * 64; drow = n0;
                src = inptr(IN_PM_W_IN) + n0; ldn = NPIN; dst = WSP(bf16, WS_WPIN) + (size_t)drow * 1024; bias = WSP(float, WS_BPIN) + drow;
                nrm = inptr(IN_MIX_NORM) + 1024; md = MOD + 9216 + 3 * 1024; }
            for (int k = F.tid; k < 1024; k += NWAVES * 64) { Gs[k] = nrm[k] * (1.0f + md[1024 + k]); Ss[k] = md[k]; }
            wg_sync();
            prep_strip(F, src, ldn, nullptr, 0, 0, 16, dst, 1024, true, Gs, Ss, nullptr, 1.0f, bias, red);
            continue;
        }
        s -= N_GU + N_CIN + N_PIN;
        if (s < N_COUT) { const int n0 = s * 64;
            prep_strip(F, inptr(IN_CONV_W_OUT) + n0, 1024, nullptr, 0, 0, 16, WSP(bf16, WS_WCOUT) + (size_t)n0 * 1024, 1024, false, Gs, Ss, MOD + 5 * 1024 + n0, 1.0f, nullptr, red);
            continue; }
        s -= N_COUT;
        if (s < N_POUT) { const int n0 = s * 64; const float* gate = MOD + 9216 + 5 * 1024 + n0;
            prep_strip(F, WSP(float, WS_WEFF) + n0, 1024, inptr(IN_PM_W_OUT) + n0, 512, 0, 16, WSP(bf16, WS_WPOUT) + (size_t)n0 * 1024, 1024, false, Gs, Ss, gate, 1.0f, nullptr, red);
            if (F.tid < 64) WSP(float, WS_BPOUT)[n0 + F.tid] = gate[F.tid] * WSP(float, WS_BEFF)[n0 + F.tid];
            continue; }
        s -= N_POUT;
        { const int f = s / 64, r = s % 64, n0 = (r >> 2) * 64, kq = r & 3;
          const float* gate = MOD + (f >> 1) * 9216 + (((f & 1) ? 6 : 0) + 2) * 1024 + n0;
          prep_strip(F, inptr(IN_W_DOWN) + (size_t)f * DFF * 1024 + n0, 1024, nullptr, 0, 704 * kq, 11, WSP(bf16, WS_WDN) + (size_t)f * 1024 * DFF + (size_t)n0 * DFF, DFF, false, Gs, Ss, gate, 0.5f, nullptr, red); }
    }
}

__device__ __forceinline__ void conv_phase(Frame& F) {
    const bf16* ZC = WSP(bf16, WS_R1); bf16* MIX = WSP(bf16, WS_MIX);
    const int c = F.wave * 64 + F.lane, lane = F.lane;
    LAS float* Y = (LAS float*)F.lds + F.wave * 4096;
    const float* conv_a_w = inptr(IN_CONV_A_W); const float* conv_b_w = inptr(IN_CONV_B_W);
    float w[31];
#pragma unroll
    for (int k = 0; k < 31; ++k) w[k] = conv_a_w[k * 512 + c];
    const float cb = inptr(IN_CONV_A_B)[c], lg = inptr(IN_LN_A_G)[c], lb = inptr(IN_LN_A_B)[c];
    const float w0 = conv_b_w[c], w1 = conv_b_w[512 + c], w2 = conv_b_w[1024 + c];
    const unsigned coff = (unsigned)c * 2u;
    for (int unit = F.bx; unit < M / 64; unit += F.G) {
        const int t0 = __builtin_amdgcn_readfirstlane(unit * 64);
#pragma unroll 1
        for (int hf = 0; hf < 2; ++hf) {
            float a[62]; const int tb = t0 + 32 * hf - 30;
#pragma unroll
            for (int i = 0; i < 62; ++i) { const int t = tb + i; const char* zr = (const char*)ZC + (size_t)(t < 0 ? 0 : t) * 3072; const float v = bf2f(*(const unsigned short*)(zr + coff)); a[i] = t < 0 ? 0.f : v; }
            LAS float* Yh = Y + hf * 2048;
#pragma unroll
            for (int tt = 0; tt < 32; ++tt) { float y = cb;
#pragma unroll
                for (int k = 0; k < 31; ++k) y += w[k] * a[tt + k];
                Yh[tt * 64 + lane] = y; } }
        float mean, rstd;
        { float s1 = 0.f;
#pragma unroll 4
          for (int cc = 0; cc < 64; ++cc) s1 += Y[lane * 64 + ((cc + lane) & 63)];
          mean = s1 * (1.0f / 64.0f); float s2 = 0.f;
#pragma unroll 4
          for (int cc = 0; cc < 64; ++cc) { const float d = Y[lane * 64 + ((cc + lane) & 63)] - mean; s2 += d * d; }
          rstd = 1.0f / sqrtf(s2 * (1.0f / 64.0f) + EPS); }
        char* mrow0 = (char*)MIX + (size_t)t0 * 2048;
#pragma unroll
        for (int tt = 0; tt < 64; ++tt) {
            const float m = __builtin_bit_cast(float, __builtin_amdgcn_readlane(__builtin_bit_cast(int, mean), tt)), r = __builtin_bit_cast(float, __builtin_amdgcn_readlane(__builtin_bit_cast(int, rstd), tt));
            const float yn = (Y[tt * 64 + lane] - m) * r * lg + lb;
            const float sv = yn * __builtin_amdgcn_rcpf(1.0f + __builtin_amdgcn_exp2f(-LOG2E * yn));
            *(unsigned short*)(mrow0 + (size_t)tt * 2048 + coff) = (unsigned short)f2bf(sv); }
        { float cv[66];
#pragma unroll
          for (int i = 0; i < 66; ++i) { const int t = t0 - 2 + i; const char* zr = (const char*)ZC + (size_t)(t < 0 ? 0 : t) * 3072 + 1024; const float v = bf2f(*(const unsigned short*)(zr + coff)); cv[i] = t < 0 ? 0.f : v; }
          const char* zb = (const char*)ZC + (size_t)t0 * 3072 + 2048;
#pragma unroll
          for (int tt = 0; tt < 64; ++tt) { const float bg = bf2f(*(const unsigned short*)(zb + (size_t)tt * 3072 + coff));
              *(unsigned short*)(mrow0 + (size_t)tt * 2048 + 1024 + coff) = (unsigned short)f2bf(bg * (w0 * cv[tt] + w1 * cv[tt + 1] + w2 * cv[tt + 2])); } }
    }
}

__device__ __forceinline__ void unpack8(const v4u q, float (&v)[8]) {
    v[0] = bf2f(q.x & 0xffffu); v[1] = bf2f(q.x >> 16); v[2] = bf2f(q.y & 0xffffu); v[3] = bf2f(q.y >> 16); v[4] = bf2f(q.z & 0xffffu); v[5] = bf2f(q.z >> 16); v[6] = bf2f(q.w & 0xffffu); v[7] = bf2f(q.w >> 16); }
template <int W> __device__ __forceinline__ void pool_strip(const bf16* U, bf16* MIX, int t0, int ch) {
    v4u r[7 + W];
#pragma unroll
    for (int k = 0; k < 7 + W; ++k) { const int t = t0 - (W - 1) + k; const v4u q = *(const v4u*)(U + (size_t)(t < 0 ? 0 : t) * 512 + ch * 8); r[k] = t < 0 ? (v4u){0u, 0u, 0u, 0u} : q; }
    float s[8];
#pragma unroll
    for (int e = 0; e < 8; ++e) s[e] = 0.f;
#pragma unroll
    for (int k = 0; k < W - 1; ++k) { float v[8]; unpack8(r[k], v);
#pragma unroll
        for (int e = 0; e < 8; ++e) s[e] += v[e]; }
#pragma unroll
    for (int i = 0; i < 8; ++i) { float cur[8]; unpack8(r[i + W - 1], cur);
#pragma unroll
        for (int e = 0; e < 8; ++e) s[e] += cur[e];
        const int t = t0 + i; const float inv = 1.0f / (float)((t + 1) < W ? (t + 1) : W); v4u o;
        o.x = pk2(s[0] * inv - cur[0], s[1] * inv - cur[1]); o.y = pk2(s[2] * inv - cur[2], s[3] * inv - cur[3]);
        o.z = pk2(s[4] * inv - cur[4], s[5] * inv - cur[5]); o.w = pk2(s[6] * inv - cur[6], s[7] * inv - cur[7]);
        *(v4u*)(MIX + (size_t)t * 1024 + ch * 8) = o;
        float old[8]; unpack8(r[i], old);
#pragma unroll
        for (int e = 0; e < 8; ++e) s[e] -= old[e]; }
}
__device__ __forceinline__ void pre_phase(Frame& F) {
    const bf16* Kb = WSP(bf16, WS_K); const bf16* U = WSP(bf16, WS_U); bf16* MIX = WSP(bf16, WS_MIX); float* KM = WSP(float, WS_KMEAN);
    LAS float* part = (LAS float*)F.lds;
    for (int unit = F.bx; unit < NBLK * NHEAD; unit += F.G) {
        const int b = unit >> 3, h = unit & 7, key = F.tid >> 3, ch = F.tid & 7;
        float s[8];
#pragma unroll
        for (int e = 0; e < 8; ++e) s[e] = 0.f;
#pragma unroll
        for (int i = 0; i < 4; ++i) { const v4u q = *(const v4u*)(Kb + (size_t)(b * 256 + 64 * i + key) * 512 + h * 64 + ch * 8);
            s[0] += bf2f(q.x & 0xffffu); s[1] += bf2f(q.x >> 16); s[2] += bf2f(q.y & 0xffffu); s[3] += bf2f(q.y >> 16);
            s[4] += bf2f(q.z & 0xffffu); s[5] += bf2f(q.z >> 16); s[6] += bf2f(q.w & 0xffffu); s[7] += bf2f(q.w >> 16); }
#pragma unroll
        for (int e = 0; e < 8; ++e) part[F.tid * 8 + e] = s[e];
        wg_sync();
        if (F.tid < 64) { const int cq = F.tid >> 3, e = F.tid & 7; float t = 0.f;
            for (int kk = 0; kk < 64; ++kk) t += part[(kk * 8 + cq) * 8 + e];
            KM[(size_t)(h * 64 + b) * 64 + F.tid] = t * (1.0f / 256.0f); }
        wg_sync();
    }
    for (int idx = F.bx * NWAVES * 64 + F.tid; idx < (M / 8) * 64; idx += F.G * NWAVES * 64) {
        const int g = (idx >> 6) & 3, ch = g * 16 + (idx & 15), strip = ((idx >> 8) << 2) | ((idx >> 4) & 3), t0 = strip * 8;
        if (g == 0) pool_strip<2>(U, MIX, t0, ch); else if (g == 1) pool_strip<4>(U, MIX, t0, ch); else if (g == 2) pool_strip<8>(U, MIX, t0, ch); else pool_strip<16>(U, MIX, t0, ch);
    }
}

__device__ __forceinline__ int list_off(int b) { return 256 * (63 * b - (b * (b - 1)) / 2); }
__device__ __forceinline__ void sel_phase(Frame& F) {
    const bf16* Qb = WSP(bf16, WS_Q); const float* KM = WSP(float, WS_KMEAN); unsigned* LIST = WSP(unsigned, WS_LIST);
    LAS float* km = (LAS float*)F.lds;
    LAS unsigned* lcnt = (LAS unsigned*)(F.lds + 16384);
    LAS unsigned* lbase = lcnt + 64;
    for (int unit = F.bx; unit < NHEAD * (M / 512); unit += F.G) {
        const int h = unit & 7, chunk = unit >> 3, t = chunk * 512 + F.tid, own = t >> 8, nb = 2 * chunk + 1;
        wg_sync();
        for (int i = F.tid; i < nb * 64; i += NWAVES * 64) km[i] = KM[(size_t)h * 4096 + i];
        if (F.tid < 64) lcnt[F.tid] = 0u;
        wg_sync();
        float q[64];
#pragma unroll
        for (int i = 0; i < 8; ++i) { const v4u v = *(const v4u*)(Qb + (size_t)t * 512 + h * 64 + i * 8);
            q[8 * i + 0] = bf2f(v.x & 0xffffu); q[8 * i + 1] = bf2f(v.x >> 16); q[8 * i + 2] = bf2f(v.y & 0xffffu); q[8 * i + 3] = bf2f(v.y >> 16);
            q[8 * i + 4] = bf2f(v.z & 0xffffu); q[8 * i + 5] = bf2f(v.z >> 16); q[8 * i + 6] = bf2f(v.w & 0xffffu); q[8 * i + 7] = bf2f(v.w >> 16); }
        float v0 = -INFINITY, v1 = -INFINITY, v2 = -INFINITY; int i0 = 0, i1 = 0, i2 = 0;
        for (int b = 0; b < nb; ++b) {
            float g = 0.f;
#pragma unroll
            for (int d4 = 0; d4 < 16; ++d4) { const f32x4 kv = *(const LAS f32x4*)(km + b * 64 + 4 * d4); g += (q[4 * d4] * kv[0] + q[4 * d4 + 1] * kv[1]) + (q[4 * d4 + 2] * kv[2] + q[4 * d4 + 3] * kv[3]); }
            if (b < own) {
                if (g > v0) { v2 = v1; i2 = i1; v1 = v0; i1 = i0; v0 = g; i0 = b; }
                else if (g > v1) { v2 = v1; i2 = i1; v1 = g; i1 = b; }
                else if (g > v2) { v2 = g; i2 = b; }
            }
        }
        const int nsel = own < 3 ? own : 3;
        unsigned p0 = 0, p1 = 0, p2 = 0;
        if (nsel > 0) p0 = __hip_atomic_fetch_add(lcnt + i0, 1u, __ATOMIC_RELAXED, __HIP_MEMORY_SCOPE_WORKGROUP);
        if (nsel > 1) p1 = __hip_atomic_fetch_add(lcnt + i1, 1u, __ATOMIC_RELAXED, __HIP_MEMORY_SCOPE_WORKGROUP);
        if (nsel > 2) p2 = __hip_atomic_fetch_add(lcnt + i2, 1u, __ATOMIC_RELAXED, __HIP_MEMORY_SCOPE_WORKGROUP);
        wg_sync();
        if (F.tid < 64) { const unsigned cn = lcnt[F.tid]; lbase[F.tid] = cn ? atomicAdd((unsigned*)F.ctl + CW_CUR + (h * 64 + F.tid) * CUR_STRIDE, cn) : 0u; }
        wg_sync();
        if (nsel > 0) LIST[(size_t)h * LIST_PER_HEAD + list_off(i0) + lbase[i0] + p0] = (unsigned)t;
        if (nsel > 1) LIST[(size_t)h * LIST_PER_HEAD + list_off(i1) + lbase[i1] + p1] = (unsigned)t | (1u << 16);
        if (nsel > 2) LIST[(size_t)h * LIST_PER_HEAD + list_off(i2) + lbase[i2] + p2] = (unsigned)t | (2u << 16);
    }
}

namespace att {
typedef short s16x4 __attribute__((ext_vector_type(4)));
typedef float f32x16 __attribute__((ext_vector_type(16)));
typedef short v4i16_t __attribute__((ext_vector_type(4)));
typedef float f32x2_t __attribute__((ext_vector_type(2)));
typedef __bf16 bf16x2_t __attribute__((ext_vector_type(2)));
constexpr int KOFF = 0, VOFF = 32768, WSF_OFF = 65536, QL_OFF = WSF_OFF + 2048, COEF_OFF = QL_OFF + 1024, SCAN_OFF = COEF_OFF + 4096, ATT_LDS_END = SCAN_OFF + 2048;
__device__ __forceinline__ int crow(int r, int hi) { return (r & 3) + 8 * (r >> 2) + 4 * hi; }
__device__ __forceinline__ unsigned cvtpk(float lo, float hi) { f32x2_t v = {lo, hi}; bf16x2_t b = __builtin_convertvector(v, bf16x2_t); return __builtin_bit_cast(unsigned, b); }
__device__ __forceinline__ s16x4 vtr(const LAS unsigned char* p) { return __builtin_bit_cast(s16x4, __builtin_amdgcn_ds_read_tr16_b64_v4i16((LAS v4i16_t*)p)); }
#define ATT_MFMA(a, b, c) __builtin_amdgcn_mfma_f32_32x32x16_bf16(a, b, c, 0, 0, 0)

__device__ __forceinline__ void load_kv(LAS unsigned char* lds, const bf16* Kb, const bf16* Vb, int b, int h, int wave, int lane) {
    const bf16* ks = Kb + (size_t)(b * 256 + lane) * 512 + h * 64 + wave * 8;
    const int vkey = 16 * (wave & 3) + (lane >> 2);
    const bf16* vs = Vb + (size_t)(b * 256 + vkey) * 512 + h * 64 + (wave >> 2) * 32 + (lane & 3) * 8;
    v4u kq[4], vq[4];
#pragma unroll
    for (int i = 0; i < 4; ++i) { kq[i] = *(const v4u*)(ks + (size_t)i * 64 * 512); vq[i] = *(const v4u*)(vs + (size_t)i * 64 * 512); }
#pragma unroll
    for (int i = 0; i < 4; ++i) { *(LAS v4u*)(lds + KOFF + i * 8192 + wave * 1024 + lane * 16) = kq[i];
                                  *(LAS v4u*)(lds + VOFF + i * 8192 + (wave >> 2) * 4096 + vkey * 64 + (lane & 3) * 16) = vq[i]; }
}

template <bool OWN>
__device__ __forceinline__ void item(Frame& F, int h, int b, const unsigned* list, int nrows) {
    LAS unsigned char* lds = F.lds;
    const int lane = F.lane, wave = F.wave, r32 = lane & 31, hi = lane >> 5;
    LAS float* wsf = (LAS float*)(lds + WSF_OFF) + wave * 64;
    LAS unsigned* QL = (LAS unsigned*)(lds + QL_OFF);
    LAS float* coef = (LAS float*)(lds + COEF_OFF) + wave * 128;
    const bf16* Qb = WSP(bf16, WS_Q);
    wg_sync();
    load_kv(lds, WSP(bf16, WS_K), WSP(bf16, WS_V), b, h, wave, lane);
    if (F.tid < 256) { unsigned e;
        if (OWN) e = (unsigned)(b * 256 + F.tid);
        else { const int rr = F.tid < nrows ? F.tid : nrows - 1; e = list[rr] | (F.tid < nrows ? 0u : 0x80000000u); }
        QL[F.tid] = e; }
    wg_sync();
    const unsigned ent = QL[wave * 32 + r32];
    const int t = (int)(ent & 0x3fffu);
    bf16x8 qr[4];
#pragma unroll
    for (int d0 = 0; d0 < 4; ++d0) qr[d0] = *(const bf16x8*)(Qb + (size_t)t * 512 + h * 64 + d0 * 16 + hi * 8);
    const float slope2 = LOG2E / (float)(2 << h);
    float m = -INFINITY, l = 0.f; f32x16 o[2]; o[0] = f32x16{}; o[1] = f32x16{};
    const int ntile = OWN ? ((wave * 32 + 31) >> 6) + 1 : 4;
#pragma unroll 1
    for (int tile = 0; tile < ntile; ++tile) {
        const float base = slope2 * (float)(b * 256 + tile * 64 + 4 * hi - t);
        f32x16 p0, p1;
#pragma unroll
        for (int r = 0; r < 16; ++r) { p0[r] = base + slope2 * (float)((r & 3) + 8 * (r >> 2)); p1[r] = p0[r] + 32.0f * slope2; }
        const LAS unsigned char* kb = lds + KOFF + tile * 8192 + hi * 1024 + r32 * 16;
#pragma unroll
        for (int d0 = 0; d0 < 4; ++d0) { const bf16x8 k0 = *(const LAS bf16x8*)(kb + d0 * 2048), k1 = *(const LAS bf16x8*)(kb + d0 * 2048 + 512);
            p0 = ATT_MFMA(k0, qr[d0], p0); p1 = ATT_MFMA(k1, qr[d0], p1); }
        if (OWN) { const int qo = t - b * 256, kk = tile * 64 + 4 * hi;
#pragma unroll
            for (int r = 0; r < 16; ++r) { const int kv = kk + (r & 3) + 8 * (r >> 2); if (kv > qo) p0[r] = -INFINITY; if (kv + 32 > qo) p1[r] = -INFINITY; } }
        float rm = fmaxf(p0[0], p1[0]);
#pragma unroll
        for (int r = 1; r < 16; ++r) rm = fmaxf(rm, fmaxf(p0[r], p1[r]));
        rm = fmaxf(rm, __shfl_xor(rm, 32));
        const float mn = fmaxf(m, rm), alpha = __builtin_amdgcn_exp2f(m - mn);
        m = mn;
        float ls = 0.f;
#pragma unroll
        for (int r = 0; r < 16; ++r) { p0[r] = __builtin_amdgcn_exp2f(p0[r] - mn); p1[r] = __builtin_amdgcn_exp2f(p1[r] - mn); ls += p0[r] + p1[r]; }
        l = l * alpha + ls;
        if (tile > 0) {
            if (hi == 0) wsf[r32] = alpha;
            asm volatile("s_waitcnt lgkmcnt(0)" ::: "memory");
#pragma unroll
            for (int r = 0; r < 16; ++r) { const float a = wsf[crow(r, hi)]; o[0][r] *= a; o[1][r] *= a; }
        }
        bf16x8 pa[4];
        { v4u w0 = {cvtpk(p0[0], p0[1]), cvtpk(p0[2], p0[3]), cvtpk(p0[4], p0[5]), cvtpk(p0[6], p0[7])};
          v4u w1 = {cvtpk(p0[8], p0[9]), cvtpk(p0[10], p0[11]), cvtpk(p0[12], p0[13]), cvtpk(p0[14], p0[15])};
          v4u w2 = {cvtpk(p1[0], p1[1]), cvtpk(p1[2], p1[3]), cvtpk(p1[4], p1[5]), cvtpk(p1[6], p1[7])};
          v4u w3 = {cvtpk(p1[8], p1[9]), cvtpk(p1[10], p1[11]), cvtpk(p1[12], p1[13]), cvtpk(p1[14], p1[15])};
          pa[0] = __builtin_bit_cast(bf16x8, w0); pa[1] = __builtin_bit_cast(bf16x8, w1); pa[2] = __builtin_bit_cast(bf16x8, w2); pa[3] = __builtin_bit_cast(bf16x8, w3); }
        const LAS unsigned char* vb = lds + VOFF + tile * 8192 + ((lane >> 4) & 1) * 32 + (lane & 3) * 8 + (4 * hi + ((lane & 15) >> 2)) * 64;
#pragma unroll
        for (int d0 = 0; d0 < 2; ++d0)
#pragma unroll
            for (int ks = 0; ks < 4; ++ks) { const s16x4 lo = vtr(vb + d0 * 4096 + ks * 1024), hh = vtr(vb + d0 * 4096 + ks * 1024 + 512);
                const bf16x8 vf = {lo[0], lo[1], lo[2], lo[3], hh[0], hh[1], hh[2], hh[3]};
                o[d0] = ATT_MFMA(pa[ks], vf, o[d0]); }
    }
    l += __shfl_xor(l, 32);
    if (!OWN) {
        if (hi == 0) wsf[32 + r32] = l;
        asm volatile("s_waitcnt lgkmcnt(0)" ::: "memory");
        bf16* PO = WSP(bf16, WS_PO); float* ML = WSP(float, WS_ML);
#pragma unroll
        for (int r = 0; r < 16; ++r) { const int q = crow(r, hi); const unsigned e = QL[wave * 32 + q]; const float rl = 1.0f / wsf[32 + q];
            if (!(e & 0x80000000u)) { const int tq = (int)(e & 0x3fffu), j = (int)((e >> 16) & 3u); bf16* op = PO + ((size_t)j * M + tq) * 512 + h * 64 + r32;
                op[0] = (bf16)f2bf(o[0][r] * rl); op[32] = (bf16)f2bf(o[1][r] * rl); } }
        if (hi == 0 && !(ent & 0x80000000u)) { const int j = (int)((ent >> 16) & 3u); f32x2_t ml = {m, l}; *(f32x2_t*)(ML + (((size_t)j * M + t) * 8 + h) * 2) = ml; }
    } else {
        const int nsel = b < 3 ? b : 3;
        if (hi == 0) { const float* ML = WSP(float, WS_ML); float mj[3], lj[3]; float mx = m;
#pragma unroll
            for (int j = 0; j < 3; ++j) { if (j < nsel) { const f32x2_t ml = *(const f32x2_t*)(ML + (((size_t)j * M + t) * 8 + h) * 2); mj[j] = ml[0]; lj[j] = ml[1]; mx = fmaxf(mx, mj[j]); } else { mj[j] = -INFINITY; lj[j] = 0.f; } }
            const float ao = __builtin_amdgcn_exp2f(m - mx); float wj[3]; float den = ao * l;
#pragma unroll
            for (int j = 0; j < 3; ++j) { wj[j] = j < nsel ? lj[j] * __builtin_amdgcn_exp2f(mj[j] - mx) : 0.f; den += wj[j]; }
            const float inv = 1.0f / den; f32x4 cf = {ao * inv, wj[0] * inv, wj[1] * inv, wj[2] * inv};
            *(LAS f32x4*)(coef + r32 * 4) = cf; }
        asm volatile("s_waitcnt lgkmcnt(0)" ::: "memory");
        const bf16* PO = WSP(bf16, WS_PO); bf16* MIX = WSP(bf16, WS_MIX);
#pragma unroll
        for (int r = 0; r < 16; ++r) { const int q = crow(r, hi), tq = b * 256 + wave * 32 + q; const f32x4 cf = *(const LAS f32x4*)(coef + q * 4);
            float a0 = cf[0] * o[0][r], a1 = cf[0] * o[1][r];
#pragma unroll
            for (int j = 0; j < 3; ++j) if (j < nsel) { const bf16* pp = PO + ((size_t)j * M + tq) * 512 + h * 64 + r32; a0 += cf[1 + j] * bf2f(pp[0]); a1 += cf[1 + j] * bf2f(pp[32]); }
            bf16* op = MIX + (size_t)tq * 1024 + 512 + h * 64 + r32; op[0] = (bf16)f2bf(a0); op[32] = (bf16)f2bf(a1); }
    }
}
}

__device__ __forceinline__ void atta_phase(Frame& F) {
    LAS unsigned* SC = (LAS unsigned*)(F.lds + att::SCAN_OFF);
    const unsigned* cur = (const unsigned*)F.ctl + CW_CUR;
    { const unsigned cn = __hip_atomic_load(cur + F.tid * CUR_STRIDE, __ATOMIC_RELAXED, __HIP_MEMORY_SCOPE_AGENT); SC[F.tid] = (cn + 255u) >> 8; }
    wg_sync();
    for (int off = 1; off < 512; off <<= 1) { const unsigned v = SC[F.tid] + (F.tid >= off ? SC[F.tid - off] : 0u); wg_sync(); SC[F.tid] = v; wg_sync(); }
    const int total = (int)SC[511];
    for (int idx = F.bx; idx < total; idx += F.G) {
        int lo = 0, hi = 511;
        while (lo < hi) { const int mid = (lo + hi) >> 1; if ((int)SC[mid] > idx) hi = mid; else lo = mid + 1; }
        const int i = lo, h = i >> 6, b = i & 63, before = i ? (int)SC[i - 1] : 0, chunk = idx - before;
        const int cn = (int)__hip_atomic_load(cur + i * CUR_STRIDE, __ATOMIC_RELAXED, __HIP_MEMORY_SCOPE_AGENT);
        const int nrows = (cn - chunk * 256) < 256 ? (cn - chunk * 256) : 256;
        att::item<false>(F, h, b, WSP(unsigned, WS_LIST) + (size_t)h * LIST_PER_HEAD + list_off(b) + chunk * 256, nrows);
    }
}
__device__ __forceinline__ void attb_phase(Frame& F) {
    for (int idx = F.bx; idx < NHEAD * NBLK; idx += F.G) att::item<true>(F, idx & 7, idx >> 3, nullptr, 256);
}

__device__ __forceinline__ void final_phase(Frame& F) {
    const int gw = F.bx * NWAVES + F.wave, NGW = F.G * NWAVES; const float* SSQ = WSP(float, WS_SSQ);
    f32x4 g[4]; const float* fnorm = inptr(IN_FINAL_NORM);
#pragma unroll
    for (int j = 0; j < 4; ++j) g[j] = ((const f32x4*)fnorm)[F.lane + 64 * j];
    for (int m = gw; m < M; m += NGW) {
        const float s = ((SSQ[m] + SSQ[M + m]) + SSQ[2 * M + m]) + SSQ[3 * M + m];
        const float ri = 1.0f / sqrtf(s * (1.0f / 1024.0f) + EPS);
        f32x4* xr = (f32x4*)(F.out + (size_t)m * D) + F.lane;
#pragma unroll
        for (int j = 0; j < 4; ++j) { const f32x4 v = xr[64 * j]; xr[64 * j] = v * ri * g[j]; }
    }
}

struct Args { const float* in[22]; float* out; unsigned char* ws; int ph_lo, ph_hi; };
__global__ void __launch_bounds__(NWAVES * 64, 2) skel_fwd(Args args) {
    extern __shared__ __attribute__((aligned(16))) unsigned char lds[];
    Frame F;
    F.lds = (LAS unsigned char*)lds;
    F.MISC = (volatile LAS unsigned*)(F.lds + MISC_OFF);
    F.tid = threadIdx.x; F.lane = F.tid & 63; F.wave = __builtin_amdgcn_readfirstlane(F.tid >> 6);
    F.G = gridDim.x; F.bx = blockIdx.x;
    F.ws = args.ws; F.ctl = (gu32*)(args.ws + WS_CTL); F.out = args.out;
    for (int u = F.tid; u < (LDS_BYTES - LDSCTL_OFF) / 4; u += NWAVES * 64) ((LAS unsigned*)(F.lds + LDSCTL_OFF))[u] = 0u;
    __syncthreads();
    XcdBarrier bar; bar.bar = (unsigned*)(F.ctl + CW_BAR); bar.x = 0; bar.st = nullptr;
    if (N_LAUNCHES == 1) bar = xcd_barrier_post((unsigned*)(F.ctl + CW_BAR), F.MISC + 8);
    const int lo = args.ph_lo, hi = args.ph_hi;
    unsigned char* ws = F.ws;
#define XB ((const pg8::bf16_t*)(ws + WS_XB))
#define SSQ ((const float*)(ws + WS_SSQ))
#ifndef DBG_ONLY
#define DBG_ONLY -1
#endif
#define IN(k) (lo <= (k) && (k) < hi && (DBG_ONLY < 0 || (k) == DBG_ONLY))
#ifndef PROBE_REPS
#define REPS(k) 1
#else
    constexpr int probe_reps[NPHASE] = PROBE_REPS;
#define REPS(k) probe_reps[k]
#endif
#define REPLOOP(k) for (int rep_ = 0; rep_ < REPS(k); ++rep_, (rep_ < REPS(k) ? xcd_barrier(bar) : (void)0))
#ifdef PROBE_AMP
    unsigned long long ts_prev = __builtin_amdgcn_s_memrealtime(), ts_amp = 0;
#define STAMP(k) do { const unsigned long long now_ = __builtin_amdgcn_s_memrealtime(); if ((k) == PROBE_AMP) ts_amp = now_ - ts_prev; ts_prev = now_; } while (0)
#else
#define STAMP(k) do { } while (0)
#endif
#define SEAM(k) do { if (IN(k) && IN((k) + 1)) xcd_barrier(bar); STAMP(k); asm volatile("" : "+v"(F.tid), "+v"(F.lane)); asm volatile("" : "+s"(F.ws), "+s"(F.out), "+s"(F.G), "+s"(F.bx), "+s"(F.wave)); ws = F.ws; } while (0)
    LAS float* TAB = (LAS float*)(F.lds + TAB_OFF);

    if (IN(PH_P0)) REPLOOP(PH_P0) { p0_phase(F); } SEAM(PH_P0);
    if (IN(PH_P1)) REPLOOP(PH_P1) { p1_phase(F); } SEAM(PH_P1);
#define FFN_PHASES(f, PH_GU, XIN) \
    if (IN(PH_GU)) REPLOOP(PH_GU) { \
        pg8::Gemm g{XB, (const pg8::bf16_t*)(ws + WS_WGU) + (size_t)(f) * NGU * 1024, M, NGU, D}; pg8::StaticOrder S; S.init(M, NGU, F.G, vbx); \
        pg8::fill_tables(TAB, S, SSQ, (const float*)(ws + WS_BGU) + (f) * NGU); pg8::EpiGU E{(pg8::bf16_t*)(ws + WS_R1), TAB}; \
        pg8::gemm_phase<pg8::EpiGU, pg8::StaticOrder, true, true>(F.lds + RING_OFF, g, S, E); } \
    SEAM(PH_GU); \
    if (IN(PH_GU + 1)) REPLOOP(PH_GU + 1) { \
        pg8::Gemm g{(const pg8::bf16_t*)(ws + WS_R1), (const pg8::bf16_t*)(ws + WS_WDN) + (size_t)(f) * 1024 * DFF, M, D, DFF}; pg8::StaticOrder S; S.init(M, D, F.G, vbx); \
        pg8::EpiRes E{XIN, F.out, (pg8::bf16_t*)(ws + WS_XB), nullptr, (float*)(ws + WS_SSQ)}; \
        pg8::gemm_phase<pg8::EpiRes, pg8::StaticOrder, false, true>(F.lds + RING_OFF, g, S, E); } \
    SEAM(PH_GU + 1);
#define OUT_PHASE(PH, WOFF, BIAS) \
    if (IN(PH)) REPLOOP(PH) { \
        pg8::Gemm g{(const pg8::bf16_t*)(ws + WS_MIX), (const pg8::bf16_t*)(ws + WOFF), M, D, D}; pg8::StaticOrder S; S.init(M, D, F.G, vbx); \
        pg8::EpiRes E{F.out, F.out, (pg8::bf16_t*)(ws + WS_XB), BIAS, (float*)(ws + WS_SSQ)}; \
        pg8::gemm_phase<pg8::EpiRes, pg8::StaticOrder, false, true>(F.lds + RING_OFF, g, S, E); } \
    SEAM(PH);

    int vbx = F.bx;
    if (N_LAUNCHES == 1 && lo == 0 && F.G == 256) { bool ok = true;
        for (int j = 0; j < 16; ++j) { const unsigned cn = xb_ld(&bar.bar[XB_XCNT(j)]); ok = ok && (cn == (j < 8 ? 32u : 0u)); }
        if (ok) vbx = (int)F.MISC[10] * 8 + (int)bar.x; }
    vbx = __builtin_amdgcn_readfirstlane(vbx);
    FFN_PHASES(0, PH_L0_GU1, inptr(IN_X))
    if (IN(PH_L0_CIN)) REPLOOP(PH_L0_CIN) {
        pg8::Gemm g{XB, (const pg8::bf16_t*)(ws + WS_WCIN), M, NCIN, D}; pg8::StaticOrder S; S.init(M, NCIN, F.G, vbx);
        pg8::fill_tables(TAB, S, SSQ, (const float*)(ws + WS_BCIN)); pg8::EpiCin E{(pg8::bf16_t*)(ws + WS_R1), TAB};
        pg8::gemm_phase<pg8::EpiCin, pg8::StaticOrder, true, true>(F.lds + RING_OFF, g, S, E); }
    SEAM(PH_L0_CIN);
    if (IN(PH_L0_CONV)) REPLOOP(PH_L0_CONV) conv_phase(F);
    SEAM(PH_L0_CONV);
    OUT_PHASE(PH_L0_COUT, WS_WCOUT, nullptr)
    FFN_PHASES(1, PH_L0_GU2, F.out)
    FFN_PHASES(2, PH_L1_GU1, F.out)
    if (IN(PH_L1_PIN)) REPLOOP(PH_L1_PIN) {
        pg8::Gemm g{XB, (const pg8::bf16_t*)(ws + WS_WPIN), M, NPIN, D}; pg8::StaticOrder S; S.init(M, NPIN, F.G, vbx);
        pg8::fill_tables(TAB, S, SSQ, (const float*)(ws + WS_BPIN)); pg8::EpiPin E{(pg8::bf16_t*)(ws + WS_Q), TAB};
        pg8::gemm_phase<pg8::EpiPin, pg8::StaticOrder, true, true>(F.lds + RING_OFF, g, S, E); }
    SEAM(PH_L1_PIN);
    if (IN(PH_L1_PRE)) REPLOOP(PH_L1_PRE) pre_phase(F);
    SEAM(PH_L1_PRE);
    if (IN(PH_L1_SEL)) REPLOOP(PH_L1_SEL) sel_phase(F);
    SEAM(PH_L1_SEL);
    if (IN(PH_L1_ATTA)) REPLOOP(PH_L1_ATTA) atta_phase(F);
    SEAM(PH_L1_ATTA);
    if (IN(PH_L1_ATTB)) REPLOOP(PH_L1_ATTB) attb_phase(F);
    SEAM(PH_L1_ATTB);
    OUT_PHASE(PH_L1_POUT, WS_WPOUT, (const float*)(ws + WS_BPOUT))
    FFN_PHASES(3, PH_L1_GU2, F.out)
    if (IN(PH_FINAL)) REPLOOP(PH_FINAL) final_phase(F);
#ifdef PROBE_AMP
    STAMP(PH_FINAL);
    if (F.bx == 0) { const unsigned long long t0_ = __builtin_amdgcn_s_memrealtime(); while (__builtin_amdgcn_s_memrealtime() - t0_ < 8ull * ts_amp) __builtin_amdgcn_s_sleep(8); }
#endif
#undef IN
#undef SEAM
}

extern "C" void kernel_launch(void* const* d_in, const int* in_sizes, int n_in, void* d_out, int out_size, void* d_ws, size_t ws_size, hipStream_t stream) {
    static int grid = 0;
    if (grid == 0) {
        if (n_in != 22 || in_sizes[0] != M * D || out_size != M * D || ws_size < WS_END) { fprintf(stderr, "kernel_launch: unexpected shapes/workspace (n_in %d, ws %zu < %zu); nothing launched\n", n_in, ws_size, (size_t)WS_END); grid = -1; return; }
        int dev = 0, cus = 0;
        if (hipGetDevice(&dev) != hipSuccess || hipDeviceGetAttribute(&cus, hipDeviceAttributeMultiprocessorCount, dev) != hipSuccess) { grid = -1; return; }
        if (hipFuncSetAttribute((const void*)skel_fwd, hipFuncAttributeMaxDynamicSharedMemorySize, LDS_BYTES) != hipSuccess) { fprintf(stderr, "kernel_launch: hipFuncSetAttribute failed\n"); grid = -1; return; }
        (void)hipGetLastError();
        grid = cus;
        if (grid != 256) fprintf(stderr, "kernel_launch: %d CUs; this kernel is laid out for 256\n", grid);
    }
    if (grid < 0) return;
    if (hipMemsetAsync((char*)d_ws + WS_CTL, 0, CTL_ZERO_BYTES, stream) != hipSuccess) return;
    Args a{};
    for (int i = 0; i < 22; ++i) a.in[i] = (const float*)d_in[i];
    a.out = (float*)d_out; a.ws = (unsigned char*)d_ws;
    for (int li = 0; li < N_LAUNCHES; ++li) {
        a.ph_lo = (N_LAUNCHES == 1) ? 0 : li; a.ph_hi = (N_LAUNCHES == 1) ? (int)NPHASE : li + 1;
        hipLaunchKernelGGL(skel_fwd, dim3(grid), dim3(NWAVES * 64), LDS_BYTES, stream, a);
        if (hipPeekAtLastError() != hipSuccess) { fprintf(stderr, "kernel_launch: launch %d failed\n", li); break; }
    }
}
```

```cpp
#include <hip/hip_runtime.h>
#include <hip/hip_bf16.h>
#include <cstdio>
#include <cstdint>
#include <cmath>

#ifndef MK_N_LAUNCHES
#define MK_N_LAUNCHES 1
#endif

constexpr int M = 16384, D = 1024, DFF = 2816, NGU = 2 * DFF, NCIN = 2560, NPIN = 2048;
constexpr int NHEAD = 8, HD = 64, MBLK = 256, NBLK = M / MBLK;
constexpr float EPS = 1e-6f;
constexpr float LOG2E = 1.4426950408889634f;
constexpr float QSCALE = 0.125f * LOG2E;

namespace pg8 {
#define PG8_LAS __attribute__((address_space(3)))
typedef unsigned short bf16_t;
typedef short bf16x8 __attribute__((ext_vector_type(8)));
typedef float f32x4 __attribute__((ext_vector_type(4)));
typedef unsigned u32x4 __attribute__((ext_vector_type(4)));
constexpr int BM = 256, BK = 64, HALF = 128, HTB = HALF * BK * 2  , STAGE_BYTES = 8 * HTB, NXCD = 8, WGM = 8;

__host__ __device__ __forceinline__ int lds_byte(int r, int c) { const int st = (r >> 4) * 2 + (c >> 5), rr = r & 15, cc = c & 31, ob = rr * 64 + cc * 2; return st * 1024 + (ob ^ (((ob >> 9) & 1) << 5)); }
__host__ __device__ __forceinline__ void stage_rc(int b, int& R, int& C) { const int st = b / 1024, sb = b % 1024, swz = sb ^ (((sb >> 9) & 1) << 5); R = (st >> 1) * 16 + swz / 64; C = (st & 1) * 32 + (swz % 64) / 2; }
__host__ __device__ __forceinline__ int perm32(int rho) { const int n = rho >> 4, i = rho & 15; return 8 * (i >> 2) + 4 * n + (i & 3); }

struct Unit { int pm, pn, idx; };
struct Gemm { const bf16_t* A; const bf16_t* Bt; int M, N, K; };

struct StaticOrder {
    int nM, nN, nwg, G, c;
    __host__ __device__ void init(int M, int N, int G_, int c_) { nM = M / BM; nN = N / BM; nwg = nM * nN; G = G_; c = c_; }
    __host__ __device__ bool next(int i, Unit& u) const {
        const long L = (long)i * G + c; if (L >= nwg) return false;
        int wgid = (int)L; { const int q = nwg / NXCD, r = nwg % NXCD, xcd = wgid % NXCD, off = wgid / NXCD; wgid = (xcd < r ? xcd * (q + 1) : r * (q + 1) + (xcd - r) * q) + off; }
        const int nig = WGM * nN, gid = wgid / nig, fm = gid * WGM, gsz = (nM - fm) < WGM ? (nM - fm) : WGM;
        u.pm = fm + ((wgid % nig) % gsz); u.pn = (wgid % nig) / gsz; u.idx = i; return true;
    }
    __device__ __forceinline__ void a_ready(const Unit&) const {}
    __device__ __forceinline__ void done(const Unit&) const {}
};

__device__ __forceinline__ unsigned cvt_pk_bf16(float lo, float hi) { unsigned r; asm volatile("v_cvt_pk_bf16_f32 %0, %1, %2" : "=v"(r) : "v"(lo), "v"(hi)); return r; }

typedef unsigned u32x2 __attribute__((ext_vector_type(2)));
constexpr int TAB_UNITS = 6;
__device__ __forceinline__ void tab_rinv(const PG8_LAS float* tab, const Unit& u, int wr, int fr, float (&rinv)[2][4]) {
#pragma unroll
    for (int ai = 0; ai < 2; ++ai)
#pragma unroll
        for (int m = 0; m < 4; ++m) rinv[ai][m] = tab[u.idx * 256 + ai * HALF + wr * 64 + m * 16 + fr];
}
__device__ __forceinline__ void tab_bias(const PG8_LAS float* tab, const Unit& u, int wc, int fq, f32x4 (&bv)[2][2]) {
#pragma unroll
    for (int bj = 0; bj < 2; ++bj)
#pragma unroll
        for (int n = 0; n < 2; ++n) bv[bj][n] = *(const PG8_LAS f32x4*)(tab + (TAB_UNITS + u.idx) * 256 + bj * HALF + wc * 32 + 8 * fq + 4 * n);
}
template <class Sched> __device__ __forceinline__ void fill_tables(PG8_LAS float* tab, const Sched& S, const float* ssq, const float* bias) {
    int tid = threadIdx.x; asm volatile("" : "+v"(tid));
    Unit u;
    for (int i = 0; i < TAB_UNITS && S.next(i, u); ++i) {
        if (tid < 256) { const int r = u.pm * BM + tid; const float s = ((ssq[r] + ssq[M + r]) + ssq[2 * M + r]) + ssq[3 * M + r]; tab[i * 256 + tid] = 1.0f / sqrtf(s * (1.0f / 1024.0f) + EPS); }
        else tab[(TAB_UNITS + i) * 256 + (tid - 256)] = bias[u.pn * BM + (tid - 256)];
    }
    __syncthreads();
}
__device__ __forceinline__ float sigm(float z) { return __builtin_amdgcn_rcpf(1.0f + __builtin_amdgcn_exp2f(-LOG2E * z)); }
__device__ __forceinline__ u32x4 pack8(const f32x4 a, const f32x4 b) { u32x4 w; w.x = cvt_pk_bf16(a[0], a[1]); w.y = cvt_pk_bf16(a[2], a[3]); w.z = cvt_pk_bf16(b[0], b[1]); w.w = cvt_pk_bf16(b[2], b[3]); return w; }

struct EpiGU {
    static constexpr bool PERM = true, AFTER_DRAIN = false, INIT_ACC = false;
    bf16_t* O; const PG8_LAS float* tab;
    __device__ __forceinline__ void operator()(const f32x4 (&acc)[2][2][4][2], const Unit& u, int wr, int wc, int fr, int fq) const {
        asm volatile("" : "+v"(fr), "+v"(fq));
        const int row0 = u.pm * BM + wr * 64 + fr, bcol0 = u.pn * BM + wc * 32 + 8 * fq, ocol0 = u.pn * HALF + wc * 32 + 8 * fq;
        f32x4 bv[2][2]; tab_bias(tab, u, wc, fq, bv);
        float rinv[2][4]; tab_rinv(tab, u, wr, fr, rinv);
#pragma unroll
        for (int ai = 0; ai < 2; ++ai)
#pragma unroll
            for (int m = 0; m < 4; ++m) { const float ri = rinv[ai][m]; bf16_t* rowp = O + (size_t)(row0 + ai * HALF + m * 16) * DFF + ocol0;
                f32x4 hv[2];
#pragma unroll
                for (int n = 0; n < 2; ++n) { const f32x4 g = acc[ai][0][m][n] * ri + bv[0][n], up = acc[ai][1][m][n] * ri + bv[1][n];
#pragma unroll
                    for (int e = 0; e < 4; ++e) hv[n][e] = g[e] * up[e] * sigm(g[e]); }
                *(u32x4*)rowp = pack8(hv[0], hv[1]);
                if (m & 1) asm volatile("" ::: "memory"); }
    }
};
struct EpiCin {
    static constexpr bool PERM = true, AFTER_DRAIN = false, INIT_ACC = false;
    bf16_t* O; const PG8_LAS float* tab;
    template <int KIND> __device__ __forceinline__ void run(const f32x4 (&acc)[2][2][4][2], const f32x4 (&bv)[2][2], const float (&rinv)[2][4], bf16_t* base) const {
#pragma unroll
        for (int ai = 0; ai < 2; ++ai)
#pragma unroll
            for (int m = 0; m < 4; ++m) { const float ri = rinv[ai][m]; bf16_t* rowp = base + (size_t)(ai * HALF + m * 16) * 1536;
                f32x4 z0[2], z1[2];
#pragma unroll
                for (int n = 0; n < 2; ++n) { z0[n] = acc[ai][0][m][n] * ri + bv[0][n]; z1[n] = acc[ai][1][m][n] * ri + bv[1][n]; }
                if (KIND == 2) { *(u32x4*)rowp = pack8(z0[0], z0[1]); *(u32x4*)(rowp + HALF) = pack8(z1[0], z1[1]); }
                else { f32x4 o[2];
#pragma unroll
                    for (int n = 0; n < 2; ++n)
#pragma unroll
                        for (int e = 0; e < 4; ++e) o[n][e] = KIND == 0 ? z0[n][e] * sigm(z1[n][e]) : z0[n][e] * z1[n][e];
                    *(u32x4*)rowp = pack8(o[0], o[1]); }
                asm volatile("" ::: "memory"); }
    }
    __device__ __forceinline__ void operator()(const f32x4 (&acc)[2][2][4][2], const Unit& u, int wr, int wc, int fr, int fq) const {
        asm volatile("" : "+v"(fr), "+v"(fq));
        const int row0 = u.pm * BM + wr * 64 + fr, bcol0 = u.pn * BM + wc * 32 + 8 * fq;
        f32x4 bv[2][2]; tab_bias(tab, u, wc, fq, bv);
        float rinv[2][4]; tab_rinv(tab, u, wr, fr, rinv);
        const int ocol0 = (u.pn >= 8 ? 1024 + 256 * (u.pn - 8) : 128 * u.pn) + wc * 32 + 8 * fq;
        bf16_t* base = O + (size_t)row0 * 1536 + ocol0;
        if (u.pn < 4) run<0>(acc, bv, rinv, base); else if (u.pn < 8) run<1>(acc, bv, rinv, base); else run<2>(acc, bv, rinv, base);
    }
};
struct EpiPin {
    static constexpr bool PERM = true, AFTER_DRAIN = false, INIT_ACC = false;
    bf16_t* O; const PG8_LAS float* tab;
    __device__ __forceinline__ void operator()(const f32x4 (&acc)[2][2][4][2], const Unit& u, int wr, int wc, int fr, int fq) const {
        asm volatile("" : "+v"(fr), "+v"(fq));
        const int row0 = u.pm * BM + wr * 64 + fr, bcol0 = u.pn * BM + wc * 32 + 8 * fq;
        f32x4 bv[2][2]; tab_bias(tab, u, wc, fq, bv);
        float rinv[2][4]; tab_rinv(tab, u, wr, fr, rinv);
        const int t = u.pn >> 1; const int slot = t == 0 ? 3 : t - 1;
        const float sc = t == 1 ? QSCALE : 1.0f;
        bf16_t* base = O + (size_t)slot * ((size_t)M * 512) + (size_t)row0 * 512 + 256 * (u.pn & 1) + wc * 32 + 8 * fq;
#pragma unroll
        for (int ai = 0; ai < 2; ++ai)
#pragma unroll
            for (int m = 0; m < 4; ++m) { const float ri = rinv[ai][m] * sc; bf16_t* rowp = base + (size_t)(ai * HALF + m * 16) * 512;
#pragma unroll
                for (int bj = 0; bj < 2; ++bj) { const f32x4 z0 = acc[ai][bj][m][0] * ri + bv[bj][0] * sc, z1 = acc[ai][bj][m][1] * ri + bv[bj][1] * sc;
                    *(u32x4*)(rowp + bj * HALF) = pack8(z0, z1); }
                asm volatile("" ::: "memory"); }
    }
};
template <bool F32IN> struct EpiRes {
    static constexpr bool PERM = false, AFTER_DRAIN = true, INIT_ACC = true;
    const float* xin; bf16_t* xb; const float* bias; float* ssq;
    __device__ __forceinline__ void init(f32x4 (&acc)[2][2][4][2], const Unit& u, int wr, int wc, int fr, int fq) const {
        const int col0 = u.pn * BM + wc * 32 + 4 * fq;
#pragma unroll
        for (int ai = 0; ai < 2; ++ai)
#pragma unroll
            for (int m = 0; m < 4; ++m) { const size_t off = (size_t)(u.pm * BM + ai * HALF + wr * 64 + m * 16 + fr) * D + col0;
#pragma unroll
                for (int bj = 0; bj < 2; ++bj)
#pragma unroll
                    for (int n = 0; n < 2; ++n) {
                        if (F32IN) acc[ai][bj][m][n] = *(const f32x4*)(xin + off + bj * HALF + n * 16);
                        else { const u32x2 q = *(const u32x2*)(xb + off + bj * HALF + n * 16);
                            acc[ai][bj][m][n] = (f32x4){__uint_as_float(q.x << 16), __uint_as_float(q.x & 0xffff0000u), __uint_as_float(q.y << 16), __uint_as_float(q.y & 0xffff0000u)}; } } }
        if (bias) {
#pragma unroll
            for (int bj = 0; bj < 2; ++bj)
#pragma unroll
                for (int n = 0; n < 2; ++n) { const f32x4 bv = *(const f32x4*)(bias + col0 + bj * HALF + n * 16);
#pragma unroll
                    for (int ai = 0; ai < 2; ++ai)
#pragma unroll
                        for (int m = 0; m < 4; ++m) acc[ai][bj][m][n] += bv; }
        }
    }
    __device__ __forceinline__ void fused(f32x4 (&acc)[2][2][4][2], const Unit& u, int wr, int wc, int fr, int fq, PG8_LAS unsigned char* lds, int wid, int lane) const {
        PG8_LAS float* P = (PG8_LAS float*)lds;
        asm volatile("" : "+v"(fr), "+v"(fq));
        const int col0 = u.pn * BM + wc * 32 + 4 * fq;
#pragma unroll
        for (int ai = 0; ai < 2; ++ai)
#pragma unroll
            for (int m = 0; m < 4; ++m) { const int rt = ai * HALF + wr * 64 + m * 16 + fr; const size_t off = (size_t)(u.pm * BM + rt) * D + col0; float ss = 0.f;
#pragma unroll
                for (int bj = 0; bj < 2; ++bj)
#pragma unroll
                    for (int n = 0; n < 2; ++n) { const int c = bj * HALF + n * 16; const f32x4 v = acc[ai][bj][m][n];
                        ss += (v[0] * v[0] + v[1] * v[1]) + (v[2] * v[2] + v[3] * v[3]);
                        u32x2 w; w.x = cvt_pk_bf16(v[0], v[1]); w.y = cvt_pk_bf16(v[2], v[3]); *(u32x2*)(xb + off + c) = w; }
                ss += __shfl_xor(ss, 16); ss += __shfl_xor(ss, 32);
                if (fq == 0) P[rt * 4 + wc] = ss; }
        asm volatile("s_waitcnt lgkmcnt(0)" ::: "memory"); __builtin_amdgcn_s_barrier(); asm volatile("" ::: "memory");
        const int tid = wid * 64 + lane;
        if (tid < 256) { const float s = ((P[tid * 4 + 0] + P[tid * 4 + 1]) + P[tid * 4 + 2]) + P[tid * 4 + 3]; ssq[(size_t)u.pn * M + u.pm * BM + tid] = s; }
        asm volatile("s_waitcnt lgkmcnt(0)" ::: "memory"); __builtin_amdgcn_s_barrier(); asm volatile("" ::: "memory");
    }
};

template <class Epi, class Sched, bool ALIGN_EPI = false, bool SP2 = false>
__device__ __forceinline__ void gemm_phase(PG8_LAS unsigned char* lds, const Gemm g, const Sched& S, const Epi& E) {
    int tid = threadIdx.x; asm volatile("" : "+v"(tid));
    const int wid = __builtin_amdgcn_readfirstlane(tid >> 6), lane = tid & 63, wr = wid >> 2, wc = wid & 3, fr = lane & 15, fq = lane >> 4;
    const int K = g.K, nt = K / BK;
    unsigned voffA[2], voffB[2];
#pragma unroll
    for (int i = 0; i < 2; ++i) { int R, C; stage_rc(tid * 16 + i * 8192, R, C); const int Rb = Epi::PERM ? ((R & ~31) + perm32(R & 31)) : R;
        voffA[i] = (unsigned)(R * K + C) * 2u; voffB[i] = (unsigned)(Rb * K + C) * 2u; }
    const size_t kstep = (size_t)(BK * 2);
    const size_t hstep = (size_t)HALF * K * 2;
    const size_t tstep = 2 * hstep;
    const unsigned ldsw = (unsigned)wid * 1024u;
    const int aoff = lds_byte(wr * 64 + fr, fq * 8), boff = lds_byte(wc * 32 + fr, fq * 8);
#define PG8_SA(b, h) (((b) * 2 + (h)) * HTB)
#define PG8_SB(b, h) ((4 + (b) * 2 + (h)) * HTB)
#define PG8_STAGE(bufoff, gbase, voff) do { _Pragma("unroll") for (int _i = 0; _i < 2; ++_i) \
        __builtin_amdgcn_global_load_lds((const unsigned*)((const char*)(gbase) + (voff)[_i]), (PG8_LAS unsigned*)(lds + (bufoff) + ldsw + _i * 8192), 16, 0, 0); } while (0)
#define PG8_LDA(dst, b, h) do { _Pragma("unroll") for (int m = 0; m < 4; ++m) _Pragma("unroll") for (int k = 0; k < 2; ++k) dst[m][k] = *(const PG8_LAS bf16x8*)(lds + PG8_SA(b, h) + aoff + m * 2048 + k * 1024); } while (0)
#define PG8_LDB(dst, b, h) do { _Pragma("unroll") for (int n = 0; n < 2; ++n) _Pragma("unroll") for (int k = 0; k < 2; ++k) dst[n][k] = *(const PG8_LAS bf16x8*)(lds + PG8_SB(b, h) + boff + n * 2048 + k * 1024); } while (0)
#define PG8_MMA(ai, bj, At, Bt) do { __builtin_amdgcn_s_setprio(1); _Pragma("unroll") for (int m = 0; m < 4; ++m) _Pragma("unroll") for (int n = 0; n < 2; ++n) _Pragma("unroll") for (int k = 0; k < 2; ++k) \
        acc[ai][bj][m][n] = __builtin_amdgcn_mfma_f32_16x16x32_bf16(Bt[n][k], At[m][k], acc[ai][bj][m][n], 0, 0, 0); __builtin_amdgcn_s_setprio(0); } while (0)
#define PG8_WAIT_V(n) asm volatile("s_waitcnt vmcnt(" #n ")" ::: "memory")
#define PG8_WAIT_L(n) asm volatile("s_waitcnt lgkmcnt(" #n ")" ::: "memory")
#define PG8_BAR __builtin_amdgcn_s_barrier()
#define PG8_SCHED __builtin_amdgcn_sched_barrier(0)
    Unit cur, nxt; int ui = 0;
    if (!S.next(0, cur)) return;
    f32x4 acc[2][2][4][2];
    if constexpr (Epi::INIT_ACC) { E.init(acc, cur, wr, wc, fr, fq); }
    else {
#pragma unroll
    for (int a = 0; a < 2; ++a)
#pragma unroll
        for (int b = 0; b < 2; ++b)
#pragma unroll
            for (int m = 0; m < 4; ++m)
#pragma unroll
                for (int n = 0; n < 2; ++n) acc[a][b][m][n] = (f32x4){0.f, 0.f, 0.f, 0.f};
    }
    bf16x8 At[4][2], B0[2][2], B1[2][2];
    const char* cA = (const char*)g.A + (size_t)cur.pm * tstep; const char* cB = (const char*)g.Bt + (size_t)cur.pn * tstep;
    S.a_ready(cur);
    if constexpr (SP2) {
        PG8_STAGE(PG8_SB(0, 0), cB, voffB); PG8_STAGE(PG8_SB(0, 1), cB + hstep, voffB); PG8_STAGE(PG8_SA(0, 0), cA, voffA); PG8_STAGE(PG8_SA(0, 1), cA + hstep, voffA);
        if (wr == 1) PG8_BAR;
        PG8_WAIT_V(2); PG8_BAR;
        PG8_STAGE(PG8_SB(1, 0), cB + kstep, voffB); PG8_STAGE(PG8_SA(1, 0), cA + kstep, voffA); PG8_STAGE(PG8_SB(1, 1), cB + hstep + kstep, voffB);
        PG8_WAIT_V(6); PG8_BAR;
    } else {
        PG8_STAGE(PG8_SB(0, 0), cB, voffB); PG8_STAGE(PG8_SA(0, 0), cA, voffA); PG8_STAGE(PG8_SB(0, 1), cB + hstep, voffB); PG8_STAGE(PG8_SA(0, 1), cA + hstep, voffA);
        if (wr == 1) PG8_BAR;
        PG8_WAIT_V(4); PG8_BAR;
        PG8_STAGE(PG8_SB(1, 0), cB + kstep, voffB); PG8_STAGE(PG8_SA(1, 0), cA + kstep, voffA); PG8_STAGE(PG8_SB(1, 1), cB + hstep + kstep, voffB);
        PG8_WAIT_V(6); PG8_BAR;
    }
    for (;;) {
        const bool has_next = S.next(ui + 1, nxt);
        const char* nA = has_next ? (const char*)g.A + (size_t)nxt.pm * tstep : cA; const char* nB = has_next ? (const char*)g.Bt + (size_t)nxt.pn * tstep : cB;
#if defined(PROBE_KREP)
        const int ntr = Epi::INIT_ACC ? nt : nt * PROBE_KREP;
        for (int tq = 0; tq < ntr; tq += 2) {
            const int t = tq % nt;
            const bool last = (tq == ntr - 2);
            const char* a1 = cA + (size_t)(t + 1) * kstep;
            const char* a2 = last ? nA : cA + (size_t)((t + 2) % nt) * kstep; const char* b2 = last ? nB : cB + (size_t)((t + 2) % nt) * kstep;
#else
        for (int t = 0; t < nt; t += 2) {
            const bool last = (t == nt - 2);
            const char* a1 = cA + (size_t)(t + 1) * kstep;
            const char* a2 = last ? nA : cA + (size_t)(t + 2) * kstep; const char* b2 = last ? nB : cB + (size_t)(t + 2) * kstep;
#endif
            const char* a3 = a2 + kstep; const char* b3 = b2 + kstep;
            if (last && has_next) S.a_ready(nxt);
            if constexpr (SP2) {
            PG8_LDB(B0, 0, 0); PG8_LDB(B1, 0, 1); PG8_SCHED; PG8_LDA(At, 0, 0); PG8_STAGE(PG8_SA(1, 1), a1 + hstep, voffA);
            PG8_WAIT_V(8); PG8_WAIT_L(0); PG8_BAR; PG8_MMA(0, 0, At, B0); PG8_MMA(0, 1, At, B1); PG8_BAR; PG8_SCHED;
            PG8_LDA(At, 0, 1); PG8_STAGE(PG8_SB(0, 0), b2, voffB); PG8_STAGE(PG8_SB(0, 1), b2 + hstep, voffB); PG8_STAGE(PG8_SA(0, 0), a2, voffA);
            PG8_WAIT_V(8); PG8_WAIT_L(0); PG8_BAR; PG8_MMA(1, 0, At, B0); PG8_MMA(1, 1, At, B1); PG8_BAR; PG8_SCHED;
            PG8_LDB(B0, 1, 0); PG8_LDB(B1, 1, 1); PG8_SCHED; PG8_LDA(At, 1, 0); PG8_STAGE(PG8_SA(0, 1), a2 + hstep, voffA);
            PG8_WAIT_V(8); PG8_WAIT_L(0); PG8_BAR; PG8_MMA(0, 0, At, B0); PG8_MMA(0, 1, At, B1); PG8_BAR; PG8_SCHED;
            PG8_LDA(At, 1, 1); PG8_STAGE(PG8_SB(1, 0), b3, voffB); PG8_STAGE(PG8_SB(1, 1), b3 + hstep, voffB); PG8_STAGE(PG8_SA(1, 0), a3, voffA);
            PG8_WAIT_V(8); PG8_WAIT_L(0); PG8_BAR; PG8_MMA(1, 0, At, B0); PG8_MMA(1, 1, At, B1); PG8_BAR; PG8_SCHED;
            } else {
            PG8_LDB(B0, 0, 0); PG8_SCHED; PG8_LDA(At, 0, 0); PG8_STAGE(PG8_SA(1, 1), a1 + hstep, voffA);
            PG8_WAIT_L(8); PG8_BAR; PG8_WAIT_L(0); PG8_MMA(0, 0, At, B0); PG8_BAR; PG8_SCHED;
            PG8_LDB(B1, 0, 1); PG8_STAGE(PG8_SB(0, 0), b2, voffB);
            PG8_BAR; PG8_WAIT_L(0); PG8_MMA(0, 1, At, B1); PG8_BAR;
            PG8_LDA(At, 0, 1); PG8_STAGE(PG8_SA(0, 0), a2, voffA);
            PG8_BAR; PG8_WAIT_L(0); PG8_MMA(1, 0, At, B0); PG8_BAR; PG8_SCHED;
            PG8_STAGE(PG8_SB(0, 1), b2 + hstep, voffB);
            PG8_WAIT_V(6); PG8_BAR; PG8_MMA(1, 1, At, B1); PG8_BAR;
            PG8_LDB(B0, 1, 0); PG8_SCHED; PG8_LDA(At, 1, 0); PG8_STAGE(PG8_SA(0, 1), a2 + hstep, voffA);
            PG8_WAIT_L(8); PG8_BAR; PG8_WAIT_L(0); PG8_MMA(0, 0, At, B0); PG8_BAR; PG8_SCHED;
            PG8_LDB(B1, 1, 1); PG8_STAGE(PG8_SB(1, 0), b3, voffB);
            PG8_BAR; PG8_WAIT_L(0); PG8_MMA(0, 1, At, B1); PG8_BAR;
            PG8_LDA(At, 1, 1); PG8_STAGE(PG8_SA(1, 0), a3, voffA);
            PG8_BAR; PG8_WAIT_L(0); PG8_MMA(1, 0, At, B0); PG8_BAR; PG8_SCHED;
            PG8_STAGE(PG8_SB(1, 1), b3 + hstep, voffB);
            PG8_WAIT_V(6); PG8_BAR; PG8_MMA(1, 1, At, B1); PG8_BAR;
            }
        }
        if constexpr (ALIGN_EPI) { if (wr == 0) PG8_BAR; }
#if defined(PROBE_KREP)
        if constexpr (!Epi::INIT_ACC) {
#pragma unroll
            for (int a = 0; a < 2; ++a)
#pragma unroll
                for (int b = 0; b < 2; ++b)
#pragma unroll
                    for (int m = 0; m < 4; ++m)
#pragma unroll
                        for (int n = 0; n < 2; ++n) acc[a][b][m][n] = acc[a][b][m][n] * (1.0f / PROBE_KREP); }
#endif
        if constexpr (!Epi::AFTER_DRAIN) { E(acc, cur, wr, wc, fr, fq); S.done(cur);
#ifdef PROBE_EPI2
            for (int pe_ = 0; pe_ < PROBE_EPI2; ++pe_) { asm volatile("" ::: "memory"); E(acc, cur, wr, wc, fr, fq); }
#endif
        }
        if (!has_next) break;
#pragma unroll
        for (int a = 0; a < 2; ++a)
#pragma unroll
            for (int b = 0; b < 2; ++b)
#pragma unroll
                for (int m = 0; m < 4; ++m)
#pragma unroll
                    for (int n = 0; n < 2; ++n) acc[a][b][m][n] = (f32x4){0.f, 0.f, 0.f, 0.f};
        cur = nxt; cA = nA; cB = nB; ++ui;
        if constexpr (ALIGN_EPI) { if (wr == 1) PG8_BAR; }
    }
    PG8_WAIT_V(0);
    if constexpr (!ALIGN_EPI) { if (wr == 0) PG8_BAR; }
    PG8_BAR;
    if constexpr (Epi::AFTER_DRAIN) { E.fused(acc, cur, wr, wc, fr, fq, lds, wid, lane); S.done(cur); }
#undef PG8_SA
#undef PG8_SB
#undef PG8_STAGE
#undef PG8_LDA
#undef PG8_LDB
#undef PG8_MMA
#undef PG8_WAIT_V
#undef PG8_WAIT_L
#undef PG8_BAR
#undef PG8_SCHED
}
}
#define GAS __attribute__((address_space(1)))
#define LAS __attribute__((address_space(3)))
typedef unsigned short bf16;
typedef unsigned v4u __attribute__((ext_vector_type(4)));
typedef float f32x4 __attribute__((ext_vector_type(4)));
typedef short bf16x8 __attribute__((ext_vector_type(8)));
typedef GAS unsigned gu32;
typedef GAS unsigned long long gu64;
#define RLX_AGENT __ATOMIC_RELAXED, __HIP_MEMORY_SCOPE_AGENT
#define LDS_WAIT() asm volatile("s_waitcnt lgkmcnt(0)" ::: "memory")
#define VM_WAIT() asm volatile("s_waitcnt vmcnt(0)" ::: "memory")
__device__ __forceinline__ unsigned long long rt() { return __builtin_amdgcn_s_memrealtime(); }
__device__ __forceinline__ unsigned f2bf(float f) { unsigned u = __builtin_bit_cast(unsigned, f); return (u + 0x7fffu + ((u >> 16) & 1u)) >> 16; }
__device__ __forceinline__ unsigned pk2(float lo, float hi) { return f2bf(lo) | (f2bf(hi) << 16); }

#define XB_TMO      128
#define XB_XCNT(j)  (256  + 64 * (j))
#define XB_XSUB(j)  (1280 + 64 * (j))
#define XB_XGEN(j)  (2304 + 64 * (j))
#define XB_TOP      3328
#define XB_TOPGEN   3392
#define XCD_BAR_WORDS 3456
#define XB_SPIN_CAP (1u << 18)

__device__ __forceinline__ unsigned xb_ld(unsigned* p)              { return __hip_atomic_load(p, __ATOMIC_RELAXED, __HIP_MEMORY_SCOPE_AGENT); }
__device__ __forceinline__ unsigned xb_add(unsigned* p, unsigned v) { return __hip_atomic_fetch_add(p, v, __ATOMIC_RELAXED, __HIP_MEMORY_SCOPE_AGENT); }
__device__ __forceinline__ unsigned xb_xcc_id() { return (unsigned)__builtin_amdgcn_s_getreg((3 << 11) | 20) & 0xFu; }
#define XB_SPIN(cond, bar) do { unsigned _sp = 0; while (cond) { __builtin_amdgcn_s_sleep(1); \
    if ((++_sp & 255u) == 0u) { if (xb_ld(&(bar)[XB_TMO])) break; if (_sp > XB_SPIN_CAP) { atomicAdd(&(bar)[XB_TMO], 1u); break; } } } } while (0)

struct XcdBarrier {
    unsigned* bar; unsigned x;
    volatile LAS unsigned* st;
};

__device__ __forceinline__ XcdBarrier xcd_barrier_post(unsigned* bar, volatile LAS unsigned* st) {
    XcdBarrier b; b.bar = bar; b.x = xb_xcc_id(); b.st = st;
    if (threadIdx.x == 0) st[2] = xb_add(&bar[XB_XCNT(b.x)], 1u);
    return b;
}
__device__ __forceinline__ void xcd_barrier_complete(unsigned* bar, unsigned x, unsigned& nloc, unsigned& nx) {
    const unsigned G = gridDim.x * gridDim.y * gridDim.z;
    unsigned sum, cnt, mine, sp = 0u;
    for (;;) {
        sum = 0u; cnt = 0u; mine = 0u;
#pragma unroll
        for (unsigned j = 0; j < 16; ++j) { const unsigned c = xb_ld(&bar[XB_XCNT(j)]); sum += c; cnt += (c > 0u) ? 1u : 0u; mine = (j == x) ? c : mine; }
        if (sum == G) break;
        __builtin_amdgcn_s_sleep(1);
        if ((++sp & 255u) == 0u) { if (xb_ld(&bar[XB_TMO])) break; if (sp > XB_SPIN_CAP) { atomicAdd(&bar[XB_TMO], 1u); break; } }
    }
    nloc = mine > 0u ? mine : 1u; nx = cnt > 0u ? cnt : 1u;
}

__device__ __forceinline__ void xcd_barrier(const XcdBarrier& b) {
    asm volatile("s_waitcnt vmcnt(0)" ::: "memory");
    __syncthreads();
    if (threadIdx.x == 0) {
        unsigned* bar = b.bar;
        __builtin_amdgcn_s_waitcnt(0);
        unsigned nloc = b.st[0], nx = b.st[1];
        if (nloc == 0u) { xcd_barrier_complete(bar, b.x, nloc, nx); b.st[0] = nloc; b.st[1] = nx; }
        const unsigned old = xb_add(&bar[XB_XSUB(b.x)], 1u);
        const unsigned gen = old / nloc;
        if (old + 1u == (gen + 1u) * nloc) {
            __builtin_amdgcn_fence(__ATOMIC_RELEASE, "agent");
            asm volatile("s_waitcnt vmcnt(0)" ::: "memory");
            const unsigned og = xb_add(&bar[XB_TOP], 1u);
            const unsigned tg = og / nx;
            if (og + 1u == (tg + 1u) * nx) xb_add(&bar[XB_TOPGEN], 1u);
            else XB_SPIN(xb_ld(&bar[XB_TOPGEN]) == tg, bar);
            __builtin_amdgcn_fence(__ATOMIC_ACQUIRE, "agent");
            xb_add(&bar[XB_XGEN(b.x)], 1u);
            asm volatile("s_waitcnt vmcnt(0)" ::: "memory");
        } else {
            XB_SPIN(xb_ld(&bar[XB_XGEN(b.x)]) == gen, bar);
            __builtin_amdgcn_fence(__ATOMIC_ACQUIRE, "agent");
            asm volatile("s_waitcnt vmcnt(0)" ::: "memory");
        }
    }
    __syncthreads();
}

constexpr size_t MiB = 1u << 20;
constexpr size_t WS_CTL = 0, CTL_ZERO_BYTES = 1 * MiB;
constexpr size_t WS_MOD = 1 * MiB;
constexpr size_t WS_BGU = WS_MOD + 128 * 1024;
constexpr size_t WS_BCIN = WS_MOD + 256 * 1024;
constexpr size_t WS_BPIN = WS_MOD + 272 * 1024;
constexpr size_t WS_BEFF = WS_MOD + 288 * 1024;
constexpr size_t WS_BPOUT = WS_MOD + 296 * 1024;
constexpr size_t WS_KMEAN = WS_MOD + 512 * 1024;
constexpr size_t WS_SSQ = 2 * MiB;
constexpr size_t WS_ML = 3 * MiB;
constexpr size_t WS_WEFF = 6 * MiB;
constexpr size_t WS_WGU = 8 * MiB;
constexpr size_t WS_WDN = 52 * MiB;
constexpr size_t WS_WCIN = 74 * MiB, WS_WCOUT = 79 * MiB, WS_WPIN = 81 * MiB, WS_WPOUT = 85 * MiB;
constexpr size_t WS_XB = 88 * MiB;
constexpr size_t WS_R1 = 120 * MiB;
constexpr size_t WS_Q = WS_R1, WS_K = WS_R1 + 16 * MiB, WS_V = WS_R1 + 32 * MiB, WS_U = WS_R1 + 48 * MiB, WS_LIST = WS_R1 + 64 * MiB;
constexpr size_t WS_MIX = 208 * MiB;
constexpr size_t WS_PO = 240 * MiB;
constexpr size_t WS_END = 288 * MiB;
constexpr int LIST_PER_HEAD = 256 * 2016;
static_assert(WS_R1 + (size_t)M * DFF * 2 <= WS_MIX && WS_LIST + (size_t)8 * LIST_PER_HEAD * 4 <= WS_MIX && WS_PO + (size_t)3 * M * 512 * 2 <= WS_END, "d_ws map");
constexpr int CW_TMO = 0, CW_CODE = 1, CW_BAR = 4096, CW_CUR = 8192, CUR_STRIDE = 16;

constexpr int RING_OFF = 0, RING_BYTES = 131072;
constexpr int LDSCTL_OFF = RING_BYTES, MISC_OFF = LDSCTL_OFF + 320;
constexpr int TAB_OFF = LDSCTL_OFF + 1024;
constexpr int LDS_BYTES = 147456;
static_assert(TAB_OFF + 2 * 6 * 256 * 4 <= LDS_BYTES, "LDS map");

enum Phase { PH_P0 = 0, PH_P1, PH_L0_GU1, PH_L0_DN1, PH_L0_CIN, PH_L0_CONV, PH_L0_COUT, PH_L0_GU2, PH_L0_DN2,
             PH_L1_GU1, PH_L1_DN1, PH_L1_PIN, PH_L1_PRE, PH_L1_SEL, PH_L1_ATTA, PH_L1_ATTB, PH_L1_POUT, PH_L1_GU2, PH_L1_DN2, PH_FINAL, NPHASE };
constexpr int NWAVES = 8;
constexpr int N_LAUNCHES = MK_N_LAUNCHES;

struct Frame {
    LAS unsigned char* lds;
    volatile LAS unsigned* MISC;
    gu32* ctl;
    int tid, lane, wave, G, bx;
    float* out;
    unsigned char* ws;
};
enum InIdx { IN_X = 0, IN_C, IN_ADA_W, IN_ADA_B, IN_FFN_NORM, IN_W_GATE, IN_W_UP, IN_W_DOWN, IN_MIX_NORM, IN_CONV_W_IN, IN_CONV_A_W, IN_CONV_A_B, IN_LN_A_G, IN_LN_A_B, IN_CONV_B_W,
             IN_CONV_W_OUT, IN_PM_W_IN, IN_POOL_W, IN_POOL_B, IN_POOL_SCALE, IN_PM_W_OUT, IN_FINAL_NORM };
typedef __attribute__((address_space(4))) const unsigned char* kptr_t;
__device__ __forceinline__ const float* inptr(int i) {
    kptr_t p = (kptr_t)__builtin_amdgcn_kernarg_segment_ptr(); asm volatile("" : "+s"(p));
    return *(const float* const __attribute__((address_space(4)))*)(p + 8 * i);
}
#define WSP(T, off) ((T*)(F.ws + (off)))

__device__ __forceinline__ float wave_sum(float v) {
#pragma unroll
    for (int o = 1; o < 64; o <<= 1) v += __shfl_xor(v, o);
    return v;
}
__device__ __forceinline__ float bf2f(unsigned h) { return __uint_as_float(h << 16); }
__device__ __forceinline__ void wg_sync() { __syncthreads(); }
__device__ __forceinline__ void lds_sync() { asm volatile("s_waitcnt lgkmcnt(0)" ::: "memory"); __builtin_amdgcn_s_barrier(); asm volatile("" ::: "memory"); }

__device__ __forceinline__ void p0_phase(Frame& F) {
    LAS float* sm = (LAS float*)F.lds;
    LAS float* red = sm + 1024;
    const float* cvec = inptr(IN_C); const float* ada_w = inptr(IN_ADA_W); const float* ada_b = inptr(IN_ADA_B);
    for (int k = F.tid; k < 1024; k += NWAVES * 64) { const float v = cvec[k]; sm[k] = v / (1.0f + expf(-v)); }
    wg_sync();
    for (int wg = F.bx; wg < 256; wg += F.G) {
        const int layer = wg >> 7, cbase = (wg & 127) * 72;
        const float* W = ada_w + (size_t)layer * 1024 * 9216 + cbase;
        const int rr = F.lane / 18, cc = F.lane - rr * 18;
        f32x4 acc = {0.f, 0.f, 0.f, 0.f};
        if (rr < 3) {
            const int kb = 128 * F.wave;
#pragma unroll 8
            for (int it = 0; it < 43; ++it) { const int kk = 3 * it + rr; if (kk < 128) { const int k = kb + kk; const f32x4 w = *(const f32x4*)(W + (size_t)k * 9216 + 4 * cc); acc += w * sm[k]; } }
#pragma unroll
            for (int e = 0; e < 4; ++e) red[(F.wave * 3 + rr) * 72 + 4 * cc + e] = acc[e];
        }
        wg_sync();
        if (F.tid < 72) { float s = ada_b[layer * 9216 + cbase + F.tid];
            for (int j = 0; j < 24; ++j) s += red[j * 72 + F.tid];
            WSP(float, WS_MOD)[layer * 9216 + cbase + F.tid] = s; }
        wg_sync();
    }
    { const int gw = F.bx * NWAVES + F.wave, NGW = F.G * NWAVES; bf16* XB = WSP(bf16, WS_XB); float* SSQ = WSP(float, WS_SSQ); const float* xin = inptr(IN_X);
      for (int m0 = gw * 8; m0 < M; m0 += NGW * 8) {
          f32x4 v[8][4];
#pragma unroll
          for (int rr = 0; rr < 8; ++rr)
#pragma unroll
              for (int j = 0; j < 4; ++j) v[rr][j] = ((const f32x4*)(xin + (size_t)(m0 + rr) * D))[F.lane + 64 * j];
#pragma unroll
          for (int rr = 0; rr < 8; ++rr) { float s = 0.f;
#pragma unroll
              for (int j = 0; j < 4; ++j) s += (v[rr][j][0] * v[rr][j][0] + v[rr][j][1] * v[rr][j][1]) + (v[rr][j][2] * v[rr][j][2] + v[rr][j][3] * v[rr][j][3]);
              s = wave_sum(s);
              unsigned long long* o8 = (unsigned long long*)(XB + (size_t)(m0 + rr) * D) + F.lane;
#pragma unroll
              for (int j = 0; j < 4; ++j) o8[64 * j] = (unsigned long long)pk2(v[rr][j][0], v[rr][j][1]) | ((unsigned long long)pk2(v[rr][j][2], v[rr][j][3]) << 32);
              if (F.lane < 4) SSQ[(size_t)F.lane * M + m0 + rr] = F.lane == 0 ? s : 0.f; }
      } }
    const float* pool_w = inptr(IN_POOL_W); const float* pool_scale = inptr(IN_POOL_SCALE); const float* pm_w_out = inptr(IN_PM_W_OUT); const float* pool_b = inptr(IN_POOL_B);
    for (int gid = F.bx * NWAVES * 64 + F.tid; gid < 512 * 256; gid += F.G * NWAVES * 64) {
        const int krow = gid >> 8, n4 = (gid & 255) * 4, g = krow >> 7;
        const float* pw = pool_w + (size_t)krow * 128; const float* ps = pool_scale + g * 128; const float* wo = pm_w_out + (size_t)(g * 128) * 1024 + n4;
        f32x4 acc = {0.f, 0.f, 0.f, 0.f};
#pragma unroll 8
        for (int d = 0; d < 128; ++d) { const float a = pw[d] * ps[d]; acc += *(const f32x4*)(wo + (size_t)d * 1024) * a; }
        *(f32x4*)(WSP(float, WS_WEFF) + (size_t)krow * 1024 + n4) = acc;
    }
    for (int wg = F.bx; wg < 16; wg += F.G) {
        const int n = wg * 64 + F.lane; float sacc = 0.f;
#pragma unroll 16
        for (int kk = 0; kk < 64; ++kk) { const int k = F.wave * 64 + kk; sacc += pool_b[k] * pool_scale[k] * pm_w_out[(size_t)k * 1024 + n]; }
        wg_sync();
        red[F.wave * 64 + F.lane] = sacc;
        wg_sync();
        if (F.tid < 64) { float t = 0.f;
#pragma unroll
            for (int w = 0; w < NWAVES; ++w) t += red[w * 64 + F.tid];
            WSP(float, WS_BEFF)[wg * 64 + F.tid] = t; }
    }
}

__device__ __forceinline__ void prep_strip(Frame& F, const float* src, int ldn, const float* src2, int ksplit, int kbeg, int ktiles,
                                           bf16* dst, int ldk, bool useG, const LAS float* Gs, const LAS float* Ss, const float* rsc, float rs_mul, float* bias_out, LAS float* red) {
    const int r = F.lane >> 4, c16 = F.lane & 15;
    f32x4 rs = {rs_mul, rs_mul, rs_mul, rs_mul};
    if (rsc) { const f32x4 g = *(const f32x4*)(rsc + 4 * c16); rs = g * rs_mul; }
    f32x4 bacc = {0.f, 0.f, 0.f, 0.f};
    for (int t = F.wave; t < ktiles; t += NWAVES) {
        const int k0 = kbeg + 64 * t + 16 * r;
        f32x4 v[16];
#pragma unroll
        for (int i = 0; i < 16; ++i) { const int k = k0 + i; const float* p = (src2 && k >= ksplit) ? src2 + (size_t)k * ldn : src + (size_t)k * ldn; v[i] = *(const f32x4*)(p + 4 * c16); }
        if (useG) {
#pragma unroll
            for (int i = 0; i < 16; ++i) { bacc += v[i] * Ss[k0 + i]; v[i] = v[i] * Gs[k0 + i]; }
        }
#pragma unroll
        for (int e = 0; e < 4; ++e) {
            v4u lo, hi; const float s = rs[e];
            lo.x = pk2(v[0][e] * s, v[1][e] * s);   lo.y = pk2(v[2][e] * s, v[3][e] * s);   lo.z = pk2(v[4][e] * s, v[5][e] * s);   lo.w = pk2(v[6][e] * s, v[7][e] * s);
            hi.x = pk2(v[8][e] * s, v[9][e] * s);   hi.y = pk2(v[10][e] * s, v[11][e] * s); hi.z = pk2(v[12][e] * s, v[13][e] * s); hi.w = pk2(v[14][e] * s, v[15][e] * s);
            bf16* o = dst + (size_t)(4 * c16 + e) * ldk + k0;
            *(v4u*)o = lo; *(v4u*)(o + 8) = hi;
        }
    }
    if (bias_out) {
#pragma unroll
        for (int e = 0; e < 4; ++e) { float s = bacc[e]; s += __shfl_xor(s, 16); s += __shfl_xor(s, 32); bacc[e] = s; }
        if (r == 0) {
#pragma unroll
            for (int e = 0; e < 4; ++e) red[F.wave * 64 + 4 * c16 + e] = bacc[e];
        }
        wg_sync();
        if (F.tid < 64) { float s = 0.f;
#pragma unroll
            for (int w = 0; w < NWAVES; ++w) s += red[w * 64 + F.tid];
            bias_out[F.tid] = s; }
        wg_sync();
    }
}
__device__ __forceinline__ void p1_phase(Frame& F) {
    LAS float* Gs = (LAS float*)F.lds;
    LAS float* Ss = Gs + 1024;
    LAS float* red = Ss + 1024;
    const float* MOD = WSP(float, WS_MOD);
    constexpr int N_GU = 352, N_CIN = 40, N_PIN = 32, N_COUT = 16, N_POUT = 16, N_DN = 256;
    constexpr int NITEMS = N_GU + N_CIN + N_PIN + N_COUT + N_POUT + N_DN;
    for (int it = F.bx; it < NITEMS; it += F.G) {
        int s = it;
        if (s < N_GU + N_CIN + N_PIN) {
            const float *nrm, *md; const float* src; int ldn; bf16* dst; float* bias; int n0, drow;
            if (s < N_GU) { const int f = s / 88, r = s % 88, isup = r / 44; n0 = (r % 44) * 64;
                src = inptr(isup ? IN_W_UP : IN_W_GATE) + (size_t)f * 1024 * DFF + n0; ldn = DFF;
                drow = 256 * (n0 / 128) + 128 * isup + (n0 % 128); dst = WSP(bf16, WS_WGU) + (size_t)f * NGU * 1024 + (size_t)drow * 1024; bias = WSP(float, WS_BGU) + f * NGU + drow;
                nrm = inptr(IN_FFN_NORM) + f * 1024; md = MOD + (f >> 1) * 9216 + ((f & 1) ? 6 : 0) * 1024; }
            else if (s < N_GU + N_CIN) { s -= N_GU; n0 = s * 64; const int seg = n0 / 512, c = n0 % 512, t2 = 256 * (c / 128) + (c % 128);
                drow = seg == 0 ? t2 : seg == 1 ? t2 + 128 : seg == 2 ? 2048 + c : seg == 3 ? 1024 + t2 : 1024 + t2 + 128;
                src = inptr(IN_CONV_W_IN) + n0; ldn = NCIN; dst = WSP(bf16, WS_WCIN) + (size_t)drow * 1024; bias = WSP(float, WS_BCIN) + drow;
                nrm = inptr(IN_MIX_NORM); md = MOD + 3 * 1024; }
            else { s -= N_GU + N_CIN; n0 = s * 64; drow = n0;
                src = inptr(IN_PM_W_IN) + n0; ldn = NPIN; dst = WSP(bf16, WS_WPIN) + (size_t)drow * 1024; bias = WSP(float, WS_BPIN) + drow;
                nrm = inptr(IN_MIX_NORM) + 1024; md = MOD + 9216 + 3 * 1024; }
            for (int k = F.tid; k < 1024; k += NWAVES * 64) { Gs[k] = nrm[k] * (1.0f + md[1024 + k]); Ss[k] = md[k]; }
            wg_sync();
            prep_strip(F, src, ldn, nullptr, 0, 0, 16, dst, 1024, true, Gs, Ss, nullptr, 1.0f, bias, red);
            continue;
        }
        s -= N_GU + N_CIN + N_PIN;
        if (s < N_COUT) { const int n0 = s * 64;
            prep_strip(F, inptr(IN_CONV_W_OUT) + n0, 1024, nullptr, 0, 0, 16, WSP(bf16, WS_WCOUT) + (size_t)n0 * 1024, 1024, false, Gs, Ss, MOD + 5 * 1024 + n0, 1.0f, nullptr, red);
            continue; }
        s -= N_COUT;
        if (s < N_POUT) { const int n0 = s * 64; const float* gate = MOD + 9216 + 5 * 1024 + n0;
            prep_strip(F, WSP(float, WS_WEFF) + n0, 1024, inptr(IN_PM_W_OUT) + n0, 512, 0, 16, WSP(bf16, WS_WPOUT) + (size_t)n0 * 1024, 1024, false, Gs, Ss, gate, 1.0f, nullptr, red);
            if (F.tid < 64) WSP(float, WS_BPOUT)[n0 + F.tid] = gate[F.tid] * WSP(float, WS_BEFF)[n0 + F.tid];
            continue; }
        s -= N_POUT;
        { const int f = s / 64, r = s % 64, n0 = (r >> 2) * 64, kq = r & 3;
          const float* gate = MOD + (f >> 1) * 9216 + (((f & 1) ? 6 : 0) + 2) * 1024 + n0;
          prep_strip(F, inptr(IN_W_DOWN) + (size_t)f * DFF * 1024 + n0, 1024, nullptr, 0, 704 * kq, 11, WSP(bf16, WS_WDN) + (size_t)f * 1024 * DFF + (size_t)n0 * DFF, DFF, false, Gs, Ss, gate, 0.5f, nullptr, red); }
    }
}

__device__ __forceinline__ void conv_phase(Frame& F) {
    const bf16* ZC = WSP(bf16, WS_R1); bf16* MIX = WSP(bf16, WS_MIX);
    const int c = F.wave * 64 + F.lane, lane = F.lane;
    LAS float* Y = (LAS float*)F.lds + F.wave * 4096;
    const float* conv_a_w = inptr(IN_CONV_A_W); const float* conv_b_w = inptr(IN_CONV_B_W);
    float w[31];
#pragma unroll
    for (int k = 0; k < 31; ++k) w[k] = conv_a_w[k * 512 + c];
    const float cb = inptr(IN_CONV_A_B)[c], lg = inptr(IN_LN_A_G)[c], lb = inptr(IN_LN_A_B)[c];
    const float w0 = conv_b_w[c], w1 = conv_b_w[512 + c], w2 = conv_b_w[1024 + c];
    const unsigned coff = (unsigned)c * 2u;
    for (int unit = F.bx; unit < M / 64; unit += F.G) {
        const int t0 = __builtin_amdgcn_readfirstlane(unit * 64);
#pragma unroll 1
        for (int hf = 0; hf < 2; ++hf) {
            float a[62]; const int tb = t0 + 32 * hf - 30;
#pragma unroll
            for (int i = 0; i < 62; ++i) { const int t = tb + i; const char* zr = (const char*)ZC + (size_t)(t < 0 ? 0 : t) * 3072; const float v = bf2f(*(const unsigned short*)(zr + coff)); a[i] = t < 0 ? 0.f : v; }
            LAS float* Yh = Y + hf * 2048;
#pragma unroll
            for (int tt = 0; tt < 32; ++tt) { float y = cb;
#pragma unroll
                for (int k = 0; k < 31; ++k) y += w[k] * a[tt + k];
                Yh[tt * 64 + lane] = y; } }
        float mean, rstd;
        { float s1 = 0.f;
#pragma unroll 4
          for (int cc = 0; cc < 64; ++cc) s1 += Y[lane * 64 + ((cc + lane) & 63)];
          mean = s1 * (1.0f / 64.0f); float s2 = 0.f;
#pragma unroll 4
          for (int cc = 0; cc < 64; ++cc) { const float d = Y[lane * 64 + ((cc + lane) & 63)] - mean; s2 += d * d; }
          rstd = 1.0f / sqrtf(s2 * (1.0f / 64.0f) + EPS); }
        char* mrow0 = (char*)MIX + (size_t)t0 * 2048;
#pragma unroll
        for (int tt = 0; tt < 64; ++tt) {
            const float m = __builtin_bit_cast(float, __builtin_amdgcn_readlane(__builtin_bit_cast(int, mean), tt)), r = __builtin_bit_cast(float, __builtin_amdgcn_readlane(__builtin_bit_cast(int, rstd), tt));
            const float yn = (Y[tt * 64 + lane] - m) * r * lg + lb;
            const float sv = yn * __builtin_amdgcn_rcpf(1.0f + __builtin_amdgcn_exp2f(-LOG2E * yn));
            *(unsigned short*)(mrow0 + (size_t)tt * 2048 + coff) = (unsigned short)f2bf(sv); }
        { float cv[66];
#pragma unroll
          for (int i = 0; i < 66; ++i) { const int t = t0 - 2 + i; const char* zr = (const char*)ZC + (size_t)(t < 0 ? 0 : t) * 3072 + 1024; const float v = bf2f(*(const unsigned short*)(zr + coff)); cv[i] = t < 0 ? 0.f : v; }
          const char* zb = (const char*)ZC + (size_t)t0 * 3072 + 2048;
#pragma unroll
          for (int tt = 0; tt < 64; ++tt) { const float bg = bf2f(*(const unsigned short*)(zb + (size_t)tt * 3072 + coff));
              *(unsigned short*)(mrow0 + (size_t)tt * 2048 + 1024 + coff) = (unsigned short)f2bf(bg * (w0 * cv[tt] + w1 * cv[tt + 1] + w2 * cv[tt + 2])); } }
    }
}

__device__ __forceinline__ void unpack8(const v4u q, float (&v)[8]) {
    v[0] = bf2f(q.x & 0xffffu); v[1] = bf2f(q.x >> 16); v[2] = bf2f(q.y & 0xffffu); v[3] = bf2f(q.y >> 16); v[4] = bf2f(q.z & 0xffffu); v[5] = bf2f(q.z >> 16); v[6] = bf2f(q.w & 0xffffu); v[7] = bf2f(q.w >> 16); }
template <int W> __device__ __forceinline__ void pool_strip(const bf16* U, bf16* MIX, int t0, int ch) {
    v4u r[7 + W];
#pragma unroll
    for (int k = 0; k < 7 + W; ++k) { const int t = t0 - (W - 1) + k; const v4u q = *(const v4u*)(U + (size_t)(t < 0 ? 0 : t) * 512 + ch * 8); r[k] = t < 0 ? (v4u){0u, 0u, 0u, 0u} : q; }
    float s[8];
#pragma unroll
    for (int e = 0; e < 8; ++e) s[e] = 0.f;
#pragma unroll
    for (int k = 0; k < W - 1; ++k) { float v[8]; unpack8(r[k], v);
#pragma unroll
        for (int e = 0; e < 8; ++e) s[e] += v[e]; }
#pragma unroll
    for (int i = 0; i < 8; ++i) { float cur[8]; unpack8(r[i + W - 1], cur);
#pragma unroll
        for (int e = 0; e < 8; ++e) s[e] += cur[e];
        const int t = t0 + i; const float inv = 1.0f / (float)((t + 1) < W ? (t + 1) : W); v4u o;
        o.x = pk2(s[0] * inv - cur[0], s[1] * inv - cur[1]); o.y = pk2(s[2] * inv - cur[2], s[3] * inv - cur[3]);
        o.z = pk2(s[4] * inv - cur[4], s[5] * inv - cur[5]); o.w = pk2(s[6] * inv - cur[6], s[7] * inv - cur[7]);
        *(v4u*)(MIX + (size_t)t * 1024 + ch * 8) = o;
        float old[8]; unpack8(r[i], old);
#pragma unroll
        for (int e = 0; e < 8; ++e) s[e] -= old[e]; }
}
__device__ __forceinline__ void pre_phase(Frame& F) {
    const bf16* Kb = WSP(bf16, WS_K); const bf16* U = WSP(bf16, WS_U); bf16* MIX = WSP(bf16, WS_MIX); float* KM = WSP(float, WS_KMEAN);
    LAS float* part = (LAS float*)F.lds;
    for (int unit = F.bx; unit < NBLK * NHEAD; unit += F.G) {
        const int b = unit >> 3, h = unit & 7, key = F.tid >> 3, ch = F.tid & 7;
        float s[8];
#pragma unroll
        for (int e = 0; e < 8; ++e) s[e] = 0.f;
#pragma unroll
        for (int i = 0; i < 4; ++i) { const v4u q = *(const v4u*)(Kb + (size_t)(b * 256 + 64 * i + key) * 512 + h * 64 + ch * 8);
            s[0] += bf2f(q.x & 0xffffu); s[1] += bf2f(q.x >> 16); s[2] += bf2f(q.y & 0xffffu); s[3] += bf2f(q.y >> 16);
            s[4] += bf2f(q.z & 0xffffu); s[5] += bf2f(q.z >> 16); s[6] += bf2f(q.w & 0xffffu); s[7] += bf2f(q.w >> 16); }
#pragma unroll
        for (int e = 0; e < 8; ++e) part[F.tid * 8 + e] = s[e];
        wg_sync();
        if (F.tid < 64) { const int cq = F.tid >> 3, e = F.tid & 7; float t = 0.f;
            for (int kk = 0; kk < 64; ++kk) t += part[(kk * 8 + cq) * 8 + e];
            KM[(size_t)(h * 64 + b) * 64 + F.tid] = t * (1.0f / 256.0f); }
        wg_sync();
    }
    for (int idx = F.bx * NWAVES * 64 + F.tid; idx < (M / 8) * 64; idx += F.G * NWAVES * 64) {
        const int g = (idx >> 6) & 3, ch = g * 16 + (idx & 15), strip = ((idx >> 8) << 2) | ((idx >> 4) & 3), t0 = strip * 8;
        if (g == 0) pool_strip<2>(U, MIX, t0, ch); else if (g == 1) pool_strip<4>(U, MIX, t0, ch); else if (g == 2) pool_strip<8>(U, MIX, t0, ch); else pool_strip<16>(U, MIX, t0, ch);
    }
}

__device__ __forceinline__ int list_off(int b) { return 256 * (63 * b - (b * (b - 1)) / 2); }
__device__ __forceinline__ void sel_phase(Frame& F) {
    const bf16* Qb = WSP(bf16, WS_Q); const float* KM = WSP(float, WS_KMEAN); unsigned* LIST = WSP(unsigned, WS_LIST);
    LAS float* km = (LAS float*)F.lds;
    LAS unsigned* lcnt = (LAS unsigned*)(F.lds + 16384);
    LAS unsigned* lbase = lcnt + 64;
    for (int unit = F.bx; unit < NHEAD * (M / 512); unit += F.G) {
        const int h = unit & 7, chunk = unit >> 3, t = chunk * 512 + F.tid, own = t >> 8, nb = 2 * chunk + 1;
        wg_sync();
        for (int i = F.tid; i < nb * 64; i += NWAVES * 64) km[i] = KM[(size_t)h * 4096 + i];
        if (F.tid < 64) lcnt[F.tid] = 0u;
        wg_sync();
        float q[64];
#pragma unroll
        for (int i = 0; i < 8; ++i) { const v4u v = *(const v4u*)(Qb + (size_t)t * 512 + h * 64 + i * 8);
            q[8 * i + 0] = bf2f(v.x & 0xffffu); q[8 * i + 1] = bf2f(v.x >> 16); q[8 * i + 2] = bf2f(v.y & 0xffffu); q[8 * i + 3] = bf2f(v.y >> 16);
            q[8 * i + 4] = bf2f(v.z & 0xffffu); q[8 * i + 5] = bf2f(v.z >> 16); q[8 * i + 6] = bf2f(v.w & 0xffffu); q[8 * i + 7] = bf2f(v.w >> 16); }
        float v0 = -INFINITY, v1 = -INFINITY, v2 = -INFINITY; int i0 = 0, i1 = 0, i2 = 0;
        for (int b = 0; b < nb; ++b) {
            float g = 0.f;
#pragma unroll
            for (int d4 = 0; d4 < 16; ++d4) { const f32x4 kv = *(const LAS f32x4*)(km + b * 64 + 4 * d4); g += (q[4 * d4] * kv[0] + q[4 * d4 + 1] * kv[1]) + (q[4 * d4 + 2] * kv[2] + q[4 * d4 + 3] * kv[3]); }
            if (b < own) {
                if (g > v0) { v2 = v1; i2 = i1; v1 = v0; i1 = i0; v0 = g; i0 = b; }
                else if (g > v1) { v2 = v1; i2 = i1; v1 = g; i1 = b; }
                else if (g > v2) { v2 = g; i2 = b; }
            }
        }
        const int nsel = own < 3 ? own : 3;
        unsigned p0 = 0, p1 = 0, p2 = 0;
        if (nsel > 0) p0 = __hip_atomic_fetch_add(lcnt + i0, 1u, __ATOMIC_RELAXED, __HIP_MEMORY_SCOPE_WORKGROUP);
        if (nsel > 1) p1 = __hip_atomic_fetch_add(lcnt + i1, 1u, __ATOMIC_RELAXED, __HIP_MEMORY_SCOPE_WORKGROUP);
        if (nsel > 2) p2 = __hip_atomic_fetch_add(lcnt + i2, 1u, __ATOMIC_RELAXED, __HIP_MEMORY_SCOPE_WORKGROUP);
        wg_sync();
        if (F.tid < 64) { const unsigned cn = lcnt[F.tid]; lbase[F.tid] = cn ? atomicAdd((unsigned*)F.ctl + CW_CUR + (h * 64 + F.tid) * CUR_STRIDE, cn) : 0u; }
        wg_sync();
        if (nsel > 0) LIST[(size_t)h * LIST_PER_HEAD + list_off(i0) + lbase[i0] + p0] = (unsigned)t;
        if (nsel > 1) LIST[(size_t)h * LIST_PER_HEAD + list_off(i1) + lbase[i1] + p1] = (unsigned)t | (1u << 16);
        if (nsel > 2) LIST[(size_t)h * LIST_PER_HEAD + list_off(i2) + lbase[i2] + p2] = (unsigned)t | (2u << 16);
    }
}

namespace att {
typedef short s16x4 __attribute__((ext_vector_type(4)));
typedef float f32x16 __attribute__((ext_vector_type(16)));
typedef short v4i16_t __attribute__((ext_vector_type(4)));
typedef float f32x2_t __attribute__((ext_vector_type(2)));
typedef __bf16 bf16x2_t __attribute__((ext_vector_type(2)));
typedef unsigned u32x2_t __attribute__((ext_vector_type(2)));
constexpr int KOFF = 0, VOFF = 32768, WSF_OFF = 65536, QL_OFF = WSF_OFF + 2048, COEF_OFF = QL_OFF + 1024, SCAN_OFF = COEF_OFF + 4096, ATT_LDS_END = SCAN_OFF + 2048;
__device__ __forceinline__ int crow(int r, int hi) { return (r & 3) + 8 * (r >> 2) + 4 * hi; }
__device__ __forceinline__ unsigned cvtpk(float lo, float hi) { f32x2_t v = {lo, hi}; bf16x2_t b = __builtin_convertvector(v, bf16x2_t); return __builtin_bit_cast(unsigned, b); }
__device__ __forceinline__ s16x4 vtr(const LAS unsigned char* p) { return __builtin_bit_cast(s16x4, __builtin_amdgcn_ds_read_tr16_b64_v4i16((LAS v4i16_t*)p)); }
#define ATT_MFMA(a, b, c) __builtin_amdgcn_mfma_f32_32x32x16_bf16(a, b, c, 0, 0, 0)

struct KVRegs { v4u k[4], v[4]; };
__device__ __forceinline__ void kv_issue(KVRegs& R, const bf16* Kb, const bf16* Vb, int b, int h, int wave, int lane) {
    const bf16* ks = Kb + (size_t)(b * 256 + lane) * 512 + h * 64 + wave * 8;
    const bf16* vs = Vb + (size_t)(b * 256 + 16 * (wave & 3) + (lane >> 2)) * 512 + h * 64 + (wave >> 2) * 32 + (lane & 3) * 8;
#pragma unroll
    for (int i = 0; i < 4; ++i) { R.k[i] = *(const v4u*)(ks + (size_t)i * 64 * 512); R.v[i] = *(const v4u*)(vs + (size_t)i * 64 * 512); }
}
__device__ __forceinline__ void kv_commit(LAS unsigned char* lds, const KVRegs& R, int wave, int lane) {
    const int vkey = 16 * (wave & 3) + (lane >> 2);
#pragma unroll
    for (int i = 0; i < 4; ++i) { *(LAS v4u*)(lds + KOFF + i * 8192 + wave * 1024 + lane * 16) = R.k[i];
                                  *(LAS v4u*)(lds + VOFF + i * 8192 + (wave >> 2) * 4096 + vkey * 64 + (lane & 3) * 16) = R.v[i]; }
}
__device__ __forceinline__ void q_load(bf16x8 (&qr)[4], const bf16* Qb, unsigned ent, int h, int hi) {
    const bf16* qp = Qb + (size_t)(ent & 0x3fffu) * 512 + h * 64 + hi * 8;
#pragma unroll
    for (int d0 = 0; d0 < 4; ++d0) qr[d0] = *(const bf16x8*)(qp + d0 * 16);
}
#define ATT_TOUCH4(x) asm volatile("" : "+v"(x[0]), "+v"(x[1]), "+v"(x[2]), "+v"(x[3]))

template <bool OWN, class Pre>
__device__ __forceinline__ void item_compute(Frame& F, int h, int b, unsigned ent, const bf16x8 (&qr)[4], Pre pre) {
    LAS unsigned char* lds = F.lds;
    const int lane = F.lane, wave = F.wave, r32 = lane & 31, hi = lane >> 5;
    const int t = (int)(ent & 0x3fffu);
    const float slope2 = LOG2E / (float)(2 << h);
    float m = -INFINITY, l = 0.f; f32x16 o[2]; o[0] = f32x16{}; o[1] = f32x16{};
    const int ntile = OWN ? ((wave * 32 + 31) >> 6) + 1 : 4;
#pragma unroll 1
    for (int tile = 0; tile < ntile; ++tile) {
        const float base = slope2 * (float)(b * 256 + tile * 64 + 4 * hi - t);
        f32x16 p0, p1;
#pragma unroll
        for (int r = 0; r < 16; ++r) { p0[r] = base + slope2 * (float)((r & 3) + 8 * (r >> 2)); p1[r] = p0[r] + 32.0f * slope2; }
        const LAS unsigned char* kb = lds + KOFF + tile * 8192 + hi * 1024 + r32 * 16;
#pragma unroll
        for (int d0 = 0; d0 < 4; ++d0) { const bf16x8 k0 = *(const LAS bf16x8*)(kb + d0 * 2048), k1 = *(const LAS bf16x8*)(kb + d0 * 2048 + 512);
            p0 = ATT_MFMA(k0, qr[d0], p0); p1 = ATT_MFMA(k1, qr[d0], p1); }
        if (OWN) { const int qo = t - b * 256, kk = tile * 64 + 4 * hi;
#pragma unroll
            for (int r = 0; r < 16; ++r) { const int kv = kk + (r & 3) + 8 * (r >> 2); if (kv > qo) p0[r] = -INFINITY; if (kv + 32 > qo) p1[r] = -INFINITY; } }
        float rm = fmaxf(p0[0], p1[0]);
#pragma unroll
        for (int r = 1; r < 16; ++r) rm = fmaxf(rm, fmaxf(p0[r], p1[r]));
        rm = fmaxf(rm, __shfl_xor(rm, 32));
        const float mn = fmaxf(m, rm), alpha = __builtin_amdgcn_exp2f(m - mn);
        m = mn;
        float ls = 0.f;
#pragma unroll
        for (int r = 0; r < 16; ++r) { p0[r] = __builtin_amdgcn_exp2f(p0[r] - mn); p1[r] = __builtin_amdgcn_exp2f(p1[r] - mn); ls += p0[r] + p1[r]; }
        l = l * alpha + ls;
        if (tile > 0) {
#pragma unroll
            for (int r = 0; r < 16; ++r) { o[0][r] *= alpha; o[1][r] *= alpha; } }
        bf16x8 pa[4];
        { v4u w0 = {cvtpk(p0[0], p0[1]), cvtpk(p0[2], p0[3]), cvtpk(p0[4], p0[5]), cvtpk(p0[6], p0[7])};
          v4u w1 = {cvtpk(p0[8], p0[9]), cvtpk(p0[10], p0[11]), cvtpk(p0[12], p0[13]), cvtpk(p0[14], p0[15])};
          v4u w2 = {cvtpk(p1[0], p1[1]), cvtpk(p1[2], p1[3]), cvtpk(p1[4], p1[5]), cvtpk(p1[6], p1[7])};
          v4u w3 = {cvtpk(p1[8], p1[9]), cvtpk(p1[10], p1[11]), cvtpk(p1[12], p1[13]), cvtpk(p1[14], p1[15])};
          pa[0] = __builtin_bit_cast(bf16x8, w0); pa[1] = __builtin_bit_cast(bf16x8, w1); pa[2] = __builtin_bit_cast(bf16x8, w2); pa[3] = __builtin_bit_cast(bf16x8, w3); }
        const LAS unsigned char* vb = lds + VOFF + tile * 8192 + ((lane >> 4) & 1) * 32 + (lane & 3) * 8 + (4 * hi + ((lane & 15) >> 2)) * 64;
#pragma unroll
        for (int d0 = 0; d0 < 2; ++d0)
#pragma unroll
            for (int ks = 0; ks < 4; ++ks) { const s16x4 lo = vtr(vb + d0 * 4096 + ks * 1024), hh = vtr(vb + d0 * 4096 + ks * 1024 + 512);
                const bf16x8 vf = {lo[0], lo[1], lo[2], lo[3], hh[0], hh[1], hh[2], hh[3]};
                o[d0] = ATT_MFMA(vf, pa[ks], o[d0]); }
    }
    l += __shfl_xor(l, 32);
    pre();
    const size_t dcol = (size_t)h * 64 + 4 * hi;
    if (!OWN) {
        if (!(ent & 0x80000000u)) {
            const int j = (int)((ent >> 16) & 3u); const float rl = 1.0f / l;
            bf16* op = WSP(bf16, WS_PO) + ((size_t)j * M + t) * 512 + dcol;
#pragma unroll
            for (int d0 = 0; d0 < 2; ++d0)
#pragma unroll
                for (int g = 0; g < 4; ++g) { u32x2_t w; w[0] = cvtpk(o[d0][4 * g] * rl, o[d0][4 * g + 1] * rl); w[1] = cvtpk(o[d0][4 * g + 2] * rl, o[d0][4 * g + 3] * rl);
                    *(u32x2_t*)(op + 32 * d0 + 8 * g) = w; }
            if (hi == 0) { f32x2_t ml = {m, l}; *(f32x2_t*)(WSP(float, WS_ML) + (((size_t)j * M + t) * 8 + h) * 2) = ml; }
        }
    } else {
        const int nsel = b < 3 ? b : 3;
        const float* ML = WSP(float, WS_ML); float mj[3], lj[3]; float mx = m;
#pragma unroll
        for (int j = 0; j < 3; ++j) { if (j < nsel) { const f32x2_t ml = *(const f32x2_t*)(ML + (((size_t)j * M + t) * 8 + h) * 2); mj[j] = ml[0]; lj[j] = ml[1]; mx = fmaxf(mx, mj[j]); } else { mj[j] = -INFINITY; lj[j] = 0.f; } }
        u32x2_t pw[3][2][4];
#pragma unroll
        for (int j = 0; j < 3; ++j) if (j < nsel) { const bf16* pp = WSP(bf16, WS_PO) + ((size_t)j * M + t) * 512 + dcol;
#pragma unroll
            for (int d0 = 0; d0 < 2; ++d0)
#pragma unroll
                for (int g = 0; g < 4; ++g) pw[j][d0][g] = *(const u32x2_t*)(pp + 32 * d0 + 8 * g); }
        const float ao = __builtin_amdgcn_exp2f(m - mx); float wj[3]; float den = ao * l;
#pragma unroll
        for (int j = 0; j < 3; ++j) { wj[j] = j < nsel ? lj[j] * __builtin_amdgcn_exp2f(mj[j] - mx) : 0.f; den += wj[j]; }
        const float inv = 1.0f / den, c0 = ao * inv;
        bf16* op = WSP(bf16, WS_MIX) + (size_t)t * 1024 + 512 + dcol;
#pragma unroll
        for (int d0 = 0; d0 < 2; ++d0)
#pragma unroll
            for (int g = 0; g < 4; ++g) { float a[4];
#pragma unroll
                for (int e = 0; e < 4; ++e) a[e] = c0 * o[d0][4 * g + e];
#pragma unroll
                for (int j = 0; j < 3; ++j) if (j < nsel) { const float cj = wj[j] * inv; const u32x2_t q = pw[j][d0][g];
                    a[0] += cj * bf2f(q[0] & 0xffffu); a[1] += cj * bf2f(q[0] >> 16); a[2] += cj * bf2f(q[1] & 0xffffu); a[3] += cj * bf2f(q[1] >> 16); }
                u32x2_t w; w[0] = cvtpk(a[0], a[1]); w[1] = cvtpk(a[2], a[3]); *(u32x2_t*)(op + 32 * d0 + 8 * g) = w; }
    }
}
}

__device__ __forceinline__ void atta_phase(Frame& F) {
    LAS unsigned* SC = (LAS unsigned*)(F.lds + att::SCAN_OFF);
    unsigned* cur = (unsigned*)F.ctl + CW_CUR;
    { const unsigned cn = __hip_atomic_load(cur + F.tid * CUR_STRIDE, __ATOMIC_RELAXED, __HIP_MEMORY_SCOPE_AGENT); SC[F.tid] = (cn + 255u) >> 8; }
    wg_sync();
    for (int off = 1; off < 512; off <<= 1) { const unsigned v = SC[F.tid] + (F.tid >= off ? SC[F.tid - off] : 0u); wg_sync(); SC[F.tid] = v; wg_sync(); }
    const int total = (int)SC[511];
    const bf16* Qb = WSP(bf16, WS_Q); const bf16* Kb = WSP(bf16, WS_K); const bf16* Vb = WSP(bf16, WS_V); const unsigned* LIST = WSP(unsigned, WS_LIST);
    const int row = F.wave * 32 + (F.lane & 31), hi = F.lane >> 5;
    LAS unsigned* ITEM = SC + 512; LAS unsigned* NROW = ITEM + 16;
    if (F.tid < 16) { const int idx_ = F.bx + F.tid * F.G; unsigned it_ = 0u, nr_ = 0u;
        if (idx_ < total) { int lo_ = 0, hi_ = 511; while (lo_ < hi_) { const int mid_ = (lo_ + hi_) >> 1; if ((int)SC[mid_] > idx_) hi_ = mid_; else lo_ = mid_ + 1; }
            const int chunk_ = idx_ - (lo_ ? (int)SC[lo_ - 1] : 0);
            const int cn_ = (int)__hip_atomic_load(cur + lo_ * CUR_STRIDE, __ATOMIC_RELAXED, __HIP_MEMORY_SCOPE_AGENT);
            it_ = (unsigned)lo_ | ((unsigned)chunk_ << 16); nr_ = (unsigned)((cn_ - chunk_ * 256) < 256 ? (cn_ - chunk_ * 256) : 256); }
        ITEM[F.tid] = it_; NROW[F.tid] = nr_; }
    wg_sync();
#define ATTA_DECODE(k_, h_, b_, ent_) do { const unsigned it_ = ITEM[k_]; const int nrows_ = (int)NROW[k_], i_ = (int)(it_ & 0xffffu), chunk_ = (int)(it_ >> 16); h_ = i_ >> 6; b_ = i_ & 63; \
        const unsigned* lp_ = LIST + (size_t)h_ * LIST_PER_HEAD + list_off(b_) + chunk_ * 256; \
        ent_ = lp_[row < nrows_ ? row : nrows_ - 1] | (row < nrows_ ? 0u : 0x80000000u); } while (0)
    int idx = F.bx, kk = 0; if (idx >= total) return;
    int h, b, h1 = 0, b1 = 0, h2 = 0, b2 = 0; unsigned ent, ent1 = 0, ent2 = 0;
    att::KVRegs R; bf16x8 qr[4], qn[4];
    ATTA_DECODE(0, h, b, ent);
    att::kv_issue(R, Kb, Vb, b, h, F.wave, F.lane); att::q_load(qr, Qb, ent, h, hi);
    if (idx + F.G < total) ATTA_DECODE(1, h1, b1, ent1);
    for (;;) {
        lds_sync(); att::kv_commit(F.lds, R, F.wave, F.lane); lds_sync();
        const bool has1 = idx + F.G < total, has2 = idx + 2 * F.G < total && kk + 2 < 16;
        if (has1) { att::kv_issue(R, Kb, Vb, b1, h1, F.wave, F.lane); att::q_load(qn, Qb, ent1, h1, hi); }
        if (has2) ATTA_DECODE(kk + 2, h2, b2, ent2);
#ifdef PROBE_ATT2
        for (int pr_ = 0; pr_ < PROBE_ATT2; ++pr_) att::item_compute<false>(F, h, b, ent, qr, [&]() {});
#endif
        att::item_compute<false>(F, h, b, ent, qr, [&]() { if (has1) {
#pragma unroll
            for (int i = 0; i < 4; ++i) { ATT_TOUCH4(R.k[i]); ATT_TOUCH4(R.v[i]); ATT_TOUCH4(qn[i]); }
            asm volatile("" : "+v"(ent2)); } });
        if (!has1) break;
        idx += F.G; ++kk; h = h1; b = b1; ent = ent1; h1 = h2; b1 = b2; ent1 = ent2;
#pragma unroll
        for (int i = 0; i < 4; ++i) qr[i] = qn[i];
    }
#undef ATTA_DECODE
}
__device__ __forceinline__ void attb_phase(Frame& F) {
    const bf16* Qb = WSP(bf16, WS_Q); const bf16* Kb = WSP(bf16, WS_K); const bf16* Vb = WSP(bf16, WS_V);
    const int row = F.wave * 32 + (F.lane & 31), hi = F.lane >> 5, total = NHEAD * NBLK;
    int idx = F.bx; if (idx >= total) return;
    att::KVRegs R; bf16x8 qr[4], qn[4];
    att::kv_issue(R, Kb, Vb, idx >> 3, idx & 7, F.wave, F.lane); att::q_load(qr, Qb, (unsigned)((idx >> 3) * 256 + row), idx & 7, hi);
    for (;;) {
        lds_sync(); att::kv_commit(F.lds, R, F.wave, F.lane); lds_sync();
        const int nidx = idx + F.G; const bool has1 = nidx < total;
        if (has1) { att::kv_issue(R, Kb, Vb, nidx >> 3, nidx & 7, F.wave, F.lane); att::q_load(qn, Qb, (unsigned)((nidx >> 3) * 256 + row), nidx & 7, hi); }
        att::item_compute<true>(F, idx & 7, idx >> 3, (unsigned)((idx >> 3) * 256 + row), qr, [&]() { if (has1) {
#pragma unroll
            for (int i = 0; i < 4; ++i) { ATT_TOUCH4(R.k[i]); ATT_TOUCH4(R.v[i]); ATT_TOUCH4(qn[i]); } } });
        if (!has1) break;
        idx = nidx;
#pragma unroll
        for (int i = 0; i < 4; ++i) qr[i] = qn[i];
    }
}

__device__ __forceinline__ void final_phase(Frame& F) {
    const int gw = F.bx * NWAVES + F.wave, NGW = F.G * NWAVES; const float* SSQ = WSP(float, WS_SSQ); const bf16* XBp = WSP(bf16, WS_XB);
    f32x4 g[4]; const float* fnorm = inptr(IN_FINAL_NORM);
#pragma unroll
    for (int j = 0; j < 4; ++j) g[j] = ((const f32x4*)fnorm)[F.lane + 64 * j];
    for (int m0 = gw * 4; m0 < M; m0 += NGW * 4) {
        unsigned long long q[4][4]; float ri[4];
#pragma unroll
        for (int rr = 0; rr < 4; ++rr) { const int m = m0 + rr;
            const float s = ((SSQ[m] + SSQ[M + m]) + SSQ[2 * M + m]) + SSQ[3 * M + m]; ri[rr] = 1.0f / sqrtf(s * (1.0f / 1024.0f) + EPS);
#pragma unroll
            for (int j = 0; j < 4; ++j) q[rr][j] = ((const unsigned long long*)(XBp + (size_t)m * D))[F.lane + 64 * j]; }
#pragma unroll
        for (int rr = 0; rr < 4; ++rr) { f32x4* xr = (f32x4*)(F.out + (size_t)(m0 + rr) * D) + F.lane;
#pragma unroll
            for (int j = 0; j < 4; ++j) { const unsigned lo = (unsigned)q[rr][j], hi = (unsigned)(q[rr][j] >> 32);
                const f32x4 v = {__uint_as_float(lo << 16), __uint_as_float(lo & 0xffff0000u), __uint_as_float(hi << 16), __uint_as_float(hi & 0xffff0000u)};
                xr[64 * j] = v * ri[rr] * g[j]; } }
    }
}

struct Args { const float* in[22]; float* out; unsigned char* ws; int ph_lo, ph_hi; };
__global__ void __launch_bounds__(NWAVES * 64, 2) skel_fwd(Args args) {
    extern __shared__ __attribute__((aligned(16))) unsigned char lds[];
    Frame F;
    F.lds = (LAS unsigned char*)lds;
    F.MISC = (volatile LAS unsigned*)(F.lds + MISC_OFF);
    F.tid = threadIdx.x; F.lane = F.tid & 63; F.wave = __builtin_amdgcn_readfirstlane(F.tid >> 6);
    F.G = gridDim.x; F.bx = blockIdx.x;
    F.ws = args.ws; F.ctl = (gu32*)(args.ws + WS_CTL); F.out = args.out;
    for (int u = F.tid; u < (LDS_BYTES - LDSCTL_OFF) / 4; u += NWAVES * 64) ((LAS unsigned*)(F.lds + LDSCTL_OFF))[u] = 0u;
    __syncthreads();
    XcdBarrier bar; bar.bar = (unsigned*)(F.ctl + CW_BAR); bar.x = 0; bar.st = nullptr;
    if (N_LAUNCHES == 1) bar = xcd_barrier_post((unsigned*)(F.ctl + CW_BAR), F.MISC + 8);
    const int lo = args.ph_lo, hi = args.ph_hi;
    unsigned char* ws = F.ws;
#define XB ((const pg8::bf16_t*)(ws + WS_XB))
#define SSQ ((const float*)(ws + WS_SSQ))
#ifndef DBG_ONLY
#define DBG_ONLY -1
#endif
#define IN(k) (lo <= (k) && (k) < hi && (DBG_ONLY < 0 || (k) == DBG_ONLY))
#ifndef PROBE_REPS
#define REPS(k) 1
#else
    constexpr int probe_reps[NPHASE] = PROBE_REPS;
#define REPS(k) probe_reps[k]
#endif
#define REPLOOP(k) for (int rep_ = 0; rep_ < REPS(k); ++rep_, (rep_ < REPS(k) ? xcd_barrier(bar) : (void)0))
#ifdef PROBE_AMP
    unsigned long long ts_prev = __builtin_amdgcn_s_memrealtime(), ts_amp = 0;
#define STAMP(k) do { const unsigned long long now_ = __builtin_amdgcn_s_memrealtime(); if ((k) == PROBE_AMP) ts_amp = now_ - ts_prev; ts_prev = now_; } while (0)
#else
#define STAMP(k) do { } while (0)
#endif
#ifdef PROBE_BAR2
#define SEAM_BAR() do { xcd_barrier(bar); xcd_barrier(bar); } while (0)
#else
#define SEAM_BAR() xcd_barrier(bar)
#endif
#define SEAM(k) do { if (IN(k) && IN((k) + 1)) SEAM_BAR(); STAMP(k); asm volatile("" : "+v"(F.tid), "+v"(F.lane)); asm volatile("" : "+s"(F.ws), "+s"(F.out), "+s"(F.G), "+s"(F.bx), "+s"(F.wave)); ws = F.ws; } while (0)
    LAS float* TAB = (LAS float*)(F.lds + TAB_OFF);

    if (IN(PH_P0)) REPLOOP(PH_P0) { p0_phase(F); } SEAM(PH_P0);
    if (IN(PH_P1)) REPLOOP(PH_P1) { p1_phase(F); } SEAM(PH_P1);
#define FFN_PHASES(f, PH_GU, XIN, F32IN) \
    if (IN(PH_GU)) REPLOOP(PH_GU) { \
        pg8::Gemm g{XB, (const pg8::bf16_t*)(ws + WS_WGU) + (size_t)(f) * NGU * 1024, M, NGU, D}; pg8::StaticOrder S; S.init(M, NGU, F.G, vbx); \
        pg8::fill_tables(TAB, S, SSQ, (const float*)(ws + WS_BGU) + (f) * NGU); pg8::EpiGU E{(pg8::bf16_t*)(ws + WS_R1), TAB}; \
        pg8::gemm_phase<pg8::EpiGU, pg8::StaticOrder, true, true>(F.lds + RING_OFF, g, S, E); } \
    SEAM(PH_GU); \
    if (IN(PH_GU + 1)) REPLOOP(PH_GU + 1) { \
        pg8::Gemm g{(const pg8::bf16_t*)(ws + WS_R1), (const pg8::bf16_t*)(ws + WS_WDN) + (size_t)(f) * 1024 * DFF, M, D, DFF}; pg8::StaticOrder S; S.init(M, D, F.G, vbx); \
        pg8::EpiRes<F32IN> E{XIN, (pg8::bf16_t*)(ws + WS_XB), nullptr, (float*)(ws + WS_SSQ)}; \
        pg8::gemm_phase<pg8::EpiRes<F32IN>, pg8::StaticOrder, false, true>(F.lds + RING_OFF, g, S, E); } \
    SEAM(PH_GU + 1);
#define OUT_PHASE(PH, WOFF, BIAS) \
    if (IN(PH)) REPLOOP(PH) { \
        pg8::Gemm g{(const pg8::bf16_t*)(ws + WS_MIX), (const pg8::bf16_t*)(ws + WOFF), M, D, D}; pg8::StaticOrder S; S.init(M, D, F.G, vbx); \
        pg8::EpiRes<false> E{nullptr, (pg8::bf16_t*)(ws + WS_XB), BIAS, (float*)(ws + WS_SSQ)}; \
        pg8::gemm_phase<pg8::EpiRes<false>, pg8::StaticOrder, false, true>(F.lds + RING_OFF, g, S, E); } \
    SEAM(PH);

    int vbx = F.bx;
    if (N_LAUNCHES == 1 && lo == 0 && F.G == 256) { bool ok = true;
        for (int j = 0; j < 16; ++j) { const unsigned cn = xb_ld(&bar.bar[XB_XCNT(j)]); ok = ok && (cn == (j < 8 ? 32u : 0u)); }
        if (ok) vbx = (int)F.MISC[10] * 8 + (int)bar.x; }
    vbx = __builtin_amdgcn_readfirstlane(vbx);
    FFN_PHASES(0, PH_L0_GU1, inptr(IN_X), true)
    if (IN(PH_L0_CIN)) REPLOOP(PH_L0_CIN) {
        pg8::Gemm g{XB, (const pg8::bf16_t*)(ws + WS_WCIN), M, NCIN, D}; pg8::StaticOrder S; S.init(M, NCIN, F.G, vbx);
        pg8::fill_tables(TAB, S, SSQ, (const float*)(ws + WS_BCIN)); pg8::EpiCin E{(pg8::bf16_t*)(ws + WS_R1), TAB};
        pg8::gemm_phase<pg8::EpiCin, pg8::StaticOrder, true, true>(F.lds + RING_OFF, g, S, E); }
    SEAM(PH_L0_CIN);
    if (IN(PH_L0_CONV)) REPLOOP(PH_L0_CONV) conv_phase(F);
    SEAM(PH_L0_CONV);
    OUT_PHASE(PH_L0_COUT, WS_WCOUT, nullptr)
    FFN_PHASES(1, PH_L0_GU2, nullptr, false)
    FFN_PHASES(2, PH_L1_GU1, nullptr, false)
    if (IN(PH_L1_PIN)) REPLOOP(PH_L1_PIN) {
        pg8::Gemm g{XB, (const pg8::bf16_t*)(ws + WS_WPIN), M, NPIN, D}; pg8::StaticOrder S; S.init(M, NPIN, F.G, vbx);
        pg8::fill_tables(TAB, S, SSQ, (const float*)(ws + WS_BPIN)); pg8::EpiPin E{(pg8::bf16_t*)(ws + WS_Q), TAB};
        pg8::gemm_phase<pg8::EpiPin, pg8::StaticOrder, true, true>(F.lds + RING_OFF, g, S, E); }
    SEAM(PH_L1_PIN);
    if (IN(PH_L1_PRE)) REPLOOP(PH_L1_PRE) pre_phase(F);
    SEAM(PH_L1_PRE);
    if (IN(PH_L1_SEL)) REPLOOP(PH_L1_SEL) sel_phase(F);
    SEAM(PH_L1_SEL);
    if (IN(PH_L1_ATTA)) REPLOOP(PH_L1_ATTA) atta_phase(F);
    SEAM(PH_L1_ATTA);
    if (IN(PH_L1_ATTB)) REPLOOP(PH_L1_ATTB) attb_phase(F);
    SEAM(PH_L1_ATTB);
    OUT_PHASE(PH_L1_POUT, WS_WPOUT, (const float*)(ws + WS_BPOUT))
    FFN_PHASES(3, PH_L1_GU2, nullptr, false)
    if (IN(PH_FINAL)) REPLOOP(PH_FINAL) final_phase(F);
#ifdef PROBE_AMP
    STAMP(PH_FINAL);
    if (F.bx == 0) { const unsigned long long t0_ = __builtin_amdgcn_s_memrealtime(); while (__builtin_amdgcn_s_memrealtime() - t0_ < 8ull * ts_amp) __builtin_amdgcn_s_sleep(8); }
#endif
#undef IN
#undef SEAM
}

extern "C" void kernel_launch(void* const* d_in, const int* in_sizes, int n_in, void* d_out, int out_size, void* d_ws, size_t ws_size, hipStream_t stream) {
    static int grid = 0;
    if (grid == 0) {
        if (n_in != 22 || in_sizes[0] != M * D || out_size != M * D || ws_size < WS_END) { fprintf(stderr, "kernel_launch: unexpected shapes/workspace (n_in %d, ws %zu < %zu); nothing launched\n", n_in, ws_size, (size_t)WS_END); grid = -1; return; }
        int dev = 0, cus = 0;
        if (hipGetDevice(&dev) != hipSuccess || hipDeviceGetAttribute(&cus, hipDeviceAttributeMultiprocessorCount, dev) != hipSuccess) { grid = -1; return; }
        if (hipFuncSetAttribute((const void*)skel_fwd, hipFuncAttributeMaxDynamicSharedMemorySize, LDS_BYTES) != hipSuccess) { fprintf(stderr, "kernel_launch: hipFuncSetAttribute failed\n"); grid = -1; return; }
        (void)hipGetLastError();
        grid = cus;
        if (grid != 256) fprintf(stderr, "kernel_launch: %d CUs; this kernel is laid out for 256\n", grid);
    }
    if (grid < 0) return;
    if (hipMemsetAsync((char*)d_ws + WS_CTL, 0, CTL_ZERO_BYTES, stream) != hipSuccess) return;
    Args a{};
    for (int i = 0; i < 22; ++i) a.in[i] = (const float*)d_in[i];
    a.out = (float*)d_out; a.ws = (unsigned char*)d_ws;
    for (int li = 0; li < N_LAUNCHES; ++li) {
        a.ph_lo = (N_LAUNCHES == 1) ? 0 : li; a.ph_hi = (N_LAUNCHES == 1) ? (int)NPHASE : li + 1;
        hipLaunchKernelGGL(skel_fwd, dim3(grid), dim3(NWAVES * 64), LDS_BYTES, stream, a);
        if (hipPeekAtLastError() != hipSuccess) { fprintf(stderr, "kernel_launch: launch %d failed\n", li); break; }
    }
}
```

```cpp
#include <hip/hip_runtime.h>
#include <hip/hip_bf16.h>
#include <cstdio>
#include <cstdint>
#include <cmath>

#ifndef MK_N_LAUNCHES
#define MK_N_LAUNCHES 1
#endif

constexpr int M = 16384, D = 1024, DFF = 2816, NGU = 2 * DFF, NCIN = 2560, NPIN = 2048;
constexpr int NHEAD = 8, HD = 64, MBLK = 256, NBLK = M / MBLK;
constexpr float EPS = 1e-6f;
constexpr float LOG2E = 1.4426950408889634f;
constexpr float QSCALE = 0.125f * LOG2E;

namespace pg8 {
#define PG8_LAS __attribute__((address_space(3)))
typedef unsigned short bf16_t;
typedef short bf16x8 __attribute__((ext_vector_type(8)));
typedef float f32x4 __attribute__((ext_vector_type(4)));
typedef unsigned u32x4 __attribute__((ext_vector_type(4)));
constexpr int BM = 256, BK = 64, HALF = 128, HTB = HALF * BK * 2  , STAGE_BYTES = 8 * HTB, NXCD = 8, WGM = 8;

__host__ __device__ __forceinline__ int lds_byte(int r, int c) { const int st = (r >> 4) * 2 + (c >> 5), rr = r & 15, cc = c & 31, ob = rr * 64 + cc * 2; return st * 1024 + (ob ^ (((ob >> 9) & 1) << 5)); }
__host__ __device__ __forceinline__ void stage_rc(int b, int& R, int& C) { const int st = b / 1024, sb = b % 1024, swz = sb ^ (((sb >> 9) & 1) << 5); R = (st >> 1) * 16 + swz / 64; C = (st & 1) * 32 + (swz % 64) / 2; }
__host__ __device__ __forceinline__ int perm32(int rho) { const int n = rho >> 4, i = rho & 15; return 8 * (i >> 2) + 4 * n + (i & 3); }

struct Unit { int pm, pn, idx; };
struct Gemm { const bf16_t* A; const bf16_t* Bt; int M, N, K; };

struct StaticOrder {
    int nM, nN, nwg, G, c;
    __host__ __device__ void init(int M, int N, int G_, int c_) { nM = M / BM; nN = N / BM; nwg = nM * nN; G = G_; c = c_; }
    __host__ __device__ bool next(int i, Unit& u) const {
        const long L = (long)i * G + c; if (L >= nwg) return false;
        int wgid = (int)L; { const int q = nwg / NXCD, r = nwg % NXCD, xcd = wgid % NXCD, off = wgid / NXCD; wgid = (xcd < r ? xcd * (q + 1) : r * (q + 1) + (xcd - r) * q) + off; }
        const int nig = WGM * nN, gid = wgid / nig, fm = gid * WGM, gsz = (nM - fm) < WGM ? (nM - fm) : WGM;
        u.pm = fm + ((wgid % nig) % gsz); u.pn = (wgid % nig) / gsz; u.idx = i; return true;
    }
    __device__ __forceinline__ void a_ready(const Unit&) const {}
    __device__ __forceinline__ void done(const Unit&) const {}
};

__device__ __forceinline__ unsigned cvt_pk_bf16(float lo, float hi) { unsigned r; asm volatile("v_cvt_pk_bf16_f32 %0, %1, %2" : "=v"(r) : "v"(lo), "v"(hi)); return r; }

typedef unsigned u32x2 __attribute__((ext_vector_type(2)));
constexpr int TAB_UNITS = 6;
__device__ __forceinline__ void tab_rinv(const PG8_LAS float* tab, const Unit& u, int wr, int fr, float (&rinv)[2][4]) {
#pragma unroll
    for (int ai = 0; ai < 2; ++ai)
#pragma unroll
        for (int m = 0; m < 4; ++m) rinv[ai][m] = tab[u.idx * 256 + ai * HALF + wr * 64 + m * 16 + fr];
}
__device__ __forceinline__ void tab_bias(const PG8_LAS float* tab, const Unit& u, int wc, int fq, f32x4 (&bv)[2][2]) {
#pragma unroll
    for (int bj = 0; bj < 2; ++bj)
#pragma unroll
        for (int n = 0; n < 2; ++n) bv[bj][n] = *(const PG8_LAS f32x4*)(tab + (TAB_UNITS + u.idx) * 256 + bj * HALF + wc * 32 + 8 * fq + 4 * n);
}
template <class Sched> __device__ __forceinline__ void fill_tables(PG8_LAS float* tab, const Sched& S, const float* ssq, const float* bias) {
    int tid = threadIdx.x; asm volatile("" : "+v"(tid));
    Unit u;
    for (int i = 0; i < TAB_UNITS && S.next(i, u); ++i) {
        if (tid < 256) { const int r = u.pm * BM + tid; const float s = ((ssq[r] + ssq[M + r]) + ssq[2 * M + r]) + ssq[3 * M + r]; tab[i * 256 + tid] = 1.0f / sqrtf(s * (1.0f / 1024.0f) + EPS); }
        else tab[(TAB_UNITS + i) * 256 + (tid - 256)] = bias[u.pn * BM + (tid - 256)];
    }
    __syncthreads();
}
__device__ __forceinline__ float sigm(float z) { return __builtin_amdgcn_rcpf(1.0f + __builtin_amdgcn_exp2f(-LOG2E * z)); }
__device__ __forceinline__ u32x4 pack8(const f32x4 a, const f32x4 b) { u32x4 w; w.x = cvt_pk_bf16(a[0], a[1]); w.y = cvt_pk_bf16(a[2], a[3]); w.z = cvt_pk_bf16(b[0], b[1]); w.w = cvt_pk_bf16(b[2], b[3]); return w; }

struct EpiGU {
    static constexpr bool PERM = true, AFTER_DRAIN = false, INIT_ACC = false;
    bf16_t* O; const PG8_LAS float* tab;
    __device__ __forceinline__ void operator()(const f32x4 (&acc)[2][2][4][2], const Unit& u, int wr, int wc, int fr, int fq) const {
        asm volatile("" : "+v"(fr), "+v"(fq));
        const int row0 = u.pm * BM + wr * 64 + fr, bcol0 = u.pn * BM + wc * 32 + 8 * fq, ocol0 = u.pn * HALF + wc * 32 + 8 * fq;
        f32x4 bv[2][2]; tab_bias(tab, u, wc, fq, bv);
        float rinv[2][4]; tab_rinv(tab, u, wr, fr, rinv);
#pragma unroll
        for (int ai = 0; ai < 2; ++ai)
#pragma unroll
            for (int m = 0; m < 4; ++m) { const float ri = rinv[ai][m]; bf16_t* rowp = O + (size_t)(row0 + ai * HALF + m * 16) * DFF + ocol0;
                f32x4 hv[2];
#pragma unroll
                for (int n = 0; n < 2; ++n) { const f32x4 g = acc[ai][0][m][n] * ri + bv[0][n], up = acc[ai][1][m][n] * ri + bv[1][n];
#pragma unroll
                    for (int e = 0; e < 4; ++e) hv[n][e] = g[e] * up[e] * sigm(g[e]); }
                *(u32x4*)rowp = pack8(hv[0], hv[1]);
                if (m & 1) asm volatile("" ::: "memory"); }
    }
};
struct EpiCin {
    static constexpr bool PERM = true, AFTER_DRAIN = false, INIT_ACC = false;
    bf16_t* O; const PG8_LAS float* tab;
    template <int KIND> __device__ __forceinline__ void run(const f32x4 (&acc)[2][2][4][2], const f32x4 (&bv)[2][2], const float (&rinv)[2][4], bf16_t* base) const {
#pragma unroll
        for (int ai = 0; ai < 2; ++ai)
#pragma unroll
            for (int m = 0; m < 4; ++m) { const float ri = rinv[ai][m]; bf16_t* rowp = base + (size_t)(ai * HALF + m * 16) * 1536;
                f32x4 z0[2], z1[2];
#pragma unroll
                for (int n = 0; n < 2; ++n) { z0[n] = acc[ai][0][m][n] * ri + bv[0][n]; z1[n] = acc[ai][1][m][n] * ri + bv[1][n]; }
                if (KIND == 2) { *(u32x4*)rowp = pack8(z0[0], z0[1]); *(u32x4*)(rowp + HALF) = pack8(z1[0], z1[1]); }
                else { f32x4 o[2];
#pragma unroll
                    for (int n = 0; n < 2; ++n)
#pragma unroll
                        for (int e = 0; e < 4; ++e) o[n][e] = KIND == 0 ? z0[n][e] * sigm(z1[n][e]) : z0[n][e] * z1[n][e];
                    *(u32x4*)rowp = pack8(o[0], o[1]); }
                asm volatile("" ::: "memory"); }
    }
    __device__ __forceinline__ void operator()(const f32x4 (&acc)[2][2][4][2], const Unit& u, int wr, int wc, int fr, int fq) const {
        asm volatile("" : "+v"(fr), "+v"(fq));
        const int row0 = u.pm * BM + wr * 64 + fr, bcol0 = u.pn * BM + wc * 32 + 8 * fq;
        f32x4 bv[2][2]; tab_bias(tab, u, wc, fq, bv);
        float rinv[2][4]; tab_rinv(tab, u, wr, fr, rinv);
        const int ocol0 = (u.pn >= 8 ? 1024 + 256 * (u.pn - 8) : 128 * u.pn) + wc * 32 + 8 * fq;
        bf16_t* base = O + (size_t)row0 * 1536 + ocol0;
        if (u.pn < 4) run<0>(acc, bv, rinv, base); else if (u.pn < 8) run<1>(acc, bv, rinv, base); else run<2>(acc, bv, rinv, base);
    }
};
struct EpiPin {
    static constexpr bool PERM = true, AFTER_DRAIN = false, INIT_ACC = false;
    bf16_t* O; const PG8_LAS float* tab; float* kmp;
    __device__ __forceinline__ void operator()(const f32x4 (&acc)[2][2][4][2], const Unit& u, int wr, int wc, int fr, int fq) const {
        asm volatile("" : "+v"(fr), "+v"(fq));
        const int row0 = u.pm * BM + wr * 64 + fr, bcol0 = u.pn * BM + wc * 32 + 8 * fq;
        f32x4 bv[2][2]; tab_bias(tab, u, wc, fq, bv);
        float rinv[2][4]; tab_rinv(tab, u, wr, fr, rinv);
        const int t = u.pn >> 1; const int slot = t == 0 ? 3 : t - 1;
        const float sc = t == 1 ? QSCALE : 1.0f;
        bf16_t* base = O + (size_t)slot * ((size_t)M * 512) + (size_t)row0 * 512 + 256 * (u.pn & 1) + wc * 32 + 8 * fq;
#pragma unroll
        for (int ai = 0; ai < 2; ++ai)
#pragma unroll
            for (int m = 0; m < 4; ++m) { const float ri = rinv[ai][m] * sc; bf16_t* rowp = base + (size_t)(ai * HALF + m * 16) * 512;
#pragma unroll
                for (int bj = 0; bj < 2; ++bj) { const f32x4 z0 = acc[ai][bj][m][0] * ri + bv[bj][0] * sc, z1 = acc[ai][bj][m][1] * ri + bv[bj][1] * sc;
                    *(u32x4*)(rowp + bj * HALF) = pack8(z0, z1); }
                asm volatile("" ::: "memory"); }
        if (t == 2) {
            f32x4 cs[2][2];
#pragma unroll
            for (int bj = 0; bj < 2; ++bj)
#pragma unroll
                for (int n = 0; n < 2; ++n) { f32x4 a = {0.f, 0.f, 0.f, 0.f};
#pragma unroll
                    for (int ai = 0; ai < 2; ++ai)
#pragma unroll
                        for (int m = 0; m < 4; ++m) a += acc[ai][bj][m][n] * rinv[ai][m];
                    a += bv[bj][n] * 8.0f;
#pragma unroll
                    for (int e = 0; e < 4; ++e) { float v = a[e]; v += __shfl_xor(v, 1); v += __shfl_xor(v, 2); v += __shfl_xor(v, 4); v += __shfl_xor(v, 8); a[e] = v; }
                    cs[bj][n] = a; }
            if (fr == 0) { float* kp = kmp + ((size_t)wr * 64 + u.pm) * 512 + 256 * (u.pn & 1) + wc * 32 + 8 * fq;
#pragma unroll
                for (int bj = 0; bj < 2; ++bj)
#pragma unroll
                    for (int n = 0; n < 2; ++n) *(f32x4*)(kp + bj * HALF + 4 * n) = cs[bj][n]; }
        }
    }
};
template <bool F32IN> struct EpiRes {
    static constexpr bool PERM = false, AFTER_DRAIN = true, INIT_ACC = true;
    const float* xin; bf16_t* xb; const float* bias; float* ssq;
    __device__ __forceinline__ void init(f32x4 (&acc)[2][2][4][2], const Unit& u, int wr, int wc, int fr, int fq) const {
        const int col0 = u.pn * BM + wc * 32 + 4 * fq;
#pragma unroll
        for (int ai = 0; ai < 2; ++ai)
#pragma unroll
            for (int m = 0; m < 4; ++m) { const size_t off = (size_t)(u.pm * BM + ai * HALF + wr * 64 + m * 16 + fr) * D + col0;
#pragma unroll
                for (int bj = 0; bj < 2; ++bj)
#pragma unroll
                    for (int n = 0; n < 2; ++n) {
                        if (F32IN) acc[ai][bj][m][n] = *(const f32x4*)(xin + off + bj * HALF + n * 16);
                        else { const u32x2 q = *(const u32x2*)(xb + off + bj * HALF + n * 16);
                            acc[ai][bj][m][n] = (f32x4){__uint_as_float(q.x << 16), __uint_as_float(q.x & 0xffff0000u), __uint_as_float(q.y << 16), __uint_as_float(q.y & 0xffff0000u)}; } } }
        if (bias) {
#pragma unroll
            for (int bj = 0; bj < 2; ++bj)
#pragma unroll
                for (int n = 0; n < 2; ++n) { const f32x4 bv = *(const f32x4*)(bias + col0 + bj * HALF + n * 16);
#pragma unroll
                    for (int ai = 0; ai < 2; ++ai)
#pragma unroll
                        for (int m = 0; m < 4; ++m) acc[ai][bj][m][n] += bv; }
        }
    }
    __device__ __forceinline__ void fused(f32x4 (&acc)[2][2][4][2], const Unit& u, int wr, int wc, int fr, int fq, PG8_LAS unsigned char* lds, int wid, int lane) const {
        PG8_LAS float* P = (PG8_LAS float*)lds;
        asm volatile("" : "+v"(fr), "+v"(fq));
        const int col0 = u.pn * BM + wc * 32 + 4 * fq;
#pragma unroll
        for (int ai = 0; ai < 2; ++ai)
#pragma unroll
            for (int m = 0; m < 4; ++m) { const int rt = ai * HALF + wr * 64 + m * 16 + fr; const size_t off = (size_t)(u.pm * BM + rt) * D + col0; float ss = 0.f;
#pragma unroll
                for (int bj = 0; bj < 2; ++bj)
#pragma unroll
                    for (int n = 0; n < 2; ++n) { const int c = bj * HALF + n * 16; const f32x4 v = acc[ai][bj][m][n];
                        ss += (v[0] * v[0] + v[1] * v[1]) + (v[2] * v[2] + v[3] * v[3]);
                        u32x2 w; w.x = cvt_pk_bf16(v[0], v[1]); w.y = cvt_pk_bf16(v[2], v[3]); *(u32x2*)(xb + off + c) = w; }
                ss += __shfl_xor(ss, 16); ss += __shfl_xor(ss, 32);
                if (fq == 0) P[rt * 4 + wc] = ss; }
        asm volatile("s_waitcnt lgkmcnt(0)" ::: "memory"); __builtin_amdgcn_s_barrier(); asm volatile("" ::: "memory");
        const int tid = wid * 64 + lane;
        if (tid < 256) { const float s = ((P[tid * 4 + 0] + P[tid * 4 + 1]) + P[tid * 4 + 2]) + P[tid * 4 + 3]; ssq[(size_t)u.pn * M + u.pm * BM + tid] = s; }
        asm volatile("s_waitcnt lgkmcnt(0)" ::: "memory"); __builtin_amdgcn_s_barrier(); asm volatile("" ::: "memory");
    }
};

template <class Epi, class Sched, bool ALIGN_EPI = false, bool SP2 = false>
__device__ __forceinline__ void gemm_phase(PG8_LAS unsigned char* lds, const Gemm g, const Sched& S, const Epi& E) {
    int tid = threadIdx.x; asm volatile("" : "+v"(tid));
    const int wid = __builtin_amdgcn_readfirstlane(tid >> 6), lane = tid & 63, wr = wid >> 2, wc = wid & 3, fr = lane & 15, fq = lane >> 4;
    const int K = g.K, nt = K / BK;
    unsigned voffA[2], voffB[2];
#pragma unroll
    for (int i = 0; i < 2; ++i) { int R, C; stage_rc(tid * 16 + i * 8192, R, C); const int Rb = Epi::PERM ? ((R & ~31) + perm32(R & 31)) : R;
        voffA[i] = (unsigned)(R * K + C) * 2u; voffB[i] = (unsigned)(Rb * K + C) * 2u; }
    const size_t kstep = (size_t)(BK * 2);
    const size_t hstep = (size_t)HALF * K * 2;
    const size_t tstep = 2 * hstep;
    const unsigned ldsw = (unsigned)wid * 1024u;
    const int aoff = lds_byte(wr * 64 + fr, fq * 8), boff = lds_byte(wc * 32 + fr, fq * 8);
#define PG8_SA(b, h) (((b) * 2 + (h)) * HTB)
#define PG8_SB(b, h) ((4 + (b) * 2 + (h)) * HTB)
#define PG8_STAGE(bufoff, gbase, voff) do { _Pragma("unroll") for (int _i = 0; _i < 2; ++_i) \
        __builtin_amdgcn_global_load_lds((const unsigned*)((const char*)(gbase) + (voff)[_i]), (PG8_LAS unsigned*)(lds + (bufoff) + ldsw + _i * 8192), 16, 0, 0); } while (0)
#define PG8_LDA(dst, b, h) do { _Pragma("unroll") for (int m = 0; m < 4; ++m) _Pragma("unroll") for (int k = 0; k < 2; ++k) dst[m][k] = *(const PG8_LAS bf16x8*)(lds + PG8_SA(b, h) + aoff + m * 2048 + k * 1024); } while (0)
#define PG8_LDB(dst, b, h) do { _Pragma("unroll") for (int n = 0; n < 2; ++n) _Pragma("unroll") for (int k = 0; k < 2; ++k) dst[n][k] = *(const PG8_LAS bf16x8*)(lds + PG8_SB(b, h) + boff + n * 2048 + k * 1024); } while (0)
#define PG8_MMA(ai, bj, At, Bt) do { __builtin_amdgcn_s_setprio(1); _Pragma("unroll") for (int m = 0; m < 4; ++m) _Pragma("unroll") for (int n = 0; n < 2; ++n) _Pragma("unroll") for (int k = 0; k < 2; ++k) \
        acc[ai][bj][m][n] = __builtin_amdgcn_mfma_f32_16x16x32_bf16(Bt[n][k], At[m][k], acc[ai][bj][m][n], 0, 0, 0); __builtin_amdgcn_s_setprio(0); } while (0)
#define PG8_WAIT_V(n) asm volatile("s_waitcnt vmcnt(" #n ")" ::: "memory")
#define PG8_WAIT_L(n) asm volatile("s_waitcnt lgkmcnt(" #n ")" ::: "memory")
#define PG8_BAR __builtin_amdgcn_s_barrier()
#define PG8_SCHED __builtin_amdgcn_sched_barrier(0)
    Unit cur, nxt; int ui = 0;
    if (!S.next(0, cur)) return;
    f32x4 acc[2][2][4][2];
    if constexpr (Epi::INIT_ACC) { E.init(acc, cur, wr, wc, fr, fq); }
    else {
#pragma unroll
    for (int a = 0; a < 2; ++a)
#pragma unroll
        for (int b = 0; b < 2; ++b)
#pragma unroll
            for (int m = 0; m < 4; ++m)
#pragma unroll
                for (int n = 0; n < 2; ++n) acc[a][b][m][n] = (f32x4){0.f, 0.f, 0.f, 0.f};
    }
    bf16x8 At[4][2], B0[2][2], B1[2][2];
    const char* cA = (const char*)g.A + (size_t)cur.pm * tstep; const char* cB = (const char*)g.Bt + (size_t)cur.pn * tstep;
    S.a_ready(cur);
    if constexpr (SP2) {
        PG8_STAGE(PG8_SB(0, 0), cB, voffB); PG8_STAGE(PG8_SB(0, 1), cB + hstep, voffB); PG8_STAGE(PG8_SA(0, 0), cA, voffA); PG8_STAGE(PG8_SA(0, 1), cA + hstep, voffA);
        if (wr == 1) PG8_BAR;
        PG8_WAIT_V(2); PG8_BAR;
        PG8_STAGE(PG8_SB(1, 0), cB + kstep, voffB); PG8_STAGE(PG8_SA(1, 0), cA + kstep, voffA); PG8_STAGE(PG8_SB(1, 1), cB + hstep + kstep, voffB);
        PG8_WAIT_V(6); PG8_BAR;
    } else {
        PG8_STAGE(PG8_SB(0, 0), cB, voffB); PG8_STAGE(PG8_SA(0, 0), cA, voffA); PG8_STAGE(PG8_SB(0, 1), cB + hstep, voffB); PG8_STAGE(PG8_SA(0, 1), cA + hstep, voffA);
        if (wr == 1) PG8_BAR;
        PG8_WAIT_V(4); PG8_BAR;
        PG8_STAGE(PG8_SB(1, 0), cB + kstep, voffB); PG8_STAGE(PG8_SA(1, 0), cA + kstep, voffA); PG8_STAGE(PG8_SB(1, 1), cB + hstep + kstep, voffB);
        PG8_WAIT_V(6); PG8_BAR;
    }
    for (;;) {
        const bool has_next = S.next(ui + 1, nxt);
        const char* nA = has_next ? (const char*)g.A + (size_t)nxt.pm * tstep : cA; const char* nB = has_next ? (const char*)g.Bt + (size_t)nxt.pn * tstep : cB;
#if defined(PROBE_KREP)
        const int ntr = Epi::INIT_ACC ? nt : nt * PROBE_KREP;
        for (int tq = 0; tq < ntr; tq += 2) {
            const int t = tq % nt;
            const bool last = (tq == ntr - 2);
            const char* a1 = cA + (size_t)(t + 1) * kstep;
            const char* a2 = last ? nA : cA + (size_t)((t + 2) % nt) * kstep; const char* b2 = last ? nB : cB + (size_t)((t + 2) % nt) * kstep;
#else
        for (int t = 0; t < nt; t += 2) {
            const bool last = (t == nt - 2);
            const char* a1 = cA + (size_t)(t + 1) * kstep;
            const char* a2 = last ? nA : cA + (size_t)(t + 2) * kstep; const char* b2 = last ? nB : cB + (size_t)(t + 2) * kstep;
#endif
            const char* a3 = a2 + kstep; const char* b3 = b2 + kstep;
            if (last && has_next) S.a_ready(nxt);
            if constexpr (SP2) {
            PG8_LDB(B0, 0, 0); PG8_LDB(B1, 0, 1); PG8_SCHED; PG8_LDA(At, 0, 0); PG8_STAGE(PG8_SA(1, 1), a1 + hstep, voffA);
            PG8_WAIT_V(8); PG8_WAIT_L(0); PG8_BAR; PG8_MMA(0, 0, At, B0); PG8_MMA(0, 1, At, B1); PG8_BAR; PG8_SCHED;
            PG8_LDA(At, 0, 1); PG8_STAGE(PG8_SB(0, 0), b2, voffB); PG8_STAGE(PG8_SB(0, 1), b2 + hstep, voffB); PG8_STAGE(PG8_SA(0, 0), a2, voffA);
            PG8_WAIT_V(8); PG8_WAIT_L(0); PG8_BAR; PG8_MMA(1, 0, At, B0); PG8_MMA(1, 1, At, B1); PG8_BAR; PG8_SCHED;
            PG8_LDB(B0, 1, 0); PG8_LDB(B1, 1, 1); PG8_SCHED; PG8_LDA(At, 1, 0); PG8_STAGE(PG8_SA(0, 1), a2 + hstep, voffA);
            PG8_WAIT_V(8); PG8_WAIT_L(0); PG8_BAR; PG8_MMA(0, 0, At, B0); PG8_MMA(0, 1, At, B1); PG8_BAR; PG8_SCHED;
            PG8_LDA(At, 1, 1); PG8_STAGE(PG8_SB(1, 0), b3, voffB); PG8_STAGE(PG8_SB(1, 1), b3 + hstep, voffB); PG8_STAGE(PG8_SA(1, 0), a3, voffA);
            PG8_WAIT_V(8); PG8_WAIT_L(0); PG8_BAR; PG8_MMA(1, 0, At, B0); PG8_MMA(1, 1, At, B1); PG8_BAR; PG8_SCHED;
            } else {
            PG8_LDB(B0, 0, 0); PG8_SCHED; PG8_LDA(At, 0, 0); PG8_STAGE(PG8_SA(1, 1), a1 + hstep, voffA);
            PG8_WAIT_L(8); PG8_BAR; PG8_WAIT_L(0); PG8_MMA(0, 0, At, B0); PG8_BAR; PG8_SCHED;
            PG8_LDB(B1, 0, 1); PG8_STAGE(PG8_SB(0, 0), b2, voffB);
            PG8_BAR; PG8_WAIT_L(0); PG8_MMA(0, 1, At, B1); PG8_BAR;
            PG8_LDA(At, 0, 1); PG8_STAGE(PG8_SA(0, 0), a2, voffA);
            PG8_BAR; PG8_WAIT_L(0); PG8_MMA(1, 0, At, B0); PG8_BAR; PG8_SCHED;
            PG8_STAGE(PG8_SB(0, 1), b2 + hstep, voffB);
            PG8_WAIT_V(6); PG8_BAR; PG8_MMA(1, 1, At, B1); PG8_BAR;
            PG8_LDB(B0, 1, 0); PG8_SCHED; PG8_LDA(At, 1, 0); PG8_STAGE(PG8_SA(0, 1), a2 + hstep, voffA);
            PG8_WAIT_L(8); PG8_BAR; PG8_WAIT_L(0); PG8_MMA(0, 0, At, B0); PG8_BAR; PG8_SCHED;
            PG8_LDB(B1, 1, 1); PG8_STAGE(PG8_SB(1, 0), b3, voffB);
            PG8_BAR; PG8_WAIT_L(0); PG8_MMA(0, 1, At, B1); PG8_BAR;
            PG8_LDA(At, 1, 1); PG8_STAGE(PG8_SA(1, 0), a3, voffA);
            PG8_BAR; PG8_WAIT_L(0); PG8_MMA(1, 0, At, B0); PG8_BAR; PG8_SCHED;
            PG8_STAGE(PG8_SB(1, 1), b3 + hstep, voffB);
            PG8_WAIT_V(6); PG8_BAR; PG8_MMA(1, 1, At, B1); PG8_BAR;
            }
        }
        if constexpr (ALIGN_EPI) { if (wr == 0) PG8_BAR; }
#if defined(PROBE_KREP)
        if constexpr (!Epi::INIT_ACC) {
#pragma unroll
            for (int a = 0; a < 2; ++a)
#pragma unroll
                for (int b = 0; b < 2; ++b)
#pragma unroll
                    for (int m = 0; m < 4; ++m)
#pragma unroll
                        for (int n = 0; n < 2; ++n) acc[a][b][m][n] = acc[a][b][m][n] * (1.0f / PROBE_KREP); }
#endif
        if constexpr (!Epi::AFTER_DRAIN) { E(acc, cur, wr, wc, fr, fq); S.done(cur);
#ifdef PROBE_EPI2
            for (int pe_ = 0; pe_ < PROBE_EPI2; ++pe_) { asm volatile("" ::: "memory"); E(acc, cur, wr, wc, fr, fq); }
#endif
        }
        if (!has_next) break;
#pragma unroll
        for (int a = 0; a < 2; ++a)
#pragma unroll
            for (int b = 0; b < 2; ++b)
#pragma unroll
                for (int m = 0; m < 4; ++m)
#pragma unroll
                    for (int n = 0; n < 2; ++n) acc[a][b][m][n] = (f32x4){0.f, 0.f, 0.f, 0.f};
        cur = nxt; cA = nA; cB = nB; ++ui;
        if constexpr (ALIGN_EPI) { if (wr == 1) PG8_BAR; }
    }
    PG8_WAIT_V(0);
    if constexpr (!ALIGN_EPI) { if (wr == 0) PG8_BAR; }
    PG8_BAR;
    if constexpr (Epi::AFTER_DRAIN) { E.fused(acc, cur, wr, wc, fr, fq, lds, wid, lane); S.done(cur); }
#undef PG8_SA
#undef PG8_SB
#undef PG8_STAGE
#undef PG8_LDA
#undef PG8_LDB
#undef PG8_MMA
#undef PG8_WAIT_V
#undef PG8_WAIT_L
#undef PG8_BAR
#undef PG8_SCHED
}
}
#define GAS __attribute__((address_space(1)))
#define LAS __attribute__((address_space(3)))
typedef unsigned short bf16;
typedef unsigned v4u __attribute__((ext_vector_type(4)));
typedef float f32x4 __attribute__((ext_vector_type(4)));
typedef short bf16x8 __attribute__((ext_vector_type(8)));
typedef GAS unsigned gu32;
typedef GAS unsigned long long gu64;
#define RLX_AGENT __ATOMIC_RELAXED, __HIP_MEMORY_SCOPE_AGENT
#define LDS_WAIT() asm volatile("s_waitcnt lgkmcnt(0)" ::: "memory")
#define VM_WAIT() asm volatile("s_waitcnt vmcnt(0)" ::: "memory")
__device__ __forceinline__ unsigned long long rt() { return __builtin_amdgcn_s_memrealtime(); }
__device__ __forceinline__ unsigned f2bf(float f) { unsigned u = __builtin_bit_cast(unsigned, f); return (u + 0x7fffu + ((u >> 16) & 1u)) >> 16; }
__device__ __forceinline__ unsigned pk2(float lo, float hi) { return f2bf(lo) | (f2bf(hi) << 16); }

#define XB_TMO      128
#define XB_XCNT(j)  (256  + 64 * (j))
#define XB_XSUB(j)  (1280 + 64 * (j))
#define XB_XGEN(j)  (2304 + 64 * (j))
#define XB_TOP      3328
#define XB_TOPGEN   3392
#define XCD_BAR_WORDS 3456
#define XB_SPIN_CAP (1u << 18)

__device__ __forceinline__ unsigned xb_ld(unsigned* p)              { return __hip_atomic_load(p, __ATOMIC_RELAXED, __HIP_MEMORY_SCOPE_AGENT); }
__device__ __forceinline__ unsigned xb_add(unsigned* p, unsigned v) { return __hip_atomic_fetch_add(p, v, __ATOMIC_RELAXED, __HIP_MEMORY_SCOPE_AGENT); }
__device__ __forceinline__ unsigned xb_xcc_id() { return (unsigned)__builtin_amdgcn_s_getreg((3 << 11) | 20) & 0xFu; }
#define XB_SPIN(cond, bar) do { unsigned _sp = 0; while (cond) { __builtin_amdgcn_s_sleep(1); \
    if ((++_sp & 255u) == 0u) { if (xb_ld(&(bar)[XB_TMO])) break; if (_sp > XB_SPIN_CAP) { atomicAdd(&(bar)[XB_TMO], 1u); break; } } } } while (0)

struct XcdBarrier {
    unsigned* bar; unsigned x;
    volatile LAS unsigned* st;
};

__device__ __forceinline__ XcdBarrier xcd_barrier_post(unsigned* bar, volatile LAS unsigned* st) {
    XcdBarrier b; b.bar = bar; b.x = xb_xcc_id(); b.st = st;
    if (threadIdx.x == 0) st[2] = xb_add(&bar[XB_XCNT(b.x)], 1u);
    return b;
}
__device__ __forceinline__ void xcd_barrier_complete(unsigned* bar, unsigned x, unsigned& nloc, unsigned& nx) {
    const unsigned G = gridDim.x * gridDim.y * gridDim.z;
    unsigned sum, cnt, mine, sp = 0u;
    for (;;) {
        sum = 0u; cnt = 0u; mine = 0u;
#pragma unroll
        for (unsigned j = 0; j < 16; ++j) { const unsigned c = xb_ld(&bar[XB_XCNT(j)]); sum += c; cnt += (c > 0u) ? 1u : 0u; mine = (j == x) ? c : mine; }
        if (sum == G) break;
        __builtin_amdgcn_s_sleep(1);
        if ((++sp & 255u) == 0u) { if (xb_ld(&bar[XB_TMO])) break; if (sp > XB_SPIN_CAP) { atomicAdd(&bar[XB_TMO], 1u); break; } }
    }
    nloc = mine > 0u ? mine : 1u; nx = cnt > 0u ? cnt : 1u;
}

__device__ __forceinline__ void xcd_barrier(const XcdBarrier& b) {
    asm volatile("s_waitcnt vmcnt(0)" ::: "memory");
    __syncthreads();
    if (threadIdx.x == 0) {
        unsigned* bar = b.bar;
        __builtin_amdgcn_s_waitcnt(0);
        unsigned nloc = b.st[0], nx = b.st[1];
        if (nloc == 0u) { xcd_barrier_complete(bar, b.x, nloc, nx); b.st[0] = nloc; b.st[1] = nx; }
        const unsigned old = xb_add(&bar[XB_XSUB(b.x)], 1u);
        const unsigned gen = old / nloc;
        if (old + 1u == (gen + 1u) * nloc) {
            __builtin_amdgcn_fence(__ATOMIC_RELEASE, "agent");
            asm volatile("s_waitcnt vmcnt(0)" ::: "memory");
            const unsigned og = xb_add(&bar[XB_TOP], 1u);
            const unsigned tg = og / nx;
            if (og + 1u == (tg + 1u) * nx) xb_add(&bar[XB_TOPGEN], 1u);
            else XB_SPIN(xb_ld(&bar[XB_TOPGEN]) == tg, bar);
            __builtin_amdgcn_fence(__ATOMIC_ACQUIRE, "agent");
            xb_add(&bar[XB_XGEN(b.x)], 1u);
            asm volatile("s_waitcnt vmcnt(0)" ::: "memory");
        } else {
            XB_SPIN(xb_ld(&bar[XB_XGEN(b.x)]) == gen, bar);
            __builtin_amdgcn_fence(__ATOMIC_ACQUIRE, "agent");
            asm volatile("s_waitcnt vmcnt(0)" ::: "memory");
        }
    }
    __syncthreads();
}

constexpr size_t MiB = 1u << 20;
constexpr size_t WS_CTL = 0, CTL_ZERO_BYTES = 1 * MiB;
constexpr size_t WS_MOD = 1 * MiB;
constexpr size_t WS_BGU = WS_MOD + 128 * 1024;
constexpr size_t WS_BCIN = WS_MOD + 256 * 1024;
constexpr size_t WS_BPIN = WS_MOD + 272 * 1024;
constexpr size_t WS_BEFF = WS_MOD + 288 * 1024;
constexpr size_t WS_BPOUT = WS_MOD + 296 * 1024;
constexpr size_t WS_KMP = WS_MOD + 512 * 1024;
constexpr size_t WS_SSQ = 2 * MiB;
constexpr size_t WS_MODP = 3 * MiB;
constexpr size_t WS_ML = 3 * MiB;
constexpr size_t WS_WEFF = 6 * MiB;
constexpr size_t WS_WGU = 8 * MiB;
constexpr size_t WS_WDN = 52 * MiB;
constexpr size_t WS_WCIN = 74 * MiB, WS_WCOUT = 79 * MiB, WS_WPIN = 81 * MiB, WS_WPOUT = 85 * MiB;
constexpr size_t WS_XB = 88 * MiB;
constexpr size_t WS_R1 = 120 * MiB;
constexpr size_t WS_Q = WS_R1, WS_K = WS_R1 + 16 * MiB, WS_V = WS_R1 + 32 * MiB, WS_U = WS_R1 + 48 * MiB, WS_LIST = WS_R1 + 64 * MiB;
constexpr size_t WS_MIX = 208 * MiB;
constexpr size_t WS_PO = 240 * MiB;
constexpr size_t WS_END = 288 * MiB;
constexpr int LIST_PER_HEAD = 256 * 2016;
static_assert(WS_R1 + (size_t)M * DFF * 2 <= WS_MIX && WS_LIST + (size_t)8 * LIST_PER_HEAD * 4 <= WS_MIX && WS_PO + (size_t)3 * M * 512 * 2 <= WS_END, "d_ws map");
constexpr int CW_TMO = 0, CW_CODE = 1, CW_BAR = 4096, CW_CUR = 8192, CUR_STRIDE = 16;

constexpr int RING_OFF = 0, RING_BYTES = 131072;
constexpr int LDSCTL_OFF = RING_BYTES, MISC_OFF = LDSCTL_OFF + 320;
constexpr int TAB_OFF = LDSCTL_OFF + 1024;
constexpr int LDS_BYTES = 147456;
static_assert(TAB_OFF + 2 * 6 * 256 * 4 <= LDS_BYTES, "LDS map");

enum Phase { PH_P0 = 0, PH_P1, PH_L0_GU1, PH_L0_DN1, PH_L0_CIN, PH_L0_CONV, PH_L0_COUT, PH_L0_GU2, PH_L0_DN2,
             PH_L1_GU1, PH_L1_DN1, PH_L1_PIN, PH_L1_SEL, PH_L1_ATTA, PH_L1_ATTB, PH_L1_POUT, PH_L1_GU2, PH_L1_DN2, PH_FINAL, NPHASE };
constexpr int NWAVES = 8;
constexpr int N_LAUNCHES = MK_N_LAUNCHES;

struct Frame {
    LAS unsigned char* lds;
    volatile LAS unsigned* MISC;
    gu32* ctl;
    int tid, lane, wave, G, bx;
    float* out;
    unsigned char* ws;
};
enum InIdx { IN_X = 0, IN_C, IN_ADA_W, IN_ADA_B, IN_FFN_NORM, IN_W_GATE, IN_W_UP, IN_W_DOWN, IN_MIX_NORM, IN_CONV_W_IN, IN_CONV_A_W, IN_CONV_A_B, IN_LN_A_G, IN_LN_A_B, IN_CONV_B_W,
             IN_CONV_W_OUT, IN_PM_W_IN, IN_POOL_W, IN_POOL_B, IN_POOL_SCALE, IN_PM_W_OUT, IN_FINAL_NORM };
typedef __attribute__((address_space(4))) const unsigned char* kptr_t;
__device__ __forceinline__ const float* inptr(int i) {
    kptr_t p = (kptr_t)__builtin_amdgcn_kernarg_segment_ptr(); asm volatile("" : "+s"(p));
    return *(const float* const __attribute__((address_space(4)))*)(p + 8 * i);
}
#define WSP(T, off) ((T*)(F.ws + (off)))

__device__ __forceinline__ float wave_sum(float v) {
#pragma unroll
    for (int o = 1; o < 64; o <<= 1) v += __shfl_xor(v, o);
    return v;
}
__device__ __forceinline__ float bf2f(unsigned h) { return __uint_as_float(h << 16); }
__device__ __forceinline__ void wg_sync() { __syncthreads(); }
__device__ __forceinline__ void lds_sync() { asm volatile("s_waitcnt lgkmcnt(0)" ::: "memory"); __builtin_amdgcn_s_barrier(); asm volatile("" ::: "memory"); }

__device__ __forceinline__ void p0_phase(Frame& F) {
    LAS float* sm = (LAS float*)F.lds;
    LAS float* red = sm + 1024;
    const float* cvec = inptr(IN_C); const float* ada_w = inptr(IN_ADA_W);
    for (int k = F.tid; k < 1024; k += NWAVES * 64) { const float v = cvec[k]; sm[k] = v / (1.0f + expf(-v)); }
    wg_sync();
    for (int wg = F.bx; wg < 256; wg += F.G) {
        const int layer = wg >> 7, cchunk = (wg >> 3) & 15, kchunk = wg & 7;
        const float* W = ada_w + (size_t)layer * 1024 * 9216 + cchunk * 576;
        f32x4 acc[3] = {{0.f, 0.f, 0.f, 0.f}, {0.f, 0.f, 0.f, 0.f}, {0.f, 0.f, 0.f, 0.f}};
#pragma unroll 4
        for (int i = 0; i < 16; ++i) { const int k = kchunk * 128 + F.wave + 8 * i; const float cv = sm[k]; const f32x4* wr_ = (const f32x4*)(W + (size_t)k * 9216);
            acc[0] += wr_[F.lane] * cv; acc[1] += wr_[64 + F.lane] * cv; if (F.lane < 16) acc[2] += wr_[128 + F.lane] * cv; }
        wg_sync();
#pragma unroll
        for (int p = 0; p < 3; ++p) if (p < 2 || F.lane < 16) { LAS float* rp = red + F.wave * 576 + 4 * (64 * p + F.lane);
#pragma unroll
            for (int e = 0; e < 4; ++e) rp[e] = acc[p][e]; }
        wg_sync();
        for (int n = F.tid; n < 576; n += NWAVES * 64) { float t = 0.f;
#pragma unroll
            for (int w = 0; w < NWAVES; ++w) t += red[w * 576 + n];
            WSP(float, WS_MODP)[(size_t)kchunk * 18432 + layer * 9216 + cchunk * 576 + n] = t; }
    }
    { const int gw = F.bx * NWAVES + F.wave, NGW = F.G * NWAVES; bf16* XB = WSP(bf16, WS_XB); float* SSQ = WSP(float, WS_SSQ); const float* xin = inptr(IN_X);
      for (int m0 = gw * 8; m0 < M; m0 += NGW * 8) {
          f32x4 v[8][4];
#pragma unroll
          for (int rr = 0; rr < 8; ++rr)
#pragma unroll
              for (int j = 0; j < 4; ++j) v[rr][j] = ((const f32x4*)(xin + (size_t)(m0 + rr) * D))[F.lane + 64 * j];
#pragma unroll
          for (int rr = 0; rr < 8; ++rr) { float s = 0.f;
#pragma unroll
              for (int j = 0; j < 4; ++j) s += (v[rr][j][0] * v[rr][j][0] + v[rr][j][1] * v[rr][j][1]) + (v[rr][j][2] * v[rr][j][2] + v[rr][j][3] * v[rr][j][3]);
              s = wave_sum(s);
              unsigned long long* o8 = (unsigned long long*)(XB + (size_t)(m0 + rr) * D) + F.lane;
#pragma unroll
              for (int j = 0; j < 4; ++j) o8[64 * j] = (unsigned long long)pk2(v[rr][j][0], v[rr][j][1]) | ((unsigned long long)pk2(v[rr][j][2], v[rr][j][3]) << 32);
              if (F.lane < 4) SSQ[(size_t)F.lane * M + m0 + rr] = F.lane == 0 ? s : 0.f; }
      } }
    const float* pool_w = inptr(IN_POOL_W); const float* pool_scale = inptr(IN_POOL_SCALE); const float* pm_w_out = inptr(IN_PM_W_OUT); const float* pool_b = inptr(IN_POOL_B);
    { LAS float* WO = (LAS float*)(F.lds + 32768); LAS float* PW = (LAS float*)(F.lds + 98304);
      for (int it = F.bx; it < 256; it += F.G) {
        const int g = it >> 6, rg = (it >> 3) & 7, cg = it & 7;
        wg_sync();
#pragma unroll
        for (int j = 0; j < 8; ++j) { const int q = F.tid + 512 * j, d = q >> 5, c4 = q & 31;
            *(LAS f32x4*)(WO + d * 128 + 4 * c4) = *(const f32x4*)(pm_w_out + (size_t)(g * 128 + d) * 1024 + cg * 128 + 4 * c4); }
#pragma unroll
        for (int j = 0; j < 4; ++j) { const int e = F.tid + 512 * j, i = e >> 7, d = e & 127; PW[e] = pool_w[(size_t)(g * 128 + rg * 16 + i) * 128 + d] * pool_scale[g * 128 + d]; }
        wg_sync();
        const int rsub = F.tid >> 7, col = F.tid & 127; float acc[4] = {0.f, 0.f, 0.f, 0.f};
#pragma unroll 4
        for (int d4 = 0; d4 < 32; ++d4) { f32x4 p[4];
#pragma unroll
            for (int i = 0; i < 4; ++i) p[i] = *(const LAS f32x4*)(PW + (4 * rsub + i) * 128 + 4 * d4);
#pragma unroll
            for (int dd = 0; dd < 4; ++dd) { const float w = WO[(4 * d4 + dd) * 128 + col];
#pragma unroll
                for (int i = 0; i < 4; ++i) acc[i] += p[i][dd] * w; } }
#pragma unroll
        for (int i = 0; i < 4; ++i) WSP(float, WS_WEFF)[(size_t)(g * 128 + rg * 16 + 4 * rsub + i) * 1024 + cg * 128 + col] = acc[i];
      } }
    for (int wg = F.bx; wg < 16; wg += F.G) {
        const int n = wg * 64 + F.lane; float sacc = 0.f;
#pragma unroll 16
        for (int kk = 0; kk < 64; ++kk) { const int k = F.wave * 64 + kk; sacc += pool_b[k] * pool_scale[k] * pm_w_out[(size_t)k * 1024 + n]; }
        wg_sync();
        red[F.wave * 64 + F.lane] = sacc;
        wg_sync();
        if (F.tid < 64) { float t = 0.f;
#pragma unroll
            for (int w = 0; w < NWAVES; ++w) t += red[w * 64 + F.tid];
            WSP(float, WS_BEFF)[wg * 64 + F.tid] = t; }
    }
}

__device__ __forceinline__ float modv(const float* modp, const float* ada_b, int idx) {
    float t = ada_b[idx];
#pragma unroll
    for (int j = 0; j < 8; ++j) t += modp[(size_t)j * 18432 + idx];
    return t; }
__device__ __forceinline__ f32x4 modv4(const float* modp, const float* ada_b, int idx) {
    f32x4 t = *(const f32x4*)(ada_b + idx);
#pragma unroll
    for (int j = 0; j < 8; ++j) t += *(const f32x4*)(modp + (size_t)j * 18432 + idx);
    return t; }
__device__ __forceinline__ void prep_strip(Frame& F, const float* src, int ldn, const float* src2, int ksplit, int kbeg, int ktiles,
                                           bf16* dst, int ldk, bool useG, const LAS float* Gs, const LAS float* Ss, const float* modp, const float* ada_b, int gidx, float rs_mul, float* bias_out, LAS float* red) {
    const int r = F.lane >> 4, c16 = F.lane & 15;
    f32x4 rs = {rs_mul, rs_mul, rs_mul, rs_mul};
    if (gidx >= 0) { const f32x4 g = modv4(modp, ada_b, gidx + 4 * c16); rs = g * rs_mul; }
    f32x4 bacc = {0.f, 0.f, 0.f, 0.f};
    for (int t = F.wave; t < ktiles; t += NWAVES) {
        const int k0 = kbeg + 64 * t + 16 * r;
        f32x4 v[16];
#pragma unroll
        for (int i = 0; i < 16; ++i) { const int k = k0 + i; const float* p = (src2 && k >= ksplit) ? src2 + (size_t)k * ldn : src + (size_t)k * ldn; v[i] = *(const f32x4*)(p + 4 * c16); }
        if (useG) {
#pragma unroll
            for (int i = 0; i < 16; ++i) { bacc += v[i] * Ss[k0 + i]; v[i] = v[i] * Gs[k0 + i]; }
        }
#pragma unroll
        for (int e = 0; e < 4; ++e) {
            v4u lo, hi; const float s = rs[e];
            lo.x = pk2(v[0][e] * s, v[1][e] * s);   lo.y = pk2(v[2][e] * s, v[3][e] * s);   lo.z = pk2(v[4][e] * s, v[5][e] * s);   lo.w = pk2(v[6][e] * s, v[7][e] * s);
            hi.x = pk2(v[8][e] * s, v[9][e] * s);   hi.y = pk2(v[10][e] * s, v[11][e] * s); hi.z = pk2(v[12][e] * s, v[13][e] * s); hi.w = pk2(v[14][e] * s, v[15][e] * s);
            bf16* o = dst + (size_t)(4 * c16 + e) * ldk + k0;
            *(v4u*)o = lo; *(v4u*)(o + 8) = hi;
        }
    }
    if (bias_out) {
#pragma unroll
        for (int e = 0; e < 4; ++e) { float s = bacc[e]; s += __shfl_xor(s, 16); s += __shfl_xor(s, 32); bacc[e] = s; }
        if (r == 0) {
#pragma unroll
            for (int e = 0; e < 4; ++e) red[F.wave * 64 + 4 * c16 + e] = bacc[e];
        }
        wg_sync();
        if (F.tid < 64) { float s = 0.f;
#pragma unroll
            for (int w = 0; w < NWAVES; ++w) s += red[w * 64 + F.tid];
            bias_out[F.tid] = s; }
        wg_sync();
    }
}
__device__ __forceinline__ void p1_phase(Frame& F) {
    LAS float* Gs = (LAS float*)F.lds;
    LAS float* Ss = Gs + 1024;
    LAS float* red = Ss + 1024;
    const float* MODP = WSP(float, WS_MODP); const float* ada_b = inptr(IN_ADA_B);
    constexpr int N_GU = 352, N_CIN = 40, N_PIN = 32, N_COUT = 16, N_POUT = 16, N_DN = 256;
    constexpr int NITEMS = N_GU + N_CIN + N_PIN + N_COUT + N_POUT + N_DN;
    for (int it = F.bx; it < NITEMS; it += F.G) {
        int s = it;
        if (s < N_GU + N_CIN + N_PIN) {
            const float* nrm; int md; const float* src; int ldn; bf16* dst; float* bias; int n0, drow;
            if (s < N_GU) { const int f = s / 88, r = s % 88, isup = r / 44; n0 = (r % 44) * 64;
                src = inptr(isup ? IN_W_UP : IN_W_GATE) + (size_t)f * 1024 * DFF + n0; ldn = DFF;
                drow = 256 * (n0 / 128) + 128 * isup + (n0 % 128); dst = WSP(bf16, WS_WGU) + (size_t)f * NGU * 1024 + (size_t)drow * 1024; bias = WSP(float, WS_BGU) + f * NGU + drow;
                nrm = inptr(IN_FFN_NORM) + f * 1024; md = (f >> 1) * 9216 + ((f & 1) ? 6 : 0) * 1024; }
            else if (s < N_GU + N_CIN) { s -= N_GU; n0 = s * 64; const int seg = n0 / 512, c = n0 % 512, t2 = 256 * (c / 128) + (c % 128);
                drow = seg == 0 ? t2 : seg == 1 ? t2 + 128 : seg == 2 ? 2048 + c : seg == 3 ? 1024 + t2 : 1024 + t2 + 128;
                src = inptr(IN_CONV_W_IN) + n0; ldn = NCIN; dst = WSP(bf16, WS_WCIN) + (size_t)drow * 1024; bias = WSP(float, WS_BCIN) + drow;
                nrm = inptr(IN_MIX_NORM); md = 3 * 1024; }
            else { s -= N_GU + N_CIN; n0 = s * 64; drow = n0;
                src = inptr(IN_PM_W_IN) + n0; ldn = NPIN; dst = WSP(bf16, WS_WPIN) + (size_t)drow * 1024; bias = WSP(float, WS_BPIN) + drow;
                nrm = inptr(IN_MIX_NORM) + 1024; md = 9216 + 3 * 1024; }
            for (int k = F.tid; k < 1024; k += NWAVES * 64) { Gs[k] = nrm[k] * (1.0f + modv(MODP, ada_b, md + 1024 + k)); Ss[k] = modv(MODP, ada_b, md + k); }
            wg_sync();
            prep_strip(F, src, ldn, nullptr, 0, 0, 16, dst, 1024, true, Gs, Ss, MODP, ada_b, -1, 1.0f, bias, red);
            continue;
        }
        s -= N_GU + N_CIN + N_PIN;
        if (s < N_COUT) { const int n0 = s * 64;
            prep_strip(F, inptr(IN_CONV_W_OUT) + n0, 1024, nullptr, 0, 0, 16, WSP(bf16, WS_WCOUT) + (size_t)n0 * 1024, 1024, false, Gs, Ss, MODP, ada_b, 5 * 1024 + n0, 1.0f, nullptr, red);
            continue; }
        s -= N_COUT;
        if (s < N_POUT) { const int n0 = s * 64; const int gate = 9216 + 5 * 1024 + n0;
            prep_strip(F, WSP(float, WS_WEFF) + n0, 1024, inptr(IN_PM_W_OUT) + n0, 512, 0, 16, WSP(bf16, WS_WPOUT) + (size_t)n0 * 1024, 1024, false, Gs, Ss, MODP, ada_b, gate, 1.0f, nullptr, red);
            if (F.tid < 64) WSP(float, WS_BPOUT)[n0 + F.tid] = modv(MODP, ada_b, gate + F.tid) * WSP(float, WS_BEFF)[n0 + F.tid];
            continue; }
        s -= N_POUT;
        { const int f = s / 64, r = s % 64, n0 = (r >> 2) * 64, kq = r & 3;
          const int gate = (f >> 1) * 9216 + (((f & 1) ? 6 : 0) + 2) * 1024 + n0;
          prep_strip(F, inptr(IN_W_DOWN) + (size_t)f * DFF * 1024 + n0, 1024, nullptr, 0, 704 * kq, 11, WSP(bf16, WS_WDN) + (size_t)f * 1024 * DFF + (size_t)n0 * DFF, DFF, false, Gs, Ss, MODP, ada_b, gate, 0.5f, nullptr, red); }
    }
}

__device__ __forceinline__ void conv_phase(Frame& F) {
    const bf16* ZC = WSP(bf16, WS_R1); bf16* MIX = WSP(bf16, WS_MIX);
    const int c = F.wave * 64 + F.lane, lane = F.lane;
    LAS float* Y = (LAS float*)F.lds + F.wave * 4096;
    const float* conv_a_w = inptr(IN_CONV_A_W); const float* conv_b_w = inptr(IN_CONV_B_W);
    float w[31];
#pragma unroll
    for (int k = 0; k < 31; ++k) w[k] = conv_a_w[k * 512 + c];
    const float cb = inptr(IN_CONV_A_B)[c], lg = inptr(IN_LN_A_G)[c], lb = inptr(IN_LN_A_B)[c];
    const float w0 = conv_b_w[c], w1 = conv_b_w[512 + c], w2 = conv_b_w[1024 + c];
    const unsigned coff = (unsigned)c * 2u;
    for (int unit = F.bx; unit < M / 64; unit += F.G) {
        const int t0 = __builtin_amdgcn_readfirstlane(unit * 64);
#pragma unroll 1
        for (int hf = 0; hf < 2; ++hf) {
            float a[62]; const int tb = t0 + 32 * hf - 30;
#pragma unroll
            for (int i = 0; i < 62; ++i) { const int t = tb + i; const char* zr = (const char*)ZC + (size_t)(t < 0 ? 0 : t) * 3072; const float v = bf2f(*(const unsigned short*)(zr + coff)); a[i] = t < 0 ? 0.f : v; }
            LAS float* Yh = Y + hf * 2048;
#pragma unroll
            for (int tt = 0; tt < 32; ++tt) { float y = cb;
#pragma unroll
                for (int k = 0; k < 31; ++k) y += w[k] * a[tt + k];
                Yh[tt * 64 + lane] = y; } }
        float mean, rstd;
        { float s1 = 0.f;
#pragma unroll 4
          for (int cc = 0; cc < 64; ++cc) s1 += Y[lane * 64 + ((cc + lane) & 63)];
          mean = s1 * (1.0f / 64.0f); float s2 = 0.f;
#pragma unroll 4
          for (int cc = 0; cc < 64; ++cc) { const float d = Y[lane * 64 + ((cc + lane) & 63)] - mean; s2 += d * d; }
          rstd = 1.0f / sqrtf(s2 * (1.0f / 64.0f) + EPS); }
        char* mrow0 = (char*)MIX + (size_t)t0 * 2048;
#pragma unroll
        for (int tt = 0; tt < 64; ++tt) {
            const float m = __builtin_bit_cast(float, __builtin_amdgcn_readlane(__builtin_bit_cast(int, mean), tt)), r = __builtin_bit_cast(float, __builtin_amdgcn_readlane(__builtin_bit_cast(int, rstd), tt));
            const float yn = (Y[tt * 64 + lane] - m) * r * lg + lb;
            const float sv = yn * __builtin_amdgcn_rcpf(1.0f + __builtin_amdgcn_exp2f(-LOG2E * yn));
            *(unsigned short*)(mrow0 + (size_t)tt * 2048 + coff) = (unsigned short)f2bf(sv); }
        { float cv[66];
#pragma unroll
          for (int i = 0; i < 66; ++i) { const int t = t0 - 2 + i; const char* zr = (const char*)ZC + (size_t)(t < 0 ? 0 : t) * 3072 + 1024; const float v = bf2f(*(const unsigned short*)(zr + coff)); cv[i] = t < 0 ? 0.f : v; }
          const char* zb = (const char*)ZC + (size_t)t0 * 3072 + 2048;
#pragma unroll
          for (int tt = 0; tt < 64; ++tt) { const float bg = bf2f(*(const unsigned short*)(zb + (size_t)tt * 3072 + coff));
              *(unsigned short*)(mrow0 + (size_t)tt * 2048 + 1024 + coff) = (unsigned short)f2bf(bg * (w0 * cv[tt] + w1 * cv[tt + 1] + w2 * cv[tt + 2])); } }
    }
}

__device__ __forceinline__ void unpack8(const v4u q, float (&v)[8]) {
    v[0] = bf2f(q.x & 0xffffu); v[1] = bf2f(q.x >> 16); v[2] = bf2f(q.y & 0xffffu); v[3] = bf2f(q.y >> 16); v[4] = bf2f(q.z & 0xffffu); v[5] = bf2f(q.z >> 16); v[6] = bf2f(q.w & 0xffffu); v[7] = bf2f(q.w >> 16); }
template <int W> __device__ __forceinline__ void pool_strip(const bf16* U, bf16* MIX, int t0, int ch) {
    v4u r[7 + W];
#pragma unroll
    for (int k = 0; k < 7 + W; ++k) { const int t = t0 - (W - 1) + k; const v4u q = *(const v4u*)(U + (size_t)(t < 0 ? 0 : t) * 512 + ch * 8); r[k] = t < 0 ? (v4u){0u, 0u, 0u, 0u} : q; }
    float s[8];
#pragma unroll
    for (int e = 0; e < 8; ++e) s[e] = 0.f;
#pragma unroll
    for (int k = 0; k < W - 1; ++k) { float v[8]; unpack8(r[k], v);
#pragma unroll
        for (int e = 0; e < 8; ++e) s[e] += v[e]; }
#pragma unroll
    for (int i = 0; i < 8; ++i) { float cur[8]; unpack8(r[i + W - 1], cur);
#pragma unroll
        for (int e = 0; e < 8; ++e) s[e] += cur[e];
        const int t = t0 + i; const float inv = 1.0f / (float)((t + 1) < W ? (t + 1) : W); v4u o;
        o.x = pk2(s[0] * inv - cur[0], s[1] * inv - cur[1]); o.y = pk2(s[2] * inv - cur[2], s[3] * inv - cur[3]);
        o.z = pk2(s[4] * inv - cur[4], s[5] * inv - cur[5]); o.w = pk2(s[6] * inv - cur[6], s[7] * inv - cur[7]);
        *(v4u*)(MIX + (size_t)t * 1024 + ch * 8) = o;
        float old[8]; unpack8(r[i], old);
#pragma unroll
        for (int e = 0; e < 8; ++e) s[e] -= old[e]; }
}
__device__ __forceinline__ void pool_items(Frame& F) {
    const bf16* U = WSP(bf16, WS_U); bf16* MIX = WSP(bf16, WS_MIX);
    for (int idx = F.bx * NWAVES * 64 + F.tid; idx < (M / 8) * 64; idx += F.G * NWAVES * 64) {
        const int g = (idx >> 6) & 3, ch = g * 16 + (idx & 15), strip = ((idx >> 8) << 2) | ((idx >> 4) & 3), t0 = strip * 8;
        if (g == 0) pool_strip<2>(U, MIX, t0, ch); else if (g == 1) pool_strip<4>(U, MIX, t0, ch); else if (g == 2) pool_strip<8>(U, MIX, t0, ch); else pool_strip<16>(U, MIX, t0, ch);
    }
}

__device__ __forceinline__ int list_off(int b) { return 256 * (63 * b - (b * (b - 1)) / 2); }
typedef float f32x16_t __attribute__((ext_vector_type(16)));
__device__ __forceinline__ bool gate_gt(float g, int b, float v, int i) { return g > v || (g == v && b < i); }
__device__ __forceinline__ void top3_push(float g, int b, float& v0, int& i0, float& v1, int& i1, float& v2, int& i2) {
    const bool c0 = gate_gt(g, b, v0, i0), c1 = gate_gt(g, b, v1, i1), c2 = gate_gt(g, b, v2, i2);
    const float n2 = c1 ? v1 : (c2 ? g : v2), n1 = c0 ? v0 : (c1 ? g : v1), n0 = c0 ? g : v0;
    const int m2 = c1 ? i1 : (c2 ? b : i2), m1 = c0 ? i0 : (c1 ? b : i1), m0 = c0 ? b : i0;
    v0 = n0; v1 = n1; v2 = n2; i0 = m0; i1 = m1; i2 = m2; }
__device__ __forceinline__ void sel_phase(Frame& F) {
    pool_items(F);
    const bf16* Qb = WSP(bf16, WS_Q); const float* KMP = WSP(float, WS_KMP); unsigned* LIST = WSP(unsigned, WS_LIST);
    LAS unsigned char* KH = F.lds;
    LAS unsigned char* KL = F.lds + 8192;
    LAS unsigned* lcnt = (LAS unsigned*)(F.lds + 16384);
    LAS unsigned* lbase = lcnt + 64;
    const int lane = F.lane, r32 = lane & 31, hi = lane >> 5;
    for (int unit = F.bx; unit < NHEAD * NBLK; unit += F.G) {
        const int h = unit & 7, own = unit >> 3, t = own * 256 + F.wave * 32 + r32;
        wg_sync();
        { const int blk = F.tid >> 3, c = F.tid & 7; const float* k0 = KMP + (size_t)blk * 512 + h * 64 + 8 * c; const float* k1 = k0 + 64 * 512;
          const f32x4 a = (*(const f32x4*)k0 + *(const f32x4*)k1) * (1.0f / 256.0f), b = (*(const f32x4*)(k0 + 4) + *(const f32x4*)(k1 + 4)) * (1.0f / 256.0f);
          const float v[8] = {a[0], a[1], a[2], a[3], b[0], b[1], b[2], b[3]}; unsigned hw[8], lw[8];
#pragma unroll
          for (int e = 0; e < 8; ++e) { hw[e] = f2bf(v[e]); lw[e] = f2bf(v[e] - bf2f(hw[e])); }
          v4u ph = {hw[0] | (hw[1] << 16), hw[2] | (hw[3] << 16), hw[4] | (hw[5] << 16), hw[6] | (hw[7] << 16)}, pl = {lw[0] | (lw[1] << 16), lw[2] | (lw[3] << 16), lw[4] | (lw[5] << 16), lw[6] | (lw[7] << 16)};
          *(LAS v4u*)(KH + c * 1024 + blk * 16) = ph; *(LAS v4u*)(KL + c * 1024 + blk * 16) = pl; }
        if (F.tid < 64) lcnt[F.tid] = 0u;
        wg_sync();
        bf16x8 qr[4];
#pragma unroll
        for (int d0 = 0; d0 < 4; ++d0) qr[d0] = *(const bf16x8*)(Qb + (size_t)t * 512 + h * 64 + d0 * 16 + hi * 8);
        f32x16_t p0 = {}, p1 = {};
#pragma unroll
        for (int d0 = 0; d0 < 4; ++d0) { const int o = hi * 1024 + r32 * 16 + d0 * 2048;
            p0 = __builtin_amdgcn_mfma_f32_32x32x16_bf16(*(const LAS bf16x8*)(KH + o), qr[d0], p0, 0, 0, 0); p1 = __builtin_amdgcn_mfma_f32_32x32x16_bf16(*(const LAS bf16x8*)(KH + o + 512), qr[d0], p1, 0, 0, 0);
            p0 = __builtin_amdgcn_mfma_f32_32x32x16_bf16(*(const LAS bf16x8*)(KL + o), qr[d0], p0, 0, 0, 0); p1 = __builtin_amdgcn_mfma_f32_32x32x16_bf16(*(const LAS bf16x8*)(KL + o + 512), qr[d0], p1, 0, 0, 0); }
        float v0 = -INFINITY, v1 = -INFINITY, v2 = -INFINITY; int i0 = 64, i1 = 64, i2 = 64;
#pragma unroll
        for (int r = 0; r < 16; ++r) { const int b0 = (r & 3) + 8 * (r >> 2) + 4 * hi;
            if (b0 < own) top3_push(p0[r], b0, v0, i0, v1, i1, v2, i2);
            if (b0 + 32 < own) top3_push(p1[r], b0 + 32, v0, i0, v1, i1, v2, i2); }
        { const float w0 = __shfl_xor(v0, 32), w1 = __shfl_xor(v1, 32), w2 = __shfl_xor(v2, 32); const int j0 = __shfl_xor(i0, 32), j1 = __shfl_xor(i1, 32), j2 = __shfl_xor(i2, 32);
          if (j0 < 64) top3_push(w0, j0, v0, i0, v1, i1, v2, i2);
          if (j1 < 64) top3_push(w1, j1, v0, i0, v1, i1, v2, i2);
          if (j2 < 64) top3_push(w2, j2, v0, i0, v1, i1, v2, i2); }
        const int nsel = hi == 0 ? (own < 3 ? own : 3) : 0;
        unsigned q0 = 0, q1 = 0, q2 = 0;
        if (nsel > 0) q0 = __hip_atomic_fetch_add(lcnt + i0, 1u, __ATOMIC_RELAXED, __HIP_MEMORY_SCOPE_WORKGROUP);
        if (nsel > 1) q1 = __hip_atomic_fetch_add(lcnt + i1, 1u, __ATOMIC_RELAXED, __HIP_MEMORY_SCOPE_WORKGROUP);
        if (nsel > 2) q2 = __hip_atomic_fetch_add(lcnt + i2, 1u, __ATOMIC_RELAXED, __HIP_MEMORY_SCOPE_WORKGROUP);
        wg_sync();
        if (F.tid < 64) { const unsigned cn = lcnt[F.tid]; lbase[F.tid] = cn ? atomicAdd((unsigned*)F.ctl + CW_CUR + (h * 64 + F.tid) * CUR_STRIDE, cn) : 0u; }
        wg_sync();
        if (nsel > 0) LIST[(size_t)h * LIST_PER_HEAD + list_off(i0) + lbase[i0] + q0] = (unsigned)t;
        if (nsel > 1) LIST[(size_t)h * LIST_PER_HEAD + list_off(i1) + lbase[i1] + q1] = (unsigned)t | (1u << 16);
        if (nsel > 2) LIST[(size_t)h * LIST_PER_HEAD + list_off(i2) + lbase[i2] + q2] = (unsigned)t | (2u << 16);
    }
}

namespace att {
typedef short s16x4 __attribute__((ext_vector_type(4)));
typedef float f32x16 __attribute__((ext_vector_type(16)));
typedef short v4i16_t __attribute__((ext_vector_type(4)));
typedef float f32x2_t __attribute__((ext_vector_type(2)));
typedef __bf16 bf16x2_t __attribute__((ext_vector_type(2)));
typedef unsigned u32x2_t __attribute__((ext_vector_type(2)));
constexpr int KOFF = 0, VOFF = 32768, WSF_OFF = 65536, QL_OFF = WSF_OFF + 2048, COEF_OFF = QL_OFF + 1024, SCAN_OFF = COEF_OFF + 4096, ATT_LDS_END = SCAN_OFF + 2048;
__device__ __forceinline__ int crow(int r, int hi) { return (r & 3) + 8 * (r >> 2) + 4 * hi; }
__device__ __forceinline__ unsigned cvtpk(float lo, float hi) { f32x2_t v = {lo, hi}; bf16x2_t b = __builtin_convertvector(v, bf16x2_t); return __builtin_bit_cast(unsigned, b); }
__device__ __forceinline__ s16x4 vtr(const LAS unsigned char* p) { return __builtin_bit_cast(s16x4, __builtin_amdgcn_ds_read_tr16_b64_v4i16((LAS v4i16_t*)p)); }
#define ATT_MFMA(a, b, c) __builtin_amdgcn_mfma_f32_32x32x16_bf16(a, b, c, 0, 0, 0)

struct KVRegs { v4u k[4], v[4]; };
__device__ __forceinline__ void kv_issue(KVRegs& R, const bf16* Kb, const bf16* Vb, int b, int h, int wave, int lane) {
    const bf16* ks = Kb + (size_t)(b * 256 + lane) * 512 + h * 64 + wave * 8;
    const bf16* vs = Vb + (size_t)(b * 256 + 16 * (wave & 3) + (lane >> 2)) * 512 + h * 64 + (wave >> 2) * 32 + (lane & 3) * 8;
#pragma unroll
    for (int i = 0; i < 4; ++i) { R.k[i] = *(const v4u*)(ks + (size_t)i * 64 * 512); R.v[i] = *(const v4u*)(vs + (size_t)i * 64 * 512); }
}
__device__ __forceinline__ void kv_commit(LAS unsigned char* lds, const KVRegs& R, int wave, int lane) {
    const int vkey = 16 * (wave & 3) + (lane >> 2);
#pragma unroll
    for (int i = 0; i < 4; ++i) { *(LAS v4u*)(lds + KOFF + i * 8192 + wave * 1024 + lane * 16) = R.k[i];
                                  *(LAS v4u*)(lds + VOFF + i * 8192 + (wave >> 2) * 4096 + vkey * 64 + (lane & 3) * 16) = R.v[i]; }
}
__device__ __forceinline__ void q_load(bf16x8 (&qr)[4], const bf16* Qb, unsigned ent, int h, int hi) {
    const bf16* qp = Qb + (size_t)(ent & 0x3fffu) * 512 + h * 64 + hi * 8;
#pragma unroll
    for (int d0 = 0; d0 < 4; ++d0) qr[d0] = *(const bf16x8*)(qp + d0 * 16);
}
#define ATT_TOUCH4(x) asm volatile("" : "+v"(x[0]), "+v"(x[1]), "+v"(x[2]), "+v"(x[3]))

template <bool OWN, class Pre>
__device__ __forceinline__ void item_compute(Frame& F, int h, int b, unsigned ent, const bf16x8 (&qr)[4], Pre pre) {
    LAS unsigned char* lds = F.lds;
    const int lane = F.lane, wave = F.wave, r32 = lane & 31, hi = lane >> 5;
    const int t = (int)(ent & 0x3fffu);
    const float slope2 = LOG2E / (float)(2 << h);
    float m = -INFINITY, l = 0.f; f32x16 o[2]; o[0] = f32x16{}; o[1] = f32x16{};
    const int ntile = OWN ? ((wave * 32 + 31) >> 6) + 1 : 4;
#pragma unroll 1
    for (int tile = 0; tile < ntile; ++tile) {
        const float base = slope2 * (float)(b * 256 + tile * 64 + 4 * hi - t);
        f32x16 p0, p1;
#pragma unroll
        for (int r = 0; r < 16; ++r) { p0[r] = base + slope2 * (float)((r & 3) + 8 * (r >> 2)); p1[r] = p0[r] + 32.0f * slope2; }
        const LAS unsigned char* kb = lds + KOFF + tile * 8192 + hi * 1024 + r32 * 16;
#pragma unroll
        for (int d0 = 0; d0 < 4; ++d0) { const bf16x8 k0 = *(const LAS bf16x8*)(kb + d0 * 2048), k1 = *(const LAS bf16x8*)(kb + d0 * 2048 + 512);
            p0 = ATT_MFMA(k0, qr[d0], p0); p1 = ATT_MFMA(k1, qr[d0], p1); }
        if (OWN) { const int qo = t - b * 256, kk = tile * 64 + 4 * hi;
#pragma unroll
            for (int r = 0; r < 16; ++r) { const int kv = kk + (r & 3) + 8 * (r >> 2); if (kv > qo) p0[r] = -INFINITY; if (kv + 32 > qo) p1[r] = -INFINITY; } }
        float rm = fmaxf(p0[0], p1[0]);
#pragma unroll
        for (int r = 1; r < 16; ++r) rm = fmaxf(rm, fmaxf(p0[r], p1[r]));
        rm = fmaxf(rm, __shfl_xor(rm, 32));
        const float mn = fmaxf(m, rm), alpha = __builtin_amdgcn_exp2f(m - mn);
        m = mn;
        float ls = 0.f;
#pragma unroll
        for (int r = 0; r < 16; ++r) { p0[r] = __builtin_amdgcn_exp2f(p0[r] - mn); p1[r] = __builtin_amdgcn_exp2f(p1[r] - mn); ls += p0[r] + p1[r]; }
        l = l * alpha + ls;
        if (tile > 0) {
#pragma unroll
            for (int r = 0; r < 16; ++r) { o[0][r] *= alpha; o[1][r] *= alpha; } }
        bf16x8 pa[4];
        { v4u w0 = {cvtpk(p0[0], p0[1]), cvtpk(p0[2], p0[3]), cvtpk(p0[4], p0[5]), cvtpk(p0[6], p0[7])};
          v4u w1 = {cvtpk(p0[8], p0[9]), cvtpk(p0[10], p0[11]), cvtpk(p0[12], p0[13]), cvtpk(p0[14], p0[15])};
          v4u w2 = {cvtpk(p1[0], p1[1]), cvtpk(p1[2], p1[3]), cvtpk(p1[4], p1[5]), cvtpk(p1[6], p1[7])};
          v4u w3 = {cvtpk(p1[8], p1[9]), cvtpk(p1[10], p1[11]), cvtpk(p1[12], p1[13]), cvtpk(p1[14], p1[15])};
          pa[0] = __builtin_bit_cast(bf16x8, w0); pa[1] = __builtin_bit_cast(bf16x8, w1); pa[2] = __builtin_bit_cast(bf16x8, w2); pa[3] = __builtin_bit_cast(bf16x8, w3); }
        const LAS unsigned char* vb = lds + VOFF + tile * 8192 + ((lane >> 4) & 1) * 32 + (lane & 3) * 8 + (4 * hi + ((lane & 15) >> 2)) * 64;
#pragma unroll
        for (int d0 = 0; d0 < 2; ++d0)
#pragma unroll
            for (int ks = 0; ks < 4; ++ks) { const s16x4 lo = vtr(vb + d0 * 4096 + ks * 1024), hh = vtr(vb + d0 * 4096 + ks * 1024 + 512);
                const bf16x8 vf = {lo[0], lo[1], lo[2], lo[3], hh[0], hh[1], hh[2], hh[3]};
                o[d0] = ATT_MFMA(vf, pa[ks], o[d0]); }
    }
    l += __shfl_xor(l, 32);
    pre();
    const size_t dcol = (size_t)h * 64 + 4 * hi;
    if (!OWN) {
        if (!(ent & 0x80000000u)) {
            const int j = (int)((ent >> 16) & 3u); const float rl = 1.0f / l;
            bf16* op = WSP(bf16, WS_PO) + ((size_t)j * M + t) * 512 + dcol;
#pragma unroll
            for (int d0 = 0; d0 < 2; ++d0)
#pragma unroll
                for (int g = 0; g < 4; ++g) { u32x2_t w; w[0] = cvtpk(o[d0][4 * g] * rl, o[d0][4 * g + 1] * rl); w[1] = cvtpk(o[d0][4 * g + 2] * rl, o[d0][4 * g + 3] * rl);
                    *(u32x2_t*)(op + 32 * d0 + 8 * g) = w; }
            if (hi == 0) { f32x2_t ml = {m, l}; *(f32x2_t*)(WSP(float, WS_ML) + (((size_t)j * M + t) * 8 + h) * 2) = ml; }
        }
    } else {
        const int nsel = b < 3 ? b : 3;
        const float* ML = WSP(float, WS_ML); float mj[3], lj[3]; float mx = m;
#pragma unroll
        for (int j = 0; j < 3; ++j) { if (j < nsel) { const f32x2_t ml = *(const f32x2_t*)(ML + (((size_t)j * M + t) * 8 + h) * 2); mj[j] = ml[0]; lj[j] = ml[1]; mx = fmaxf(mx, mj[j]); } else { mj[j] = -INFINITY; lj[j] = 0.f; } }
        u32x2_t pw[3][2][4];
#pragma unroll
        for (int j = 0; j < 3; ++j) if (j < nsel) { const bf16* pp = WSP(bf16, WS_PO) + ((size_t)j * M + t) * 512 + dcol;
#pragma unroll
            for (int d0 = 0; d0 < 2; ++d0)
#pragma unroll
                for (int g = 0; g < 4; ++g) pw[j][d0][g] = *(const u32x2_t*)(pp + 32 * d0 + 8 * g); }
        const float ao = __builtin_amdgcn_exp2f(m - mx); float wj[3]; float den = ao * l;
#pragma unroll
        for (int j = 0; j < 3; ++j) { wj[j] = j < nsel ? lj[j] * __builtin_amdgcn_exp2f(mj[j] - mx) : 0.f; den += wj[j]; }
        const float inv = 1.0f / den, c0 = ao * inv;
        bf16* op = WSP(bf16, WS_MIX) + (size_t)t * 1024 + 512 + dcol;
#pragma unroll
        for (int d0 = 0; d0 < 2; ++d0)
#pragma unroll
            for (int g = 0; g < 4; ++g) { float a[4];
#pragma unroll
                for (int e = 0; e < 4; ++e) a[e] = c0 * o[d0][4 * g + e];
#pragma unroll
                for (int j = 0; j < 3; ++j) if (j < nsel) { const float cj = wj[j] * inv; const u32x2_t q = pw[j][d0][g];
                    a[0] += cj * bf2f(q[0] & 0xffffu); a[1] += cj * bf2f(q[0] >> 16); a[2] += cj * bf2f(q[1] & 0xffffu); a[3] += cj * bf2f(q[1] >> 16); }
                u32x2_t w; w[0] = cvtpk(a[0], a[1]); w[1] = cvtpk(a[2], a[3]); *(u32x2_t*)(op + 32 * d0 + 8 * g) = w; }
    }
}
}

__device__ __forceinline__ void atta_phase(Frame& F) {
    LAS unsigned* SC = (LAS unsigned*)(F.lds + att::SCAN_OFF);
    unsigned* cur = (unsigned*)F.ctl + CW_CUR;
    { const unsigned cn = __hip_atomic_load(cur + F.tid * CUR_STRIDE, __ATOMIC_RELAXED, __HIP_MEMORY_SCOPE_AGENT); SC[F.tid] = (cn + 255u) >> 8; }
    wg_sync();
    for (int off = 1; off < 512; off <<= 1) { const unsigned v = SC[F.tid] + (F.tid >= off ? SC[F.tid - off] : 0u); wg_sync(); SC[F.tid] = v; wg_sync(); }
    const int total = (int)SC[511];
    const bf16* Qb = WSP(bf16, WS_Q); const bf16* Kb = WSP(bf16, WS_K); const bf16* Vb = WSP(bf16, WS_V); const unsigned* LIST = WSP(unsigned, WS_LIST);
    const int row = F.wave * 32 + (F.lane & 31), hi = F.lane >> 5;
    LAS unsigned* ITEM = SC + 512; LAS unsigned* NROW = ITEM + 16;
    if (F.tid < 16) { const int idx_ = F.bx + F.tid * F.G; unsigned it_ = 0u, nr_ = 0u;
        if (idx_ < total) { int lo_ = 0, hi_ = 511; while (lo_ < hi_) { const int mid_ = (lo_ + hi_) >> 1; if ((int)SC[mid_] > idx_) hi_ = mid_; else lo_ = mid_ + 1; }
            const int chunk_ = idx_ - (lo_ ? (int)SC[lo_ - 1] : 0);
            const int cn_ = (int)__hip_atomic_load(cur + lo_ * CUR_STRIDE, __ATOMIC_RELAXED, __HIP_MEMORY_SCOPE_AGENT);
            it_ = (unsigned)lo_ | ((unsigned)chunk_ << 16); nr_ = (unsigned)((cn_ - chunk_ * 256) < 256 ? (cn_ - chunk_ * 256) : 256); }
        ITEM[F.tid] = it_; NROW[F.tid] = nr_; }
    wg_sync();
#define ATTA_DECODE(k_, h_, b_, ent_) do { const unsigned it_ = ITEM[k_]; const int nrows_ = (int)NROW[k_], i_ = (int)(it_ & 0xffffu), chunk_ = (int)(it_ >> 16); h_ = i_ >> 6; b_ = i_ & 63; \
        const unsigned* lp_ = LIST + (size_t)h_ * LIST_PER_HEAD + list_off(b_) + chunk_ * 256; \
        ent_ = lp_[row < nrows_ ? row : nrows_ - 1] | (row < nrows_ ? 0u : 0x80000000u); } while (0)
    int idx = F.bx, kk = 0; if (idx >= total) return;
    int h, b, h1 = 0, b1 = 0, h2 = 0, b2 = 0; unsigned ent, ent1 = 0, ent2 = 0;
    att::KVRegs R; bf16x8 qr[4], qn[4];
    ATTA_DECODE(0, h, b, ent);
    att::kv_issue(R, Kb, Vb, b, h, F.wave, F.lane); att::q_load(qr, Qb, ent, h, hi);
    if (idx + F.G < total) ATTA_DECODE(1, h1, b1, ent1);
    for (;;) {
        lds_sync(); att::kv_commit(F.lds, R, F.wave, F.lane); lds_sync();
        const bool has1 = idx + F.G < total, has2 = idx + 2 * F.G < total && kk + 2 < 16;
        if (has1) { att::kv_issue(R, Kb, Vb, b1, h1, F.wave, F.lane); att::q_load(qn, Qb, ent1, h1, hi); }
        if (has2) ATTA_DECODE(kk + 2, h2, b2, ent2);
#ifdef PROBE_ATT2
        for (int pr_ = 0; pr_ < PROBE_ATT2; ++pr_) att::item_compute<false>(F, h, b, ent, qr, [&]() {});
#endif
        att::item_compute<false>(F, h, b, ent, qr, [&]() { if (has1) {
#pragma unroll
            for (int i = 0; i < 4; ++i) { ATT_TOUCH4(R.k[i]); ATT_TOUCH4(R.v[i]); ATT_TOUCH4(qn[i]); }
            asm volatile("" : "+v"(ent2)); } });
        if (!has1) break;
        idx += F.G; ++kk; h = h1; b = b1; ent = ent1; h1 = h2; b1 = b2; ent1 = ent2;
#pragma unroll
        for (int i = 0; i < 4; ++i) qr[i] = qn[i];
    }
#undef ATTA_DECODE
}
__device__ __forceinline__ void attb_phase(Frame& F) {
    const bf16* Qb = WSP(bf16, WS_Q); const bf16* Kb = WSP(bf16, WS_K); const bf16* Vb = WSP(bf16, WS_V);
    const int row = F.wave * 32 + (F.lane & 31), hi = F.lane >> 5, total = NHEAD * NBLK;
    int idx = F.bx; if (idx >= total) return;
    att::KVRegs R; bf16x8 qr[4], qn[4];
    att::kv_issue(R, Kb, Vb, idx >> 3, idx & 7, F.wave, F.lane); att::q_load(qr, Qb, (unsigned)((idx >> 3) * 256 + row), idx & 7, hi);
    for (;;) {
        lds_sync(); att::kv_commit(F.lds, R, F.wave, F.lane); lds_sync();
        const int nidx = idx + F.G; const bool has1 = nidx < total;
        if (has1) { att::kv_issue(R, Kb, Vb, nidx >> 3, nidx & 7, F.wave, F.lane); att::q_load(qn, Qb, (unsigned)((nidx >> 3) * 256 + row), nidx & 7, hi); }
        att::item_compute<true>(F, idx & 7, idx >> 3, (unsigned)((idx >> 3) * 256 + row), qr, [&]() { if (has1) {
#pragma unroll
            for (int i = 0; i < 4; ++i) { ATT_TOUCH4(R.k[i]); ATT_TOUCH4(R.v[i]); ATT_TOUCH4(qn[i]); } } });
        if (!has1) break;
        idx = nidx;
#pragma unroll
        for (int i = 0; i < 4; ++i) qr[i] = qn[i];
    }
}

__device__ __forceinline__ void final_phase(Frame& F) {
    const int gw = F.bx * NWAVES + F.wave, NGW = F.G * NWAVES; const float* SSQ = WSP(float, WS_SSQ); const bf16* XBp = WSP(bf16, WS_XB);
    f32x4 g[4]; const float* fnorm = inptr(IN_FINAL_NORM);
#pragma unroll
    for (int j = 0; j < 4; ++j) g[j] = ((const f32x4*)fnorm)[F.lane + 64 * j];
    for (int m0 = gw * 4; m0 < M; m0 += NGW * 4) {
        unsigned long long q[4][4]; float ri[4];
#pragma unroll
        for (int rr = 0; rr < 4; ++rr) { const int m = m0 + rr;
            const float s = ((SSQ[m] + SSQ[M + m]) + SSQ[2 * M + m]) + SSQ[3 * M + m]; ri[rr] = 1.0f / sqrtf(s * (1.0f / 1024.0f) + EPS);
#pragma unroll
            for (int j = 0; j < 4; ++j) q[rr][j] = ((const unsigned long long*)(XBp + (size_t)m * D))[F.lane + 64 * j]; }
#pragma unroll
        for (int rr = 0; rr < 4; ++rr) { f32x4* xr = (f32x4*)(F.out + (size_t)(m0 + rr) * D) + F.lane;
#pragma unroll
            for (int j = 0; j < 4; ++j) { const unsigned lo = (unsigned)q[rr][j], hi = (unsigned)(q[rr][j] >> 32);
                const f32x4 v = {__uint_as_float(lo << 16), __uint_as_float(lo & 0xffff0000u), __uint_as_float(hi << 16), __uint_as_float(hi & 0xffff0000u)};
                xr[64 * j] = v * ri[rr] * g[j]; } }
    }
}

struct Args { const float* in[22]; float* out; unsigned char* ws; int ph_lo, ph_hi; };
__global__ void __launch_bounds__(NWAVES * 64, 2) skel_fwd(Args args) {
    extern __shared__ __attribute__((aligned(16))) unsigned char lds[];
    Frame F;
    F.lds = (LAS unsigned char*)lds;
    F.MISC = (volatile LAS unsigned*)(F.lds + MISC_OFF);
    F.tid = threadIdx.x; F.lane = F.tid & 63; F.wave = __builtin_amdgcn_readfirstlane(F.tid >> 6);
    F.G = gridDim.x; F.bx = blockIdx.x;
    F.ws = args.ws; F.ctl = (gu32*)(args.ws + WS_CTL); F.out = args.out;
    for (int u = F.tid; u < (LDS_BYTES - LDSCTL_OFF) / 4; u += NWAVES * 64) ((LAS unsigned*)(F.lds + LDSCTL_OFF))[u] = 0u;
    __syncthreads();
    XcdBarrier bar; bar.bar = (unsigned*)(F.ctl + CW_BAR); bar.x = 0; bar.st = nullptr;
    if (N_LAUNCHES == 1) bar = xcd_barrier_post((unsigned*)(F.ctl + CW_BAR), F.MISC + 8);
    const int lo = args.ph_lo, hi = args.ph_hi;
    unsigned char* ws = F.ws;
#define XB ((const pg8::bf16_t*)(ws + WS_XB))
#define SSQ ((const float*)(ws + WS_SSQ))
#ifndef DBG_ONLY
#define DBG_ONLY -1
#endif
#define IN(k) (lo <= (k) && (k) < hi && (DBG_ONLY < 0 || (k) == DBG_ONLY))
#ifndef PROBE_REPS
#define REPS(k) 1
#else
    constexpr int probe_reps[NPHASE] = PROBE_REPS;
#define REPS(k) probe_reps[k]
#endif
#define REPLOOP(k) for (int rep_ = 0; rep_ < REPS(k); ++rep_, (rep_ < REPS(k) ? xcd_barrier(bar) : (void)0))
#ifdef PROBE_AMP
    unsigned long long ts_prev = __builtin_amdgcn_s_memrealtime(), ts_amp = 0;
#define STAMP(k) do { const unsigned long long now_ = __builtin_amdgcn_s_memrealtime(); if ((k) == PROBE_AMP) ts_amp = now_ - ts_prev; ts_prev = now_; } while (0)
#else
#define STAMP(k) do { } while (0)
#endif
#ifdef PROBE_BAR2
#define SEAM_BAR() do { xcd_barrier(bar); xcd_barrier(bar); } while (0)
#else
#define SEAM_BAR() xcd_barrier(bar)
#endif
#define SEAM(k) do { if (IN(k) && IN((k) + 1)) SEAM_BAR(); STAMP(k); asm volatile("" : "+v"(F.tid), "+v"(F.lane)); asm volatile("" : "+s"(F.ws), "+s"(F.out), "+s"(F.G), "+s"(F.bx), "+s"(F.wave)); ws = F.ws; } while (0)
    LAS float* TAB = (LAS float*)(F.lds + TAB_OFF);

    if (IN(PH_P0)) REPLOOP(PH_P0) { p0_phase(F); } SEAM(PH_P0);
    if (IN(PH_P1)) REPLOOP(PH_P1) { p1_phase(F); } SEAM(PH_P1);
#define FFN_PHASES(f, PH_GU, XIN, F32IN) \
    if (IN(PH_GU)) REPLOOP(PH_GU) { \
        pg8::Gemm g{XB, (const pg8::bf16_t*)(ws + WS_WGU) + (size_t)(f) * NGU * 1024, M, NGU, D}; pg8::StaticOrder S; S.init(M, NGU, F.G, vbx); \
        pg8::fill_tables(TAB, S, SSQ, (const float*)(ws + WS_BGU) + (f) * NGU); pg8::EpiGU E{(pg8::bf16_t*)(ws + WS_R1), TAB}; \
        pg8::gemm_phase<pg8::EpiGU, pg8::StaticOrder, true, true>(F.lds + RING_OFF, g, S, E); } \
    SEAM(PH_GU); \
    if (IN(PH_GU + 1)) REPLOOP(PH_GU + 1) { \
        pg8::Gemm g{(const pg8::bf16_t*)(ws + WS_R1), (const pg8::bf16_t*)(ws + WS_WDN) + (size_t)(f) * 1024 * DFF, M, D, DFF}; pg8::StaticOrder S; S.init(M, D, F.G, vbx); \
        pg8::EpiRes<F32IN> E{XIN, (pg8::bf16_t*)(ws + WS_XB), nullptr, (float*)(ws + WS_SSQ)}; \
        pg8::gemm_phase<pg8::EpiRes<F32IN>, pg8::StaticOrder, false, true>(F.lds + RING_OFF, g, S, E); } \
    SEAM(PH_GU + 1);
#define OUT_PHASE(PH, WOFF, BIAS) \
    if (IN(PH)) REPLOOP(PH) { \
        pg8::Gemm g{(const pg8::bf16_t*)(ws + WS_MIX), (const pg8::bf16_t*)(ws + WOFF), M, D, D}; pg8::StaticOrder S; S.init(M, D, F.G, vbx); \
        pg8::EpiRes<false> E{nullptr, (pg8::bf16_t*)(ws + WS_XB), BIAS, (float*)(ws + WS_SSQ)}; \
        pg8::gemm_phase<pg8::EpiRes<false>, pg8::StaticOrder, false, true>(F.lds + RING_OFF, g, S, E); } \
    SEAM(PH);

    int vbx = F.bx;
    if (N_LAUNCHES == 1 && lo == 0 && F.G == 256) { bool ok = true;
        for (int j = 0; j < 16; ++j) { const unsigned cn = xb_ld(&bar.bar[XB_XCNT(j)]); ok = ok && (cn == (j < 8 ? 32u : 0u)); }
        if (ok) vbx = (int)F.MISC[10] * 8 + (int)bar.x; }
    vbx = __builtin_amdgcn_readfirstlane(vbx);
    FFN_PHASES(0, PH_L0_GU1, inptr(IN_X), true)
    if (IN(PH_L0_CIN)) REPLOOP(PH_L0_CIN) {
        pg8::Gemm g{XB, (const pg8::bf16_t*)(ws + WS_WCIN), M, NCIN, D}; pg8::StaticOrder S; S.init(M, NCIN, F.G, vbx);
        pg8::fill_tables(TAB, S, SSQ, (const float*)(ws + WS_BCIN)); pg8::EpiCin E{(pg8::bf16_t*)(ws + WS_R1), TAB};
        pg8::gemm_phase<pg8::EpiCin, pg8::StaticOrder, true, true>(F.lds + RING_OFF, g, S, E); }
    SEAM(PH_L0_CIN);
    if (IN(PH_L0_CONV)) REPLOOP(PH_L0_CONV) conv_phase(F);
    SEAM(PH_L0_CONV);
    OUT_PHASE(PH_L0_COUT, WS_WCOUT, nullptr)
    FFN_PHASES(1, PH_L0_GU2, nullptr, false)
    FFN_PHASES(2, PH_L1_GU1, nullptr, false)
    if (IN(PH_L1_PIN)) REPLOOP(PH_L1_PIN) {
        pg8::Gemm g{XB, (const pg8::bf16_t*)(ws + WS_WPIN), M, NPIN, D}; pg8::StaticOrder S; S.init(M, NPIN, F.G, vbx);
        pg8::fill_tables(TAB, S, SSQ, (const float*)(ws + WS_BPIN)); pg8::EpiPin E{(pg8::bf16_t*)(ws + WS_Q), TAB, (float*)(ws + WS_KMP)};
        pg8::gemm_phase<pg8::EpiPin, pg8::StaticOrder, true, true>(F.lds + RING_OFF, g, S, E); }
    SEAM(PH_L1_PIN);
    if (IN(PH_L1_SEL)) REPLOOP(PH_L1_SEL) sel_phase(F);
    SEAM(PH_L1_SEL);
    if (IN(PH_L1_ATTA)) REPLOOP(PH_L1_ATTA) atta_phase(F);
    SEAM(PH_L1_ATTA);
    if (IN(PH_L1_ATTB)) REPLOOP(PH_L1_ATTB) attb_phase(F);
    SEAM(PH_L1_ATTB);
    OUT_PHASE(PH_L1_POUT, WS_WPOUT, (const float*)(ws + WS_BPOUT))
    FFN_PHASES(3, PH_L1_GU2, nullptr, false)
    if (IN(PH_FINAL)) REPLOOP(PH_FINAL) final_phase(F);
#ifdef PROBE_AMP
    STAMP(PH_FINAL);
    if (F.bx == 0) { const unsigned long long t0_ = __builtin_amdgcn_s_memrealtime(); while (__builtin_amdgcn_s_memrealtime() - t0_ < 8ull * ts_amp) __builtin_amdgcn_s_sleep(8); }
#endif
#undef IN
#undef SEAM
}

extern "C" void kernel_launch(void* const* d_in, const int* in_sizes, int n_in, void* d_out, int out_size, void* d_ws, size_t ws_size, hipStream_t stream) {
    static int grid = 0;
    if (grid == 0) {
        if (n_in != 22 || in_sizes[0] != M * D || out_size != M * D || ws_size < WS_END) { fprintf(stderr, "kernel_launch: unexpected shapes/workspace (n_in %d, ws %zu < %zu); nothing launched\n", n_in, ws_size, (size_t)WS_END); grid = -1; return; }
        int dev = 0, cus = 0;
        if (hipGetDevice(&dev) != hipSuccess || hipDeviceGetAttribute(&cus, hipDeviceAttributeMultiprocessorCount, dev) != hipSuccess) { grid = -1; return; }
        if (hipFuncSetAttribute((const void*)skel_fwd, hipFuncAttributeMaxDynamicSharedMemorySize, LDS_BYTES) != hipSuccess) { fprintf(stderr, "kernel_launch: hipFuncSetAttribute failed\n"); grid = -1; return; }
        (void)hipGetLastError();
        grid = cus;
        if (grid != 256) fprintf(stderr, "kernel_launch: %d CUs; this kernel is laid out for 256\n", grid);
    }
    if (grid < 0) return;
    if (hipMemsetAsync((char*)d_ws + WS_CTL, 0, CTL_ZERO_BYTES, stream) != hipSuccess) return;
    Args a{};
    for (int i = 0; i < 22; ++i) a.in[i] = (const float*)d_in[i];
    a.out = (float*)d_out; a.ws = (unsigned char*)d_ws;
    for (int li = 0; li < N_LAUNCHES; ++li) {
        a.ph_lo = (N_LAUNCHES == 1) ? 0 : li; a.ph_hi = (N_LAUNCHES == 1) ? (int)NPHASE : li + 1;
        hipLaunchKernelGGL(skel_fwd, dim3(grid), dim3(NWAVES * 64), LDS_BYTES, stream, a);
        if (hipPeekAtLastError() != hipSuccess) { fprintf(stderr, "kernel_launch: launch %d failed\n", li); break; }
    }
}
```

```cpp
#include <hip/hip_runtime.h>
#include <hip/hip_bf16.h>
#include <cstdio>
#include <cstdint>
#include <cmath>

#ifndef MK_N_LAUNCHES
#define MK_N_LAUNCHES 1
#endif

constexpr int M = 16384, D = 1024, DFF = 2816, NGU = 2 * DFF, NCIN = 2560, NPIN = 2048;
constexpr int NHEAD = 8, HD = 64, MBLK = 256, NBLK = M / MBLK;
constexpr float EPS = 1e-6f;
constexpr float LOG2E = 1.4426950408889634f;
constexpr float QSCALE = 0.125f * LOG2E;

namespace pg8 {
#define PG8_LAS __attribute__((address_space(3)))
typedef unsigned short bf16_t;
typedef short bf16x8 __attribute__((ext_vector_type(8)));
typedef float f32x4 __attribute__((ext_vector_type(4)));
typedef unsigned u32x4 __attribute__((ext_vector_type(4)));
constexpr int BM = 256, BK = 64, HALF = 128, HTB = HALF * BK * 2  , STAGE_BYTES = 8 * HTB, NXCD = 8, WGM = 8;

__host__ __device__ __forceinline__ int lds_byte(int r, int c) { const int st = (r >> 4) * 2 + (c >> 5), rr = r & 15, cc = c & 31, ob = rr * 64 + cc * 2; return st * 1024 + (ob ^ (((ob >> 9) & 1) << 5)); }
__host__ __device__ __forceinline__ void stage_rc(int b, int& R, int& C) { const int st = b / 1024, sb = b % 1024, swz = sb ^ (((sb >> 9) & 1) << 5); R = (st >> 1) * 16 + swz / 64; C = (st & 1) * 32 + (swz % 64) / 2; }
__host__ __device__ __forceinline__ int perm32(int rho) { const int n = rho >> 4, i = rho & 15; return 8 * (i >> 2) + 4 * n + (i & 3); }

struct Unit { int pm, pn, idx, half; };
struct Gemm { const bf16_t* A; const bf16_t* Bt; int M, N, K; };

struct StaticOrder {
    int nM, nN, nwg, G, c;
    __host__ __device__ void init(int M, int N, int G_, int c_) { nM = M / BM; nN = N / BM; nwg = nM * nN; G = G_; c = c_; }
    __host__ __device__ bool next(int i, Unit& u) const {
        const int nfull = nwg / G, rem = nwg - nfull * G;
        long L; u.half = 0;
        if (rem * 2 == G && G == 256 && i == nfull) { L = (long)nfull * G + (((c >> 4) << 3) | (c & 7)); u.half = 1 + ((c >> 3) & 1); }
        else { L = (long)i * G + c; if (L >= nwg || (rem * 2 == G && G == 256 && i > nfull)) return false; }
        int wgid = (int)L; { const int q = nwg / NXCD, r = nwg % NXCD, xcd = wgid % NXCD, off = wgid / NXCD; wgid = (xcd < r ? xcd * (q + 1) : r * (q + 1) + (xcd - r) * q) + off; }
        const int nig = WGM * nN, gid = wgid / nig, fm = gid * WGM, gsz = (nM - fm) < WGM ? (nM - fm) : WGM;
        u.pm = fm + ((wgid % nig) % gsz); u.pn = (wgid % nig) / gsz; u.idx = i; return true;
    }
    __device__ __forceinline__ void a_ready(const Unit&) const {}
    __device__ __forceinline__ void done(const Unit&) const {}
};

__device__ __forceinline__ unsigned cvt_pk_bf16(float lo, float hi) { unsigned r; asm volatile("v_cvt_pk_bf16_f32 %0, %1, %2" : "=v"(r) : "v"(lo), "v"(hi)); return r; }

typedef unsigned u32x2 __attribute__((ext_vector_type(2)));
constexpr int TAB_UNITS = 6;
__device__ __forceinline__ void tab_rinv(const PG8_LAS float* tab, const Unit& u, int wr, int fr, float (&rinv)[2][4]) {
#pragma unroll
    for (int ai = 0; ai < 2; ++ai)
#pragma unroll
        for (int m = 0; m < 4; ++m) rinv[ai][m] = tab[u.idx * 256 + ai * HALF + wr * 64 + m * 16 + fr];
}
__device__ __forceinline__ void tab_bias(const PG8_LAS float* tab, const Unit& u, int wc, int fq, f32x4 (&bv)[2][2]) {
#pragma unroll
    for (int bj = 0; bj < 2; ++bj)
#pragma unroll
        for (int n = 0; n < 2; ++n) bv[bj][n] = *(const PG8_LAS f32x4*)(tab + (TAB_UNITS + u.idx) * 256 + bj * HALF + wc * 32 + 8 * fq + 4 * n);
}
template <class Sched> __device__ __forceinline__ void fill_tables(PG8_LAS float* tab, const Sched& S, const float* ssq, const float* bias) {
    int tid = threadIdx.x; asm volatile("" : "+v"(tid));
    Unit u;
    for (int i = 0; i < TAB_UNITS && S.next(i, u); ++i) {
        if (tid < 256) { const int r = u.pm * BM + (u.half == 2 ? HALF : 0) + tid; const float s = ((ssq[r] + ssq[M + r]) + ssq[2 * M + r]) + ssq[3 * M + r]; tab[i * 256 + tid] = 1.0f / sqrtf(s * (1.0f / 1024.0f) + EPS); }
        else tab[(TAB_UNITS + i) * 256 + (tid - 256)] = bias[u.pn * BM + (tid - 256)];
    }
    __syncthreads();
}
__device__ __forceinline__ float sigm(float z) { return __builtin_amdgcn_rcpf(1.0f + __builtin_amdgcn_exp2f(-LOG2E * z)); }
__device__ __forceinline__ u32x4 pack8(const f32x4 a, const f32x4 b) { u32x4 w; w.x = cvt_pk_bf16(a[0], a[1]); w.y = cvt_pk_bf16(a[2], a[3]); w.z = cvt_pk_bf16(b[0], b[1]); w.w = cvt_pk_bf16(b[2], b[3]); return w; }

typedef __amdgpu_buffer_rsrc_t rsrc_t;
__device__ __forceinline__ rsrc_t mk_rsrc(const void* base, size_t bytes) { return __builtin_amdgcn_make_buffer_rsrc((void*)base, 0, (int)bytes, 0x00020000); }
__device__ __forceinline__ void st16_wt(rsrc_t r, const void* base, const void* p, u32x4 v) { __builtin_amdgcn_raw_buffer_store_b128(v, r, (unsigned)((const char*)p - (const char*)base), 0, 16); }
__device__ __forceinline__ void st8_wt(rsrc_t r, const void* base, const void* p, u32x2 v) { __builtin_amdgcn_raw_buffer_store_b64(v, r, (unsigned)((const char*)p - (const char*)base), 0, 16); }

struct EpiGU {
    static constexpr bool PERM = true, AFTER_DRAIN = false, INIT_ACC = false;
    bf16_t* O; const PG8_LAS float* tab;
    __device__ __forceinline__ void operator()(const f32x4 (&acc)[2][2][4][2], const Unit& u, int wr, int wc, int fr, int fq) const {
        asm volatile("" : "+v"(fr), "+v"(fq));
        const int row0 = u.pm * BM + (u.half == 2 ? HALF : 0) + wr * 64 + fr, ocol0 = u.pn * HALF + wc * 32 + 8 * fq, nai = u.half ? 1 : 2;
        f32x4 bv[2][2]; tab_bias(tab, u, wc, fq, bv);
        float rinv[2][4]; tab_rinv(tab, u, wr, fr, rinv);
        const rsrc_t rsrc = mk_rsrc(O, (size_t)M * DFF * 2);
#pragma unroll
        for (int ai = 0; ai < 2; ++ai) if (ai < nai)
#pragma unroll
            for (int m = 0; m < 4; ++m) { const float ri = rinv[ai][m]; bf16_t* rowp = O + (size_t)(row0 + ai * HALF + m * 16) * DFF + ocol0;
                f32x4 hv[2];
#pragma unroll
                for (int n = 0; n < 2; ++n) { const f32x4 g = acc[ai][0][m][n] * ri + bv[0][n], up = acc[ai][1][m][n] * ri + bv[1][n];
#pragma unroll
                    for (int e = 0; e < 4; ++e) hv[n][e] = g[e] * up[e] * sigm(g[e]); }
                st16_wt(rsrc, O, rowp, pack8(hv[0], hv[1]));
                if (m & 1) asm volatile("" ::: "memory"); }
    }
};
struct EpiCin {
    static constexpr bool PERM = true, AFTER_DRAIN = false, INIT_ACC = false;
    bf16_t* O; const PG8_LAS float* tab;
    template <int KIND> __device__ __forceinline__ void run(const f32x4 (&acc)[2][2][4][2], const f32x4 (&bv)[2][2], const float (&rinv)[2][4], bf16_t* base, int nai) const {
        const rsrc_t rsrc = mk_rsrc(O, (size_t)M * 1536 * 2);
#pragma unroll
        for (int ai = 0; ai < 2; ++ai) if (ai < nai)
#pragma unroll
            for (int m = 0; m < 4; ++m) { const float ri = rinv[ai][m]; bf16_t* rowp = base + (size_t)(ai * HALF + m * 16) * 1536;
                f32x4 z0[2], z1[2];
#pragma unroll
                for (int n = 0; n < 2; ++n) { z0[n] = acc[ai][0][m][n] * ri + bv[0][n]; z1[n] = acc[ai][1][m][n] * ri + bv[1][n]; }
                if (KIND == 2) { st16_wt(rsrc, O, rowp, pack8(z0[0], z0[1])); st16_wt(rsrc, O, rowp + HALF, pack8(z1[0], z1[1])); }
                else { f32x4 o[2];
#pragma unroll
                    for (int n = 0; n < 2; ++n)
#pragma unroll
                        for (int e = 0; e < 4; ++e) o[n][e] = KIND == 0 ? z0[n][e] * sigm(z1[n][e]) : z0[n][e] * z1[n][e];
                    st16_wt(rsrc, O, rowp, pack8(o[0], o[1])); }
                asm volatile("" ::: "memory"); }
    }
    __device__ __forceinline__ void operator()(const f32x4 (&acc)[2][2][4][2], const Unit& u, int wr, int wc, int fr, int fq) const {
        asm volatile("" : "+v"(fr), "+v"(fq));
        const int row0 = u.pm * BM + (u.half == 2 ? HALF : 0) + wr * 64 + fr;
        f32x4 bv[2][2]; tab_bias(tab, u, wc, fq, bv);
        float rinv[2][4]; tab_rinv(tab, u, wr, fr, rinv);
        const int ocol0 = (u.pn >= 8 ? 1024 + 256 * (u.pn - 8) : 128 * u.pn) + wc * 32 + 8 * fq;
        bf16_t* base = O + (size_t)row0 * 1536 + ocol0;
        const int nai = u.half ? 1 : 2;
        if (u.pn < 4) run<0>(acc, bv, rinv, base, nai); else if (u.pn < 8) run<1>(acc, bv, rinv, base, nai); else run<2>(acc, bv, rinv, base, nai);
    }
};
struct EpiPin {
    static constexpr bool PERM = true, AFTER_DRAIN = false, INIT_ACC = false;
    bf16_t* O; const PG8_LAS float* tab; float* kmp;
    __device__ __forceinline__ void operator()(const f32x4 (&acc)[2][2][4][2], const Unit& u, int wr, int wc, int fr, int fq) const {
        asm volatile("" : "+v"(fr), "+v"(fq));
        const int row0 = u.pm * BM + wr * 64 + fr;
        f32x4 bv[2][2]; tab_bias(tab, u, wc, fq, bv);
        float rinv[2][4]; tab_rinv(tab, u, wr, fr, rinv);
        const int t = u.pn >> 1; const int slot = t == 0 ? 3 : t - 1;
        const float sc = t == 1 ? QSCALE : 1.0f;
        bf16_t* base = O + (size_t)slot * ((size_t)M * 512) + (size_t)row0 * 512 + 256 * (u.pn & 1) + wc * 32 + 8 * fq;
        const rsrc_t rsrc = mk_rsrc(O, (size_t)4 * M * 512 * 2);
#pragma unroll
        for (int ai = 0; ai < 2; ++ai)
#pragma unroll
            for (int m = 0; m < 4; ++m) { const float ri = rinv[ai][m] * sc; bf16_t* rowp = base + (size_t)(ai * HALF + m * 16) * 512;
#pragma unroll
                for (int bj = 0; bj < 2; ++bj) { const f32x4 z0 = acc[ai][bj][m][0] * ri + bv[bj][0] * sc, z1 = acc[ai][bj][m][1] * ri + bv[bj][1] * sc;
                    st16_wt(rsrc, O, rowp + bj * HALF, pack8(z0, z1)); }
                asm volatile("" ::: "memory"); }
        if (t == 2) {
            f32x4 cs[2][2];
#pragma unroll
            for (int bj = 0; bj < 2; ++bj)
#pragma unroll
                for (int n = 0; n < 2; ++n) { f32x4 a = {0.f, 0.f, 0.f, 0.f};
#pragma unroll
                    for (int ai = 0; ai < 2; ++ai)
#pragma unroll
                        for (int m = 0; m < 4; ++m) a += acc[ai][bj][m][n] * rinv[ai][m];
                    a += bv[bj][n] * 8.0f;
#pragma unroll
                    for (int e = 0; e < 4; ++e) { float v = a[e]; v += __shfl_xor(v, 1); v += __shfl_xor(v, 2); v += __shfl_xor(v, 4); v += __shfl_xor(v, 8); a[e] = v; }
                    cs[bj][n] = a; }
            if (fr == 0) { float* kp = kmp + ((size_t)wr * 64 + u.pm) * 512 + 256 * (u.pn & 1) + wc * 32 + 8 * fq;
#pragma unroll
                for (int bj = 0; bj < 2; ++bj)
#pragma unroll
                    for (int n = 0; n < 2; ++n) *(f32x4*)(kp + bj * HALF + 4 * n) = cs[bj][n]; }
        }
    }
};
template <bool F32IN> struct EpiRes {
    static constexpr bool PERM = false, AFTER_DRAIN = true, INIT_ACC = true;
    const float* xin; bf16_t* xb; const float* bias; float* ssq;
    __device__ __forceinline__ void init(f32x4 (&acc)[2][2][4][2], const Unit& u, int wr, int wc, int fr, int fq) const {
        const int col0 = u.pn * BM + wc * 32 + 4 * fq;
#pragma unroll
        for (int ai = 0; ai < 2; ++ai)
#pragma unroll
            for (int m = 0; m < 4; ++m) { const size_t off = (size_t)(u.pm * BM + ai * HALF + wr * 64 + m * 16 + fr) * D + col0;
#pragma unroll
                for (int bj = 0; bj < 2; ++bj)
#pragma unroll
                    for (int n = 0; n < 2; ++n) {
                        if (F32IN) acc[ai][bj][m][n] = *(const f32x4*)(xin + off + bj * HALF + n * 16);
                        else { const u32x2 q = *(const u32x2*)(xb + off + bj * HALF + n * 16);
                            acc[ai][bj][m][n] = (f32x4){__uint_as_float(q.x << 16), __uint_as_float(q.x & 0xffff0000u), __uint_as_float(q.y << 16), __uint_as_float(q.y & 0xffff0000u)}; } } }
        if (bias) {
#pragma unroll
            for (int bj = 0; bj < 2; ++bj)
#pragma unroll
                for (int n = 0; n < 2; ++n) { const f32x4 bv = *(const f32x4*)(bias + col0 + bj * HALF + n * 16);
#pragma unroll
                    for (int ai = 0; ai < 2; ++ai)
#pragma unroll
                        for (int m = 0; m < 4; ++m) acc[ai][bj][m][n] += bv; }
        }
    }
    __device__ __forceinline__ void fused(f32x4 (&acc)[2][2][4][2], const Unit& u, int wr, int wc, int fr, int fq, PG8_LAS unsigned char* lds, int wid, int lane) const {
        PG8_LAS float* P = (PG8_LAS float*)lds;
        asm volatile("" : "+v"(fr), "+v"(fq));
        const int col0 = u.pn * BM + wc * 32 + 4 * fq; const rsrc_t rsrc = mk_rsrc(xb, (size_t)M * D * 2);
#pragma unroll
        for (int ai = 0; ai < 2; ++ai)
#pragma unroll
            for (int m = 0; m < 4; ++m) { const int rt = ai * HALF + wr * 64 + m * 16 + fr; const size_t off = (size_t)(u.pm * BM + rt) * D + col0; float ss = 0.f;
#pragma unroll
                for (int bj = 0; bj < 2; ++bj)
#pragma unroll
                    for (int n = 0; n < 2; ++n) { const int c = bj * HALF + n * 16; const f32x4 v = acc[ai][bj][m][n];
                        ss += (v[0] * v[0] + v[1] * v[1]) + (v[2] * v[2] + v[3] * v[3]);
                        u32x2 w; w.x = cvt_pk_bf16(v[0], v[1]); w.y = cvt_pk_bf16(v[2], v[3]); st8_wt(rsrc, xb, xb + off + c, w); }
                ss += __shfl_xor(ss, 16); ss += __shfl_xor(ss, 32);
                if (fq == 0) P[rt * 4 + wc] = ss; }
        asm volatile("s_waitcnt lgkmcnt(0)" ::: "memory"); __builtin_amdgcn_s_barrier(); asm volatile("" ::: "memory");
        const int tid = wid * 64 + lane;
        if (tid < 256) { const float s = ((P[tid * 4 + 0] + P[tid * 4 + 1]) + P[tid * 4 + 2]) + P[tid * 4 + 3]; ssq[(size_t)u.pn * M + u.pm * BM + tid] = s; }
        asm volatile("s_waitcnt lgkmcnt(0)" ::: "memory"); __builtin_amdgcn_s_barrier(); asm volatile("" ::: "memory");
    }
};

template <class Epi, class Sched, bool ALIGN_EPI = false, bool SP2 = false>
__device__ __forceinline__ void gemm_phase(PG8_LAS unsigned char* lds, const Gemm g, const Sched& S, const Epi& E) {
    int tid = threadIdx.x; asm volatile("" : "+v"(tid));
    const int wid = __builtin_amdgcn_readfirstlane(tid >> 6), lane = tid & 63, wr = wid >> 2, wc = wid & 3, fr = lane & 15, fq = lane >> 4;
    const int K = g.K, nt = K / BK;
    unsigned voffA[2], voffB[2];
#pragma unroll
    for (int i = 0; i < 2; ++i) { int R, C; stage_rc(tid * 16 + i * 8192, R, C); const int Rb = Epi::PERM ? ((R & ~31) + perm32(R & 31)) : R;
        voffA[i] = (unsigned)(R * K + C) * 2u; voffB[i] = (unsigned)(Rb * K + C) * 2u; }
    const size_t kstep = (size_t)(BK * 2);
    const size_t hstep = (size_t)HALF * K * 2;
    const size_t tstep = 2 * hstep;
    const unsigned ldsw = (unsigned)wid * 1024u;
    const int aoff = lds_byte(wr * 64 + fr, fq * 8), boff = lds_byte(wc * 32 + fr, fq * 8);
#define PG8_SA(b, h) (((b) * 2 + (h)) * HTB)
#define PG8_SB(b, h) ((4 + (b) * 2 + (h)) * HTB)
#define PG8_STAGE(bufoff, gbase, voff) do { _Pragma("unroll") for (int _i = 0; _i < 2; ++_i) \
        __builtin_amdgcn_global_load_lds((const unsigned*)((const char*)(gbase) + (voff)[_i]), (PG8_LAS unsigned*)(lds + (bufoff) + ldsw + _i * 8192), 16, 0, 0); } while (0)
#define PG8_LDA(dst, b, h) do { _Pragma("unroll") for (int m = 0; m < 4; ++m) _Pragma("unroll") for (int k = 0; k < 2; ++k) dst[m][k] = *(const PG8_LAS bf16x8*)(lds + PG8_SA(b, h) + aoff + m * 2048 + k * 1024); } while (0)
#define PG8_LDB(dst, b, h) do { _Pragma("unroll") for (int n = 0; n < 2; ++n) _Pragma("unroll") for (int k = 0; k < 2; ++k) dst[n][k] = *(const PG8_LAS bf16x8*)(lds + PG8_SB(b, h) + boff + n * 2048 + k * 1024); } while (0)
#define PG8_MMA(ai, bj, At, Bt) do { __builtin_amdgcn_s_setprio(1); _Pragma("unroll") for (int m = 0; m < 4; ++m) _Pragma("unroll") for (int n = 0; n < 2; ++n) _Pragma("unroll") for (int k = 0; k < 2; ++k) \
        acc[ai][bj][m][n] = __builtin_amdgcn_mfma_f32_16x16x32_bf16(Bt[n][k], At[m][k], acc[ai][bj][m][n], 0, 0, 0); __builtin_amdgcn_s_setprio(0); } while (0)
#define PG8_WAIT_V(n) asm volatile("s_waitcnt vmcnt(" #n ")" ::: "memory")
#define PG8_WAIT_L(n) asm volatile("s_waitcnt lgkmcnt(" #n ")" ::: "memory")
#define PG8_BAR __builtin_amdgcn_s_barrier()
#define PG8_SCHED __builtin_amdgcn_sched_barrier(0)
    Unit cur, nxt; int ui = 0;
    if (!S.next(0, cur)) return;
    f32x4 acc[2][2][4][2];
    if constexpr (Epi::INIT_ACC) { E.init(acc, cur, wr, wc, fr, fq); }
    else {
#pragma unroll
    for (int a = 0; a < 2; ++a)
#pragma unroll
        for (int b = 0; b < 2; ++b)
#pragma unroll
            for (int m = 0; m < 4; ++m)
#pragma unroll
                for (int n = 0; n < 2; ++n) acc[a][b][m][n] = (f32x4){0.f, 0.f, 0.f, 0.f};
    }
    bf16x8 At[4][2], B0[2][2], B1[2][2];
    const char* cA = (const char*)g.A + (size_t)cur.pm * tstep + (cur.half == 2 ? hstep : 0); const char* cB = (const char*)g.Bt + (size_t)cur.pn * tstep;
    S.a_ready(cur);
    if constexpr (SP2) {
        PG8_STAGE(PG8_SB(0, 0), cB, voffB); PG8_STAGE(PG8_SB(0, 1), cB + hstep, voffB); PG8_STAGE(PG8_SA(0, 0), cA, voffA); PG8_STAGE(PG8_SA(0, 1), cA + hstep, voffA);
        if (wr == 1) PG8_BAR;
        PG8_WAIT_V(2); PG8_BAR;
        PG8_STAGE(PG8_SB(1, 0), cB + kstep, voffB); PG8_STAGE(PG8_SA(1, 0), cA + kstep, voffA); PG8_STAGE(PG8_SB(1, 1), cB + hstep + kstep, voffB);
        PG8_WAIT_V(6); PG8_BAR;
    } else {
        PG8_STAGE(PG8_SB(0, 0), cB, voffB); PG8_STAGE(PG8_SA(0, 0), cA, voffA); PG8_STAGE(PG8_SB(0, 1), cB + hstep, voffB); PG8_STAGE(PG8_SA(0, 1), cA + hstep, voffA);
        if (wr == 1) PG8_BAR;
        PG8_WAIT_V(4); PG8_BAR;
        PG8_STAGE(PG8_SB(1, 0), cB + kstep, voffB); PG8_STAGE(PG8_SA(1, 0), cA + kstep, voffA); PG8_STAGE(PG8_SB(1, 1), cB + hstep + kstep, voffB);
        PG8_WAIT_V(6); PG8_BAR;
    }
    for (;;) {
        const bool has_next = S.next(ui + 1, nxt);
        const bool full = cur.half == 0;
        const char* nA = has_next ? (const char*)g.A + (size_t)nxt.pm * tstep + (nxt.half == 2 ? hstep : 0) : cA; const char* nB = has_next ? (const char*)g.Bt + (size_t)nxt.pn * tstep : cB;
#if defined(PROBE_KREP)
        const int ntr = Epi::INIT_ACC ? nt : nt * PROBE_KREP;
        for (int tq = 0; tq < ntr; tq += 2) {
            const int t = tq % nt;
            const bool last = (tq == ntr - 2);
            const char* a1 = cA + (size_t)(t + 1) * kstep;
            const char* a2 = last ? nA : cA + (size_t)((t + 2) % nt) * kstep; const char* b2 = last ? nB : cB + (size_t)((t + 2) % nt) * kstep;
#else
        for (int t = 0; t < nt; t += 2) {
            const bool last = (t == nt - 2);
            const char* a1 = cA + (size_t)(t + 1) * kstep;
            const char* a2 = last ? nA : cA + (size_t)(t + 2) * kstep; const char* b2 = last ? nB : cB + (size_t)(t + 2) * kstep;
#endif
            const char* a3 = a2 + kstep; const char* b3 = b2 + kstep;
            if (last && has_next) S.a_ready(nxt);
            if constexpr (SP2) {
            PG8_LDB(B0, 0, 0); PG8_LDB(B1, 0, 1); PG8_SCHED; PG8_LDA(At, 0, 0); PG8_STAGE(PG8_SA(1, 1), a1 + hstep, voffA);
            PG8_WAIT_V(8); PG8_WAIT_L(0); PG8_BAR; PG8_MMA(0, 0, At, B0); PG8_MMA(0, 1, At, B1); PG8_BAR; PG8_SCHED;
            if (full) PG8_LDA(At, 0, 1); PG8_STAGE(PG8_SB(0, 0), b2, voffB); PG8_STAGE(PG8_SB(0, 1), b2 + hstep, voffB); PG8_STAGE(PG8_SA(0, 0), a2, voffA);
            PG8_WAIT_V(8); PG8_WAIT_L(0); PG8_BAR; if (full) { PG8_MMA(1, 0, At, B0); PG8_MMA(1, 1, At, B1); } PG8_BAR; PG8_SCHED;
            PG8_LDB(B0, 1, 0); PG8_LDB(B1, 1, 1); PG8_SCHED; PG8_LDA(At, 1, 0); PG8_STAGE(PG8_SA(0, 1), a2 + hstep, voffA);
            PG8_WAIT_V(8); PG8_WAIT_L(0); PG8_BAR; PG8_MMA(0, 0, At, B0); PG8_MMA(0, 1, At, B1); PG8_BAR; PG8_SCHED;
            if (full) PG8_LDA(At, 1, 1); PG8_STAGE(PG8_SB(1, 0), b3, voffB); PG8_STAGE(PG8_SB(1, 1), b3 + hstep, voffB); PG8_STAGE(PG8_SA(1, 0), a3, voffA);
            PG8_WAIT_V(8); PG8_WAIT_L(0); PG8_BAR; if (full) { PG8_MMA(1, 0, At, B0); PG8_MMA(1, 1, At, B1); } PG8_BAR; PG8_SCHED;
            } else {
            PG8_LDB(B0, 0, 0); PG8_SCHED; PG8_LDA(At, 0, 0); PG8_STAGE(PG8_SA(1, 1), a1 + hstep, voffA);
            PG8_WAIT_L(8); PG8_BAR; PG8_WAIT_L(0); PG8_MMA(0, 0, At, B0); PG8_BAR; PG8_SCHED;
            PG8_LDB(B1, 0, 1); PG8_STAGE(PG8_SB(0, 0), b2, voffB);
            PG8_BAR; PG8_WAIT_L(0); PG8_MMA(0, 1, At, B1); PG8_BAR;
            PG8_LDA(At, 0, 1); PG8_STAGE(PG8_SA(0, 0), a2, voffA);
            PG8_BAR; PG8_WAIT_L(0); PG8_MMA(1, 0, At, B0); PG8_BAR; PG8_SCHED;
            PG8_STAGE(PG8_SB(0, 1), b2 + hstep, voffB);
            PG8_WAIT_V(6); PG8_BAR; PG8_MMA(1, 1, At, B1); PG8_BAR;
            PG8_LDB(B0, 1, 0); PG8_SCHED; PG8_LDA(At, 1, 0); PG8_STAGE(PG8_SA(0, 1), a2 + hstep, voffA);
            PG8_WAIT_L(8); PG8_BAR; PG8_WAIT_L(0); PG8_MMA(0, 0, At, B0); PG8_BAR; PG8_SCHED;
            PG8_LDB(B1, 1, 1); PG8_STAGE(PG8_SB(1, 0), b3, voffB);
            PG8_BAR; PG8_WAIT_L(0); PG8_MMA(0, 1, At, B1); PG8_BAR;
            PG8_LDA(At, 1, 1); PG8_STAGE(PG8_SA(1, 0), a3, voffA);
            PG8_BAR; PG8_WAIT_L(0); PG8_MMA(1, 0, At, B0); PG8_BAR; PG8_SCHED;
            PG8_STAGE(PG8_SB(1, 1), b3 + hstep, voffB);
            PG8_WAIT_V(6); PG8_BAR; PG8_MMA(1, 1, At, B1); PG8_BAR;
            }
        }
        if constexpr (ALIGN_EPI) { if (wr == 0) PG8_BAR; }
#if defined(PROBE_KREP)
        if constexpr (!Epi::INIT_ACC) {
#pragma unroll
            for (int a = 0; a < 2; ++a)
#pragma unroll
                for (int b = 0; b < 2; ++b)
#pragma unroll
                    for (int m = 0; m < 4; ++m)
#pragma unroll
                        for (int n = 0; n < 2; ++n) acc[a][b][m][n] = acc[a][b][m][n] * (1.0f / PROBE_KREP); }
#endif
        if constexpr (!Epi::AFTER_DRAIN) { E(acc, cur, wr, wc, fr, fq); S.done(cur);
#ifdef PROBE_EPI2
            for (int pe_ = 0; pe_ < PROBE_EPI2; ++pe_) { asm volatile("" ::: "memory"); E(acc, cur, wr, wc, fr, fq); }
#endif
        }
        if (!has_next) break;
#pragma unroll
        for (int a = 0; a < 2; ++a)
#pragma unroll
            for (int b = 0; b < 2; ++b)
#pragma unroll
                for (int m = 0; m < 4; ++m)
#pragma unroll
                    for (int n = 0; n < 2; ++n) acc[a][b][m][n] = (f32x4){0.f, 0.f, 0.f, 0.f};
        cur = nxt; cA = nA; cB = nB; ++ui;
        if constexpr (ALIGN_EPI) { if (wr == 1) PG8_BAR; }
    }
    PG8_WAIT_V(0);
    if constexpr (!ALIGN_EPI) { if (wr == 0) PG8_BAR; }
    PG8_BAR;
    if constexpr (Epi::AFTER_DRAIN) { E.fused(acc, cur, wr, wc, fr, fq, lds, wid, lane); S.done(cur); }
#undef PG8_SA
#undef PG8_SB
#undef PG8_STAGE
#undef PG8_LDA
#undef PG8_LDB
#undef PG8_MMA
#undef PG8_WAIT_V
#undef PG8_WAIT_L
#undef PG8_BAR
#undef PG8_SCHED
}
}
#define GAS __attribute__((address_space(1)))
#define LAS __attribute__((address_space(3)))
typedef unsigned short bf16;
typedef unsigned v4u __attribute__((ext_vector_type(4)));
typedef float f32x4 __attribute__((ext_vector_type(4)));
typedef short bf16x8 __attribute__((ext_vector_type(8)));
typedef GAS unsigned gu32;
typedef GAS unsigned long long gu64;
#define RLX_AGENT __ATOMIC_RELAXED, __HIP_MEMORY_SCOPE_AGENT
#define LDS_WAIT() asm volatile("s_waitcnt lgkmcnt(0)" ::: "memory")
#define VM_WAIT() asm volatile("s_waitcnt vmcnt(0)" ::: "memory")
__device__ __forceinline__ unsigned long long rt() { return __builtin_amdgcn_s_memrealtime(); }
__device__ __forceinline__ unsigned f2bf(float f) { unsigned u = __builtin_bit_cast(unsigned, f); return (u + 0x7fffu + ((u >> 16) & 1u)) >> 16; }
__device__ __forceinline__ unsigned pk2(float lo, float hi) { return f2bf(lo) | (f2bf(hi) << 16); }

#define XB_TMO      128
#define XB_XCNT(j)  (256  + 64 * (j))
#define XB_XSUB(j)  (1280 + 64 * (j))
#define XB_XGEN(j)  (2304 + 64 * (j))
#define XB_TOP      3328
#define XB_TOPGEN   3392
#define XCD_BAR_WORDS 3456
#define XB_SPIN_CAP (1u << 18)

__device__ __forceinline__ unsigned xb_ld(unsigned* p)              { return __hip_atomic_load(p, __ATOMIC_RELAXED, __HIP_MEMORY_SCOPE_AGENT); }
__device__ __forceinline__ unsigned xb_add(unsigned* p, unsigned v) { return __hip_atomic_fetch_add(p, v, __ATOMIC_RELAXED, __HIP_MEMORY_SCOPE_AGENT); }
__device__ __forceinline__ unsigned xb_xcc_id() { return (unsigned)__builtin_amdgcn_s_getreg((3 << 11) | 20) & 0xFu; }
#define XB_SPIN(cond, bar) do { unsigned _sp = 0; while (cond) { __builtin_amdgcn_s_sleep(1); \
    if ((++_sp & 255u) == 0u) { if (xb_ld(&(bar)[XB_TMO])) break; if (_sp > XB_SPIN_CAP) { atomicAdd(&(bar)[XB_TMO], 1u); break; } } } } while (0)

struct XcdBarrier {
    unsigned* bar; unsigned x;
    volatile LAS unsigned* st;
};

__device__ __forceinline__ XcdBarrier xcd_barrier_post(unsigned* bar, volatile LAS unsigned* st) {
    XcdBarrier b; b.bar = bar; b.x = xb_xcc_id(); b.st = st;
    if (threadIdx.x == 0) st[2] = xb_add(&bar[XB_XCNT(b.x)], 1u);
    return b;
}
__device__ __forceinline__ void xcd_barrier_complete(unsigned* bar, unsigned x, unsigned& nloc, unsigned& nx) {
    const unsigned G = gridDim.x * gridDim.y * gridDim.z;
    unsigned sum, cnt, mine, sp = 0u;
    for (;;) {
        sum = 0u; cnt = 0u; mine = 0u;
#pragma unroll
        for (unsigned j = 0; j < 16; ++j) { const unsigned c = xb_ld(&bar[XB_XCNT(j)]); sum += c; cnt += (c > 0u) ? 1u : 0u; mine = (j == x) ? c : mine; }
        if (sum == G) break;
        __builtin_amdgcn_s_sleep(1);
        if ((++sp & 255u) == 0u) { if (xb_ld(&bar[XB_TMO])) break; if (sp > XB_SPIN_CAP) { atomicAdd(&bar[XB_TMO], 1u); break; } }
    }
    nloc = mine > 0u ? mine : 1u; nx = cnt > 0u ? cnt : 1u;
}

__device__ __forceinline__ void xcd_barrier(const XcdBarrier& b) {
    asm volatile("s_waitcnt vmcnt(0)" ::: "memory");
    __syncthreads();
    if (threadIdx.x == 0) {
        unsigned* bar = b.bar;
        __builtin_amdgcn_s_waitcnt(0);
        unsigned nloc = b.st[0], nx = b.st[1];
        if (nloc == 0u) { xcd_barrier_complete(bar, b.x, nloc, nx); b.st[0] = nloc; b.st[1] = nx; }
        const unsigned old = xb_add(&bar[XB_XSUB(b.x)], 1u);
        const unsigned gen = old / nloc;
        if (old + 1u == (gen + 1u) * nloc) {
            __builtin_amdgcn_fence(__ATOMIC_RELEASE, "agent");
            asm volatile("s_waitcnt vmcnt(0)" ::: "memory");
            const unsigned og = xb_add(&bar[XB_TOP], 1u);
            const unsigned tg = og / nx;
            if (og + 1u == (tg + 1u) * nx) xb_add(&bar[XB_TOPGEN], 1u);
            else XB_SPIN(xb_ld(&bar[XB_TOPGEN]) == tg, bar);
            __builtin_amdgcn_fence(__ATOMIC_ACQUIRE, "agent");
            xb_add(&bar[XB_XGEN(b.x)], 1u);
            asm volatile("s_waitcnt vmcnt(0)" ::: "memory");
        } else {
            XB_SPIN(xb_ld(&bar[XB_XGEN(b.x)]) == gen, bar);
            __builtin_amdgcn_fence(__ATOMIC_ACQUIRE, "agent");
            asm volatile("s_waitcnt vmcnt(0)" ::: "memory");
        }
    }
    __syncthreads();
}

constexpr size_t MiB = 1u << 20;
constexpr size_t WS_CTL = 0, CTL_ZERO_BYTES = 1 * MiB;
constexpr size_t WS_MOD = 1 * MiB;
constexpr size_t WS_BGU = WS_MOD + 128 * 1024;
constexpr size_t WS_BCIN = WS_MOD + 256 * 1024;
constexpr size_t WS_BPIN = WS_MOD + 272 * 1024;
constexpr size_t WS_BEFF = WS_MOD + 288 * 1024;
constexpr size_t WS_BPOUT = WS_MOD + 296 * 1024;
constexpr size_t WS_KMP = WS_MOD + 512 * 1024;
constexpr size_t WS_SSQ = 2 * MiB;
constexpr size_t WS_MODP = 3 * MiB;
constexpr size_t WS_ML = 3 * MiB;
constexpr size_t WS_WEFF = 6 * MiB;
constexpr size_t WS_WGU = 8 * MiB;
constexpr size_t WS_WDN = 52 * MiB;
constexpr size_t WS_WCIN = 74 * MiB, WS_WCOUT = 79 * MiB, WS_WPIN = 81 * MiB, WS_WPOUT = 85 * MiB;
constexpr size_t WS_XB = 88 * MiB;
constexpr size_t WS_R1 = 120 * MiB;
constexpr size_t WS_Q = WS_R1, WS_K = WS_R1 + 16 * MiB, WS_V = WS_R1 + 32 * MiB, WS_U = WS_R1 + 48 * MiB, WS_LIST = WS_R1 + 64 * MiB;
constexpr size_t WS_MIX = 208 * MiB;
constexpr size_t WS_PO = 240 * MiB;
constexpr size_t WS_END = 288 * MiB;
constexpr int LIST_PER_HEAD = 256 * 2016;
static_assert(WS_R1 + (size_t)M * DFF * 2 <= WS_MIX && WS_LIST + (size_t)8 * LIST_PER_HEAD * 4 <= WS_MIX && WS_PO + (size_t)3 * M * 512 * 2 <= WS_END, "d_ws map");
constexpr int CW_TMO = 0, CW_CODE = 1, CW_BAR = 4096, CW_CUR = 8192, CUR_STRIDE = 16;

constexpr int RING_OFF = 0, RING_BYTES = 131072;
constexpr int LDSCTL_OFF = RING_BYTES, MISC_OFF = LDSCTL_OFF + 320;
constexpr int TAB_OFF = LDSCTL_OFF + 1024;
constexpr int LDS_BYTES = 147456;
static_assert(TAB_OFF + 2 * 6 * 256 * 4 <= LDS_BYTES, "LDS map");

enum Phase { PH_P0 = 0, PH_P1, PH_L0_GU1, PH_L0_DN1, PH_L0_CIN, PH_L0_CONV, PH_L0_COUT, PH_L0_GU2, PH_L0_DN2,
             PH_L1_GU1, PH_L1_DN1, PH_L1_PIN, PH_L1_SEL, PH_L1_ATTA, PH_L1_ATTB, PH_L1_POUT, PH_L1_GU2, PH_L1_DN2, PH_FINAL, NPHASE };
constexpr int NWAVES = 8;
constexpr int N_LAUNCHES = MK_N_LAUNCHES;

struct Frame {
    LAS unsigned char* lds;
    volatile LAS unsigned* MISC;
    gu32* ctl;
    int tid, lane, wave, G, bx;
    float* out;
    unsigned char* ws;
};
enum InIdx { IN_X = 0, IN_C, IN_ADA_W, IN_ADA_B, IN_FFN_NORM, IN_W_GATE, IN_W_UP, IN_W_DOWN, IN_MIX_NORM, IN_CONV_W_IN, IN_CONV_A_W, IN_CONV_A_B, IN_LN_A_G, IN_LN_A_B, IN_CONV_B_W,
             IN_CONV_W_OUT, IN_PM_W_IN, IN_POOL_W, IN_POOL_B, IN_POOL_SCALE, IN_PM_W_OUT, IN_FINAL_NORM };
typedef __attribute__((address_space(4))) const unsigned char* kptr_t;
__device__ __forceinline__ const float* inptr(int i) {
    kptr_t p = (kptr_t)__builtin_amdgcn_kernarg_segment_ptr(); asm volatile("" : "+s"(p));
    return *(const float* const __attribute__((address_space(4)))*)(p + 8 * i);
}
#define WSP(T, off) ((T*)(F.ws + (off)))

__device__ __forceinline__ float wave_sum(float v) {
#pragma unroll
    for (int o = 1; o < 64; o <<= 1) v += __shfl_xor(v, o);
    return v;
}
__device__ __forceinline__ float bf2f(unsigned h) { return __uint_as_float(h << 16); }
__device__ __forceinline__ void wg_sync() { __syncthreads(); }
__device__ __forceinline__ void lds_sync() { asm volatile("s_waitcnt lgkmcnt(0)" ::: "memory"); __builtin_amdgcn_s_barrier(); asm volatile("" ::: "memory"); }

__device__ __forceinline__ void p0_phase(Frame& F) {
    LAS float* sm = (LAS float*)F.lds;
    LAS float* red = sm + 1024;
    const float* cvec = inptr(IN_C); const float* ada_w = inptr(IN_ADA_W);
    for (int k = F.tid; k < 1024; k += NWAVES * 64) { const float v = cvec[k]; sm[k] = v / (1.0f + expf(-v)); }
    wg_sync();
    for (int wg = F.bx; wg < 256; wg += F.G) {
        const int layer = wg >> 7, cchunk = (wg >> 3) & 15, kchunk = wg & 7;
        const float* W = ada_w + (size_t)layer * 1024 * 9216 + cchunk * 576;
        f32x4 acc[3] = {{0.f, 0.f, 0.f, 0.f}, {0.f, 0.f, 0.f, 0.f}, {0.f, 0.f, 0.f, 0.f}};
#pragma unroll 4
        for (int i = 0; i < 16; ++i) { const int k = kchunk * 128 + F.wave + 8 * i; const float cv = sm[k]; const f32x4* wr_ = (const f32x4*)(W + (size_t)k * 9216);
            acc[0] += wr_[F.lane] * cv; acc[1] += wr_[64 + F.lane] * cv; if (F.lane < 16) acc[2] += wr_[128 + F.lane] * cv; }
        wg_sync();
#pragma unroll
        for (int p = 0; p < 3; ++p) if (p < 2 || F.lane < 16) { LAS float* rp = red + F.wave * 576 + 4 * (64 * p + F.lane);
#pragma unroll
            for (int e = 0; e < 4; ++e) rp[e] = acc[p][e]; }
        wg_sync();
        for (int n = F.tid; n < 576; n += NWAVES * 64) { float t = 0.f;
#pragma unroll
            for (int w = 0; w < NWAVES; ++w) t += red[w * 576 + n];
            WSP(float, WS_MODP)[(size_t)kchunk * 18432 + layer * 9216 + cchunk * 576 + n] = t; }
    }
    { const int gw = F.bx * NWAVES + F.wave, NGW = F.G * NWAVES; bf16* XB = WSP(bf16, WS_XB); float* SSQ = WSP(float, WS_SSQ); const float* xin = inptr(IN_X);
      for (int m0 = gw * 8; m0 < M; m0 += NGW * 8) {
          f32x4 v[8][4];
#pragma unroll
          for (int rr = 0; rr < 8; ++rr)
#pragma unroll
              for (int j = 0; j < 4; ++j) v[rr][j] = ((const f32x4*)(xin + (size_t)(m0 + rr) * D))[F.lane + 64 * j];
#pragma unroll
          for (int rr = 0; rr < 8; ++rr) { float s = 0.f;
#pragma unroll
              for (int j = 0; j < 4; ++j) s += (v[rr][j][0] * v[rr][j][0] + v[rr][j][1] * v[rr][j][1]) + (v[rr][j][2] * v[rr][j][2] + v[rr][j][3] * v[rr][j][3]);
              s = wave_sum(s);
              unsigned long long* o8 = (unsigned long long*)(XB + (size_t)(m0 + rr) * D) + F.lane;
#pragma unroll
              for (int j = 0; j < 4; ++j) o8[64 * j] = (unsigned long long)pk2(v[rr][j][0], v[rr][j][1]) | ((unsigned long long)pk2(v[rr][j][2], v[rr][j][3]) << 32);
              if (F.lane < 4) SSQ[(size_t)F.lane * M + m0 + rr] = F.lane == 0 ? s : 0.f; }
      } }
    const float* pool_w = inptr(IN_POOL_W); const float* pool_scale = inptr(IN_POOL_SCALE); const float* pm_w_out = inptr(IN_PM_W_OUT); const float* pool_b = inptr(IN_POOL_B);
    { LAS float* WO = (LAS float*)(F.lds + 32768); LAS float* PW = (LAS float*)(F.lds + 98304);
      for (int it = F.bx; it < 256; it += F.G) {
        const int g = it >> 6, rg = (it >> 3) & 7, cg = it & 7;
        wg_sync();
#pragma unroll
        for (int j = 0; j < 8; ++j) { const int q = F.tid + 512 * j, d = q >> 5, c4 = q & 31;
            *(LAS f32x4*)(WO + d * 128 + 4 * c4) = *(const f32x4*)(pm_w_out + (size_t)(g * 128 + d) * 1024 + cg * 128 + 4 * c4); }
#pragma unroll
        for (int j = 0; j < 4; ++j) { const int e = F.tid + 512 * j, i = e >> 7, d = e & 127; PW[e] = pool_w[(size_t)(g * 128 + rg * 16 + i) * 128 + d] * pool_scale[g * 128 + d]; }
        wg_sync();
        const int rsub = F.tid >> 7, col = F.tid & 127; float acc[4] = {0.f, 0.f, 0.f, 0.f};
#pragma unroll 4
        for (int d4 = 0; d4 < 32; ++d4) { f32x4 p[4];
#pragma unroll
            for (int i = 0; i < 4; ++i) p[i] = *(const LAS f32x4*)(PW + (4 * rsub + i) * 128 + 4 * d4);
#pragma unroll
            for (int dd = 0; dd < 4; ++dd) { const float w = WO[(4 * d4 + dd) * 128 + col];
#pragma unroll
                for (int i = 0; i < 4; ++i) acc[i] += p[i][dd] * w; } }
#pragma unroll
        for (int i = 0; i < 4; ++i) WSP(float, WS_WEFF)[(size_t)(g * 128 + rg * 16 + 4 * rsub + i) * 1024 + cg * 128 + col] = acc[i];
      } }
    for (int wg = F.bx; wg < 16; wg += F.G) {
        const int n = wg * 64 + F.lane; float sacc = 0.f;
#pragma unroll 16
        for (int kk = 0; kk < 64; ++kk) { const int k = F.wave * 64 + kk; sacc += pool_b[k] * pool_scale[k] * pm_w_out[(size_t)k * 1024 + n]; }
        wg_sync();
        red[F.wave * 64 + F.lane] = sacc;
        wg_sync();
        if (F.tid < 64) { float t = 0.f;
#pragma unroll
            for (int w = 0; w < NWAVES; ++w) t += red[w * 64 + F.tid];
            WSP(float, WS_BEFF)[wg * 64 + F.tid] = t; }
    }
}

__device__ __forceinline__ float modv(const float* modp, const float* ada_b, int idx) {
    float t = ada_b[idx];
#pragma unroll
    for (int j = 0; j < 8; ++j) t += modp[(size_t)j * 18432 + idx];
    return t; }
__device__ __forceinline__ f32x4 modv4(const float* modp, const float* ada_b, int idx) {
    f32x4 t = *(const f32x4*)(ada_b + idx);
#pragma unroll
    for (int j = 0; j < 8; ++j) t += *(const f32x4*)(modp + (size_t)j * 18432 + idx);
    return t; }
__device__ __forceinline__ void prep_strip(Frame& F, const float* src, int ldn, const float* src2, int ksplit, int kbeg, int ktiles,
                                           bf16* dst, int ldk, bool useG, const LAS float* Gs, const LAS float* Ss, const float* modp, const float* ada_b, int gidx, float rs_mul, float* bias_out, LAS float* red) {
    const int r = F.lane >> 4, c16 = F.lane & 15;
    f32x4 rs = {rs_mul, rs_mul, rs_mul, rs_mul};
    if (gidx >= 0) { const f32x4 g = modv4(modp, ada_b, gidx + 4 * c16); rs = g * rs_mul; }
    f32x4 bacc = {0.f, 0.f, 0.f, 0.f};
    for (int t = F.wave; t < ktiles; t += NWAVES) {
        const int k0 = kbeg + 64 * t + 16 * r;
        f32x4 v[16];
#pragma unroll
        for (int i = 0; i < 16; ++i) { const int k = k0 + i; const float* p = (src2 && k >= ksplit) ? src2 + (size_t)k * ldn : src + (size_t)k * ldn; v[i] = *(const f32x4*)(p + 4 * c16); }
        if (useG) {
#pragma unroll
            for (int i = 0; i < 16; ++i) { bacc += v[i] * Ss[k0 + i]; v[i] = v[i] * Gs[k0 + i]; }
        }
#pragma unroll
        for (int e = 0; e < 4; ++e) {
            v4u lo, hi; const float s = rs[e];
            lo.x = pk2(v[0][e] * s, v[1][e] * s);   lo.y = pk2(v[2][e] * s, v[3][e] * s);   lo.z = pk2(v[4][e] * s, v[5][e] * s);   lo.w = pk2(v[6][e] * s, v[7][e] * s);
            hi.x = pk2(v[8][e] * s, v[9][e] * s);   hi.y = pk2(v[10][e] * s, v[11][e] * s); hi.z = pk2(v[12][e] * s, v[13][e] * s); hi.w = pk2(v[14][e] * s, v[15][e] * s);
            bf16* o = dst + (size_t)(4 * c16 + e) * ldk + k0;
            *(v4u*)o = lo; *(v4u*)(o + 8) = hi;
        }
    }
    if (bias_out) {
#pragma unroll
        for (int e = 0; e < 4; ++e) { float s = bacc[e]; s += __shfl_xor(s, 16); s += __shfl_xor(s, 32); bacc[e] = s; }
        if (r == 0) {
#pragma unroll
            for (int e = 0; e < 4; ++e) red[F.wave * 64 + 4 * c16 + e] = bacc[e];
        }
        wg_sync();
        if (F.tid < 64) { float s = 0.f;
#pragma unroll
            for (int w = 0; w < NWAVES; ++w) s += red[w * 64 + F.tid];
            bias_out[F.tid] = s; }
        wg_sync();
    }
}
__device__ __forceinline__ void p1_phase(Frame& F) {
    LAS float* Gs = (LAS float*)F.lds;
    LAS float* Ss = Gs + 1024;
    LAS float* red = Ss + 1024;
    const float* MODP = WSP(float, WS_MODP); const float* ada_b = inptr(IN_ADA_B);
    constexpr int N_GU = 352, N_CIN = 40, N_PIN = 32, N_COUT = 16, N_POUT = 16, N_DN = 256;
    constexpr int NITEMS = N_GU + N_CIN + N_PIN + N_COUT + N_POUT + N_DN;
    for (int it = F.bx; it < NITEMS; it += F.G) {
        int s = it;
        if (s < N_GU + N_CIN + N_PIN) {
            const float* nrm; int md; const float* src; int ldn; bf16* dst; float* bias; int n0, drow;
            if (s < N_GU) { const int f = s / 88, r = s % 88, isup = r / 44; n0 = (r % 44) * 64;
                src = inptr(isup ? IN_W_UP : IN_W_GATE) + (size_t)f * 1024 * DFF + n0; ldn = DFF;
                drow = 256 * (n0 / 128) + 128 * isup + (n0 % 128); dst = WSP(bf16, WS_WGU) + (size_t)f * NGU * 1024 + (size_t)drow * 1024; bias = WSP(float, WS_BGU) + f * NGU + drow;
                nrm = inptr(IN_FFN_NORM) + f * 1024; md = (f >> 1) * 9216 + ((f & 1) ? 6 : 0) * 1024; }
            else if (s < N_GU + N_CIN) { s -= N_GU; n0 = s * 64; const int seg = n0 / 512, c = n0 % 512, t2 = 256 * (c / 128) + (c % 128);
                drow = seg == 0 ? t2 : seg == 1 ? t2 + 128 : seg == 2 ? 2048 + c : seg == 3 ? 1024 + t2 : 1024 + t2 + 128;
                src = inptr(IN_CONV_W_IN) + n0; ldn = NCIN; dst = WSP(bf16, WS_WCIN) + (size_t)drow * 1024; bias = WSP(float, WS_BCIN) + drow;
                nrm = inptr(IN_MIX_NORM); md = 3 * 1024; }
            else { s -= N_GU + N_CIN; n0 = s * 64; drow = n0;
                src = inptr(IN_PM_W_IN) + n0; ldn = NPIN; dst = WSP(bf16, WS_WPIN) + (size_t)drow * 1024; bias = WSP(float, WS_BPIN) + drow;
                nrm = inptr(IN_MIX_NORM) + 1024; md = 9216 + 3 * 1024; }
            for (int k = F.tid; k < 1024; k += NWAVES * 64) { Gs[k] = nrm[k] * (1.0f + modv(MODP, ada_b, md + 1024 + k)); Ss[k] = modv(MODP, ada_b, md + k); }
            wg_sync();
            prep_strip(F, src, ldn, nullptr, 0, 0, 16, dst, 1024, true, Gs, Ss, MODP, ada_b, -1, 1.0f, bias, red);
            continue;
        }
        s -= N_GU + N_CIN + N_PIN;
        if (s < N_COUT) { const int n0 = s * 64;
            prep_strip(F, inptr(IN_CONV_W_OUT) + n0, 1024, nullptr, 0, 0, 16, WSP(bf16, WS_WCOUT) + (size_t)n0 * 1024, 1024, false, Gs, Ss, MODP, ada_b, 5 * 1024 + n0, 1.0f, nullptr, red);
            continue; }
        s -= N_COUT;
        if (s < N_POUT) { const int n0 = s * 64; const int gate = 9216 + 5 * 1024 + n0;
            prep_strip(F, WSP(float, WS_WEFF) + n0, 1024, inptr(IN_PM_W_OUT) + n0, 512, 0, 16, WSP(bf16, WS_WPOUT) + (size_t)n0 * 1024, 1024, false, Gs, Ss, MODP, ada_b, gate, 1.0f, nullptr, red);
            if (F.tid < 64) WSP(float, WS_BPOUT)[n0 + F.tid] = modv(MODP, ada_b, gate + F.tid) * WSP(float, WS_BEFF)[n0 + F.tid];
            continue; }
        s -= N_POUT;
        { const int f = s / 64, r = s % 64, n0 = (r >> 2) * 64, kq = r & 3;
          const int gate = (f >> 1) * 9216 + (((f & 1) ? 6 : 0) + 2) * 1024 + n0;
          prep_strip(F, inptr(IN_W_DOWN) + (size_t)f * DFF * 1024 + n0, 1024, nullptr, 0, 704 * kq, 11, WSP(bf16, WS_WDN) + (size_t)f * 1024 * DFF + (size_t)n0 * DFF, DFF, false, Gs, Ss, MODP, ada_b, gate, 0.5f, nullptr, red); }
    }
}

__device__ __forceinline__ void conv_phase(Frame& F) {
    const bf16* ZC = WSP(bf16, WS_R1); bf16* MIX = WSP(bf16, WS_MIX);
    const int c = F.wave * 64 + F.lane, lane = F.lane;
    LAS float* Y = (LAS float*)F.lds + F.wave * 4096;
    const float* conv_a_w = inptr(IN_CONV_A_W); const float* conv_b_w = inptr(IN_CONV_B_W);
    float w[31];
#pragma unroll
    for (int k = 0; k < 31; ++k) w[k] = conv_a_w[k * 512 + c];
    const float cb = inptr(IN_CONV_A_B)[c], lg = inptr(IN_LN_A_G)[c], lb = inptr(IN_LN_A_B)[c];
    const float w0 = conv_b_w[c], w1 = conv_b_w[512 + c], w2 = conv_b_w[1024 + c];
    const unsigned coff = (unsigned)c * 2u;
    for (int unit = F.bx; unit < M / 64; unit += F.G) {
        const int t0 = __builtin_amdgcn_readfirstlane(unit * 64);
#pragma unroll 1
        for (int hf = 0; hf < 2; ++hf) {
            float a[62]; const int tb = t0 + 32 * hf - 30;
#pragma unroll
            for (int i = 0; i < 62; ++i) { const int t = tb + i; const char* zr = (const char*)ZC + (size_t)(t < 0 ? 0 : t) * 3072; const float v = bf2f(*(const unsigned short*)(zr + coff)); a[i] = t < 0 ? 0.f : v; }
            LAS float* Yh = Y + hf * 2048;
#pragma unroll
            for (int tt = 0; tt < 32; ++tt) { float y = cb;
#pragma unroll
                for (int k = 0; k < 31; ++k) y += w[k] * a[tt + k];
                Yh[tt * 64 + lane] = y; } }
        float mean, rstd;
        { float s1 = 0.f;
#pragma unroll 4
          for (int cc = 0; cc < 64; ++cc) s1 += Y[lane * 64 + ((cc + lane) & 63)];
          mean = s1 * (1.0f / 64.0f); float s2 = 0.f;
#pragma unroll 4
          for (int cc = 0; cc < 64; ++cc) { const float d = Y[lane * 64 + ((cc + lane) & 63)] - mean; s2 += d * d; }
          rstd = 1.0f / sqrtf(s2 * (1.0f / 64.0f) + EPS); }
        char* mrow0 = (char*)MIX + (size_t)t0 * 2048;
#pragma unroll
        for (int tt = 0; tt < 64; ++tt) {
            const float m = __builtin_bit_cast(float, __builtin_amdgcn_readlane(__builtin_bit_cast(int, mean), tt)), r = __builtin_bit_cast(float, __builtin_amdgcn_readlane(__builtin_bit_cast(int, rstd), tt));
            const float yn = (Y[tt * 64 + lane] - m) * r * lg + lb;
            const float sv = yn * __builtin_amdgcn_rcpf(1.0f + __builtin_amdgcn_exp2f(-LOG2E * yn));
            *(unsigned short*)(mrow0 + (size_t)tt * 2048 + coff) = (unsigned short)f2bf(sv); }
        { float cv[66];
#pragma unroll
          for (int i = 0; i < 66; ++i) { const int t = t0 - 2 + i; const char* zr = (const char*)ZC + (size_t)(t < 0 ? 0 : t) * 3072 + 1024; const float v = bf2f(*(const unsigned short*)(zr + coff)); cv[i] = t < 0 ? 0.f : v; }
          const char* zb = (const char*)ZC + (size_t)t0 * 3072 + 2048;
#pragma unroll
          for (int tt = 0; tt < 64; ++tt) { const float bg = bf2f(*(const unsigned short*)(zb + (size_t)tt * 3072 + coff));
              *(unsigned short*)(mrow0 + (size_t)tt * 2048 + 1024 + coff) = (unsigned short)f2bf(bg * (w0 * cv[tt] + w1 * cv[tt + 1] + w2 * cv[tt + 2])); } }
    }
}

__device__ __forceinline__ void unpack8(const v4u q, float (&v)[8]) {
    v[0] = bf2f(q.x & 0xffffu); v[1] = bf2f(q.x >> 16); v[2] = bf2f(q.y & 0xffffu); v[3] = bf2f(q.y >> 16); v[4] = bf2f(q.z & 0xffffu); v[5] = bf2f(q.z >> 16); v[6] = bf2f(q.w & 0xffffu); v[7] = bf2f(q.w >> 16); }
template <int W> __device__ __forceinline__ void pool_strip(const bf16* U, bf16* MIX, int t0, int ch) {
    v4u r[7 + W];
#pragma unroll
    for (int k = 0; k < 7 + W; ++k) { const int t = t0 - (W - 1) + k; const v4u q = *(const v4u*)(U + (size_t)(t < 0 ? 0 : t) * 512 + ch * 8); r[k] = t < 0 ? (v4u){0u, 0u, 0u, 0u} : q; }
    float s[8];
#pragma unroll
    for (int e = 0; e < 8; ++e) s[e] = 0.f;
#pragma unroll
    for (int k = 0; k < W - 1; ++k) { float v[8]; unpack8(r[k], v);
#pragma unroll
        for (int e = 0; e < 8; ++e) s[e] += v[e]; }
#pragma unroll
    for (int i = 0; i < 8; ++i) { float cur[8]; unpack8(r[i + W - 1], cur);
#pragma unroll
        for (int e = 0; e < 8; ++e) s[e] += cur[e];
        const int t = t0 + i; const float inv = 1.0f / (float)((t + 1) < W ? (t + 1) : W); v4u o;
        o.x = pk2(s[0] * inv - cur[0], s[1] * inv - cur[1]); o.y = pk2(s[2] * inv - cur[2], s[3] * inv - cur[3]);
        o.z = pk2(s[4] * inv - cur[4], s[5] * inv - cur[5]); o.w = pk2(s[6] * inv - cur[6], s[7] * inv - cur[7]);
        *(v4u*)(MIX + (size_t)t * 1024 + ch * 8) = o;
        float old[8]; unpack8(r[i], old);
#pragma unroll
        for (int e = 0; e < 8; ++e) s[e] -= old[e]; }
}
__device__ __forceinline__ void pool_items(Frame& F) {
    const bf16* U = WSP(bf16, WS_U); bf16* MIX = WSP(bf16, WS_MIX);
    for (int idx = F.bx * NWAVES * 64 + F.tid; idx < (M / 8) * 64; idx += F.G * NWAVES * 64) {
        const int g = (idx >> 6) & 3, ch = g * 16 + (idx & 15), strip = ((idx >> 8) << 2) | ((idx >> 4) & 3), t0 = strip * 8;
        if (g == 0) pool_strip<2>(U, MIX, t0, ch); else if (g == 1) pool_strip<4>(U, MIX, t0, ch); else if (g == 2) pool_strip<8>(U, MIX, t0, ch); else pool_strip<16>(U, MIX, t0, ch);
    }
}

__device__ __forceinline__ int list_off(int b) { return 256 * (63 * b - (b * (b - 1)) / 2); }
typedef float f32x16_t __attribute__((ext_vector_type(16)));
__device__ __forceinline__ bool gate_gt(float g, int b, float v, int i) { return g > v || (g == v && b < i); }
__device__ __forceinline__ void top3_push(float g, int b, float& v0, int& i0, float& v1, int& i1, float& v2, int& i2) {
    const bool c0 = gate_gt(g, b, v0, i0), c1 = gate_gt(g, b, v1, i1), c2 = gate_gt(g, b, v2, i2);
    const float n2 = c1 ? v1 : (c2 ? g : v2), n1 = c0 ? v0 : (c1 ? g : v1), n0 = c0 ? g : v0;
    const int m2 = c1 ? i1 : (c2 ? b : i2), m1 = c0 ? i0 : (c1 ? b : i1), m0 = c0 ? b : i0;
    v0 = n0; v1 = n1; v2 = n2; i0 = m0; i1 = m1; i2 = m2; }
__device__ __forceinline__ void sel_phase(Frame& F) {
    pool_items(F);
    const bf16* Qb = WSP(bf16, WS_Q); const float* KMP = WSP(float, WS_KMP); unsigned* LIST = WSP(unsigned, WS_LIST);
    LAS unsigned char* KH = F.lds;
    LAS unsigned char* KL = F.lds + 8192;
    LAS unsigned* lcnt = (LAS unsigned*)(F.lds + 16384);
    LAS unsigned* lbase = lcnt + 64;
    const int lane = F.lane, r32 = lane & 31, hi = lane >> 5;
    for (int unit = F.bx; unit < NHEAD * NBLK; unit += F.G) {
        const int h = unit & 7, own = unit >> 3, t = own * 256 + F.wave * 32 + r32;
        wg_sync();
        { const int blk = F.tid >> 3, c = F.tid & 7; const float* k0 = KMP + (size_t)blk * 512 + h * 64 + 8 * c; const float* k1 = k0 + 64 * 512;
          const f32x4 a = (*(const f32x4*)k0 + *(const f32x4*)k1) * (1.0f / 256.0f), b = (*(const f32x4*)(k0 + 4) + *(const f32x4*)(k1 + 4)) * (1.0f / 256.0f);
          const float v[8] = {a[0], a[1], a[2], a[3], b[0], b[1], b[2], b[3]}; unsigned hw[8], lw[8];
#pragma unroll
          for (int e = 0; e < 8; ++e) { hw[e] = f2bf(v[e]); lw[e] = f2bf(v[e] - bf2f(hw[e])); }
          v4u ph = {hw[0] | (hw[1] << 16), hw[2] | (hw[3] << 16), hw[4] | (hw[5] << 16), hw[6] | (hw[7] << 16)}, pl = {lw[0] | (lw[1] << 16), lw[2] | (lw[3] << 16), lw[4] | (lw[5] << 16), lw[6] | (lw[7] << 16)};
          *(LAS v4u*)(KH + c * 1024 + blk * 16) = ph; *(LAS v4u*)(KL + c * 1024 + blk * 16) = pl; }
        if (F.tid < 64) lcnt[F.tid] = 0u;
        wg_sync();
        bf16x8 qr[4];
#pragma unroll
        for (int d0 = 0; d0 < 4; ++d0) qr[d0] = *(const bf16x8*)(Qb + (size_t)t * 512 + h * 64 + d0 * 16 + hi * 8);
        f32x16_t p0 = {}, p1 = {};
#pragma unroll
        for (int d0 = 0; d0 < 4; ++d0) { const int o = hi * 1024 + r32 * 16 + d0 * 2048;
            p0 = __builtin_amdgcn_mfma_f32_32x32x16_bf16(*(const LAS bf16x8*)(KH + o), qr[d0], p0, 0, 0, 0); p1 = __builtin_amdgcn_mfma_f32_32x32x16_bf16(*(const LAS bf16x8*)(KH + o + 512), qr[d0], p1, 0, 0, 0);
            p0 = __builtin_amdgcn_mfma_f32_32x32x16_bf16(*(const LAS bf16x8*)(KL + o), qr[d0], p0, 0, 0, 0); p1 = __builtin_amdgcn_mfma_f32_32x32x16_bf16(*(const LAS bf16x8*)(KL + o + 512), qr[d0], p1, 0, 0, 0); }
        float v0 = -INFINITY, v1 = -INFINITY, v2 = -INFINITY; int i0 = 64, i1 = 64, i2 = 64;
#pragma unroll
        for (int r = 0; r < 16; ++r) { const int b0 = (r & 3) + 8 * (r >> 2) + 4 * hi;
            if (b0 < own) top3_push(p0[r], b0, v0, i0, v1, i1, v2, i2);
            if (b0 + 32 < own) top3_push(p1[r], b0 + 32, v0, i0, v1, i1, v2, i2); }
        { const float w0 = __shfl_xor(v0, 32), w1 = __shfl_xor(v1, 32), w2 = __shfl_xor(v2, 32); const int j0 = __shfl_xor(i0, 32), j1 = __shfl_xor(i1, 32), j2 = __shfl_xor(i2, 32);
          if (j0 < 64) top3_push(w0, j0, v0, i0, v1, i1, v2, i2);
          if (j1 < 64) top3_push(w1, j1, v0, i0, v1, i1, v2, i2);
          if (j2 < 64) top3_push(w2, j2, v0, i0, v1, i1, v2, i2); }
        const int nsel = hi == 0 ? (own < 3 ? own : 3) : 0;
        unsigned q0 = 0, q1 = 0, q2 = 0;
        if (nsel > 0) q0 = __hip_atomic_fetch_add(lcnt + i0, 1u, __ATOMIC_RELAXED, __HIP_MEMORY_SCOPE_WORKGROUP);
        if (nsel > 1) q1 = __hip_atomic_fetch_add(lcnt + i1, 1u, __ATOMIC_RELAXED, __HIP_MEMORY_SCOPE_WORKGROUP);
        if (nsel > 2) q2 = __hip_atomic_fetch_add(lcnt + i2, 1u, __ATOMIC_RELAXED, __HIP_MEMORY_SCOPE_WORKGROUP);
        wg_sync();
        if (F.tid < 64) { const unsigned cn = lcnt[F.tid]; lbase[F.tid] = cn ? atomicAdd((unsigned*)F.ctl + CW_CUR + (h * 64 + F.tid) * CUR_STRIDE, cn) : 0u; }
        wg_sync();
        if (nsel > 0) LIST[(size_t)h * LIST_PER_HEAD + list_off(i0) + lbase[i0] + q0] = (unsigned)t;
        if (nsel > 1) LIST[(size_t)h * LIST_PER_HEAD + list_off(i1) + lbase[i1] + q1] = (unsigned)t | (1u << 16);
        if (nsel > 2) LIST[(size_t)h * LIST_PER_HEAD + list_off(i2) + lbase[i2] + q2] = (unsigned)t | (2u << 16);
    }
}

namespace att {
typedef short s16x4 __attribute__((ext_vector_type(4)));
typedef float f32x16 __attribute__((ext_vector_type(16)));
typedef short v4i16_t __attribute__((ext_vector_type(4)));
typedef float f32x2_t __attribute__((ext_vector_type(2)));
typedef __bf16 bf16x2_t __attribute__((ext_vector_type(2)));
typedef unsigned u32x2_t __attribute__((ext_vector_type(2)));
constexpr int KOFF = 0, VOFF = 32768, WSF_OFF = 65536, QL_OFF = WSF_OFF + 2048, COEF_OFF = QL_OFF + 1024, SCAN_OFF = COEF_OFF + 4096, ATT_LDS_END = SCAN_OFF + 2048;
__device__ __forceinline__ int crow(int r, int hi) { return (r & 3) + 8 * (r >> 2) + 4 * hi; }
__device__ __forceinline__ unsigned cvtpk(float lo, float hi) { f32x2_t v = {lo, hi}; bf16x2_t b = __builtin_convertvector(v, bf16x2_t); return __builtin_bit_cast(unsigned, b); }
__device__ __forceinline__ s16x4 vtr(const LAS unsigned char* p) { return __builtin_bit_cast(s16x4, __builtin_amdgcn_ds_read_tr16_b64_v4i16((LAS v4i16_t*)p)); }
#define ATT_MFMA(a, b, c) __builtin_amdgcn_mfma_f32_32x32x16_bf16(a, b, c, 0, 0, 0)

struct KVRegs { v4u k[4], v[4]; };
__device__ __forceinline__ void kv_issue(KVRegs& R, const bf16* Kb, const bf16* Vb, int b, int h, int wave, int lane) {
    const bf16* ks = Kb + (size_t)(b * 256 + lane) * 512 + h * 64 + wave * 8;
    const bf16* vs = Vb + (size_t)(b * 256 + 16 * (wave & 3) + (lane >> 2)) * 512 + h * 64 + (wave >> 2) * 32 + (lane & 3) * 8;
#pragma unroll
    for (int i = 0; i < 4; ++i) { R.k[i] = *(const v4u*)(ks + (size_t)i * 64 * 512); R.v[i] = *(const v4u*)(vs + (size_t)i * 64 * 512); }
}
__device__ __forceinline__ void kv_commit(LAS unsigned char* lds, const KVRegs& R, int wave, int lane) {
    const int vkey = 16 * (wave & 3) + (lane >> 2);
#pragma unroll
    for (int i = 0; i < 4; ++i) { *(LAS v4u*)(lds + KOFF + i * 8192 + wave * 1024 + lane * 16) = R.k[i];
                                  *(LAS v4u*)(lds + VOFF + i * 8192 + (wave >> 2) * 4096 + vkey * 64 + (lane & 3) * 16) = R.v[i]; }
}
__device__ __forceinline__ void q_load(bf16x8 (&qr)[4], const bf16* Qb, unsigned ent, int h, int hi) {
    const bf16* qp = Qb + (size_t)(ent & 0x3fffu) * 512 + h * 64 + hi * 8;
#pragma unroll
    for (int d0 = 0; d0 < 4; ++d0) qr[d0] = *(const bf16x8*)(qp + d0 * 16);
}
#define ATT_TOUCH4(x) asm volatile("" : "+v"(x[0]), "+v"(x[1]), "+v"(x[2]), "+v"(x[3]))

template <bool OWN, class Pre>
__device__ __forceinline__ void item_compute(Frame& F, int h, int b, unsigned ent, const bf16x8 (&qr)[4], Pre pre) {
    LAS unsigned char* lds = F.lds;
    const int lane = F.lane, wave = F.wave, r32 = lane & 31, hi = lane >> 5;
    const int t = (int)(ent & 0x3fffu);
    const float slope2 = LOG2E / (float)(2 << h);
    float m = -INFINITY, l = 0.f; f32x16 o[2]; o[0] = f32x16{}; o[1] = f32x16{};
    const int ntile = OWN ? ((wave * 32 + 31) >> 6) + 1 : 4;
#pragma unroll 1
    for (int tile = 0; tile < ntile; ++tile) {
        const float base = slope2 * (float)(b * 256 + tile * 64 + 4 * hi - t);
        f32x16 p0, p1;
#pragma unroll
        for (int r = 0; r < 16; ++r) { p0[r] = base + slope2 * (float)((r & 3) + 8 * (r >> 2)); p1[r] = p0[r] + 32.0f * slope2; }
        const LAS unsigned char* kb = lds + KOFF + tile * 8192 + hi * 1024 + r32 * 16;
#pragma unroll
        for (int d0 = 0; d0 < 4; ++d0) { const bf16x8 k0 = *(const LAS bf16x8*)(kb + d0 * 2048), k1 = *(const LAS bf16x8*)(kb + d0 * 2048 + 512);
            p0 = ATT_MFMA(k0, qr[d0], p0); p1 = ATT_MFMA(k1, qr[d0], p1); }
        if (OWN) { const int qo = t - b * 256, kk = tile * 64 + 4 * hi;
#pragma unroll
            for (int r = 0; r < 16; ++r) { const int kv = kk + (r & 3) + 8 * (r >> 2); if (kv > qo) p0[r] = -INFINITY; if (kv + 32 > qo) p1[r] = -INFINITY; } }
        float rm = fmaxf(p0[0], p1[0]);
#pragma unroll
        for (int r = 1; r < 16; ++r) rm = fmaxf(rm, fmaxf(p0[r], p1[r]));
        rm = fmaxf(rm, __shfl_xor(rm, 32));
        const float mn = fmaxf(m, rm), alpha = __builtin_amdgcn_exp2f(m - mn);
        m = mn;
        float ls = 0.f;
#pragma unroll
        for (int r = 0; r < 16; ++r) { p0[r] = __builtin_amdgcn_exp2f(p0[r] - mn); p1[r] = __builtin_amdgcn_exp2f(p1[r] - mn); ls += p0[r] + p1[r]; }
        l = l * alpha + ls;
        if (tile > 0) {
#pragma unroll
            for (int r = 0; r < 16; ++r) { o[0][r] *= alpha; o[1][r] *= alpha; } }
        bf16x8 pa[4];
        { v4u w0 = {cvtpk(p0[0], p0[1]), cvtpk(p0[2], p0[3]), cvtpk(p0[4], p0[5]), cvtpk(p0[6], p0[7])};
          v4u w1 = {cvtpk(p0[8], p0[9]), cvtpk(p0[10], p0[11]), cvtpk(p0[12], p0[13]), cvtpk(p0[14], p0[15])};
          v4u w2 = {cvtpk(p1[0], p1[1]), cvtpk(p1[2], p1[3]), cvtpk(p1[4], p1[5]), cvtpk(p1[6], p1[7])};
          v4u w3 = {cvtpk(p1[8], p1[9]), cvtpk(p1[10], p1[11]), cvtpk(p1[12], p1[13]), cvtpk(p1[14], p1[15])};
          pa[0] = __builtin_bit_cast(bf16x8, w0); pa[1] = __builtin_bit_cast(bf16x8, w1); pa[2] = __builtin_bit_cast(bf16x8, w2); pa[3] = __builtin_bit_cast(bf16x8, w3); }
        const LAS unsigned char* vb = lds + VOFF + tile * 8192 + ((lane >> 4) & 1) * 32 + (lane & 3) * 8 + (4 * hi + ((lane & 15) >> 2)) * 64;
#pragma unroll
        for (int d0 = 0; d0 < 2; ++d0)
#pragma unroll
            for (int ks = 0; ks < 4; ++ks) { const s16x4 lo = vtr(vb + d0 * 4096 + ks * 1024), hh = vtr(vb + d0 * 4096 + ks * 1024 + 512);
                const bf16x8 vf = {lo[0], lo[1], lo[2], lo[3], hh[0], hh[1], hh[2], hh[3]};
                o[d0] = ATT_MFMA(vf, pa[ks], o[d0]); }
    }
    l += __shfl_xor(l, 32);
    pre();
    const size_t dcol = (size_t)h * 64 + 4 * hi;
    if (!OWN) {
        if (!(ent & 0x80000000u)) {
            const int j = (int)((ent >> 16) & 3u); const float rl = 1.0f / l;
            bf16* op = WSP(bf16, WS_PO) + ((size_t)j * M + t) * 512 + dcol;
#pragma unroll
            for (int d0 = 0; d0 < 2; ++d0)
#pragma unroll
                for (int g = 0; g < 4; ++g) { u32x2_t w; w[0] = cvtpk(o[d0][4 * g] * rl, o[d0][4 * g + 1] * rl); w[1] = cvtpk(o[d0][4 * g + 2] * rl, o[d0][4 * g + 3] * rl);
                    *(u32x2_t*)(op + 32 * d0 + 8 * g) = w; }
            if (hi == 0) { f32x2_t ml = {m, l}; *(f32x2_t*)(WSP(float, WS_ML) + (((size_t)j * M + t) * 8 + h) * 2) = ml; }
        }
    } else {
        const int nsel = b < 3 ? b : 3;
        const float* ML = WSP(float, WS_ML); float mj[3], lj[3]; float mx = m;
#pragma unroll
        for (int j = 0; j < 3; ++j) { if (j < nsel) { const f32x2_t ml = *(const f32x2_t*)(ML + (((size_t)j * M + t) * 8 + h) * 2); mj[j] = ml[0]; lj[j] = ml[1]; mx = fmaxf(mx, mj[j]); } else { mj[j] = -INFINITY; lj[j] = 0.f; } }
        u32x2_t pw[3][2][4];
#pragma unroll
        for (int j = 0; j < 3; ++j) if (j < nsel) { const bf16* pp = WSP(bf16, WS_PO) + ((size_t)j * M + t) * 512 + dcol;
#pragma unroll
            for (int d0 = 0; d0 < 2; ++d0)
#pragma unroll
                for (int g = 0; g < 4; ++g) pw[j][d0][g] = *(const u32x2_t*)(pp + 32 * d0 + 8 * g); }
        const float ao = __builtin_amdgcn_exp2f(m - mx); float wj[3]; float den = ao * l;
#pragma unroll
        for (int j = 0; j < 3; ++j) { wj[j] = j < nsel ? lj[j] * __builtin_amdgcn_exp2f(mj[j] - mx) : 0.f; den += wj[j]; }
        const float inv = 1.0f / den, c0 = ao * inv;
        bf16* op = WSP(bf16, WS_MIX) + (size_t)t * 1024 + 512 + dcol;
#pragma unroll
        for (int d0 = 0; d0 < 2; ++d0)
#pragma unroll
            for (int g = 0; g < 4; ++g) { float a[4];
#pragma unroll
                for (int e = 0; e < 4; ++e) a[e] = c0 * o[d0][4 * g + e];
#pragma unroll
                for (int j = 0; j < 3; ++j) if (j < nsel) { const float cj = wj[j] * inv; const u32x2_t q = pw[j][d0][g];
                    a[0] += cj * bf2f(q[0] & 0xffffu); a[1] += cj * bf2f(q[0] >> 16); a[2] += cj * bf2f(q[1] & 0xffffu); a[3] += cj * bf2f(q[1] >> 16); }
                u32x2_t w; w[0] = cvtpk(a[0], a[1]); w[1] = cvtpk(a[2], a[3]); *(u32x2_t*)(op + 32 * d0 + 8 * g) = w; }
    }
}
}

__device__ __forceinline__ void atta_phase(Frame& F) {
    LAS unsigned* SC = (LAS unsigned*)(F.lds + att::SCAN_OFF);
    unsigned* cur = (unsigned*)F.ctl + CW_CUR;
    { const unsigned cn = __hip_atomic_load(cur + F.tid * CUR_STRIDE, __ATOMIC_RELAXED, __HIP_MEMORY_SCOPE_AGENT); SC[F.tid] = (cn + 255u) >> 8; }
    wg_sync();
    for (int off = 1; off < 512; off <<= 1) { const unsigned v = SC[F.tid] + (F.tid >= off ? SC[F.tid - off] : 0u); wg_sync(); SC[F.tid] = v; wg_sync(); }
    const int total = (int)SC[511];
    const bf16* Qb = WSP(bf16, WS_Q); const bf16* Kb = WSP(bf16, WS_K); const bf16* Vb = WSP(bf16, WS_V); const unsigned* LIST = WSP(unsigned, WS_LIST);
    const int row = F.wave * 32 + (F.lane & 31), hi = F.lane >> 5;
    LAS unsigned* ITEM = SC + 512; LAS unsigned* NROW = ITEM + 16;
    if (F.tid < 16) { const int idx_ = F.bx + F.tid * F.G; unsigned it_ = 0u, nr_ = 0u;
        if (idx_ < total) { int lo_ = 0, hi_ = 511; while (lo_ < hi_) { const int mid_ = (lo_ + hi_) >> 1; if ((int)SC[mid_] > idx_) hi_ = mid_; else lo_ = mid_ + 1; }
            const int chunk_ = idx_ - (lo_ ? (int)SC[lo_ - 1] : 0);
            const int cn_ = (int)__hip_atomic_load(cur + lo_ * CUR_STRIDE, __ATOMIC_RELAXED, __HIP_MEMORY_SCOPE_AGENT);
            it_ = (unsigned)lo_ | ((unsigned)chunk_ << 16); nr_ = (unsigned)((cn_ - chunk_ * 256) < 256 ? (cn_ - chunk_ * 256) : 256); }
        ITEM[F.tid] = it_; NROW[F.tid] = nr_; }
    wg_sync();
#define ATTA_DECODE(k_, h_, b_, ent_) do { const unsigned it_ = ITEM[k_]; const int nrows_ = (int)NROW[k_], i_ = (int)(it_ & 0xffffu), chunk_ = (int)(it_ >> 16); h_ = i_ >> 6; b_ = i_ & 63; \
        const unsigned* lp_ = LIST + (size_t)h_ * LIST_PER_HEAD + list_off(b_) + chunk_ * 256; \
        ent_ = lp_[row < nrows_ ? row : nrows_ - 1] | (row < nrows_ ? 0u : 0x80000000u); } while (0)
    int idx = F.bx, kk = 0; if (idx >= total) return;
    int h, b, h1 = 0, b1 = 0, h2 = 0, b2 = 0; unsigned ent, ent1 = 0, ent2 = 0;
    att::KVRegs R; bf16x8 qr[4], qn[4];
    ATTA_DECODE(0, h, b, ent);
    att::kv_issue(R, Kb, Vb, b, h, F.wave, F.lane); att::q_load(qr, Qb, ent, h, hi);
    if (idx + F.G < total) ATTA_DECODE(1, h1, b1, ent1);
    for (;;) {
        lds_sync(); att::kv_commit(F.lds, R, F.wave, F.lane); lds_sync();
        const bool has1 = idx + F.G < total, has2 = idx + 2 * F.G < total && kk + 2 < 16;
        if (has1) { att::kv_issue(R, Kb, Vb, b1, h1, F.wave, F.lane); att::q_load(qn, Qb, ent1, h1, hi); }
        if (has2) ATTA_DECODE(kk + 2, h2, b2, ent2);
#ifdef PROBE_ATT2
        for (int pr_ = 0; pr_ < PROBE_ATT2; ++pr_) att::item_compute<false>(F, h, b, ent, qr, [&]() {});
#endif
        att::item_compute<false>(F, h, b, ent, qr, [&]() { if (has1) {
#pragma unroll
            for (int i = 0; i < 4; ++i) { ATT_TOUCH4(R.k[i]); ATT_TOUCH4(R.v[i]); ATT_TOUCH4(qn[i]); }
            asm volatile("" : "+v"(ent2)); } });
        if (!has1) break;
        idx += F.G; ++kk; h = h1; b = b1; ent = ent1; h1 = h2; b1 = b2; ent1 = ent2;
#pragma unroll
        for (int i = 0; i < 4; ++i) qr[i] = qn[i];
    }
#undef ATTA_DECODE
}
__device__ __forceinline__ void attb_phase(Frame& F) {
    const bf16* Qb = WSP(bf16, WS_Q); const bf16* Kb = WSP(bf16, WS_K); const bf16* Vb = WSP(bf16, WS_V);
    const int row = F.wave * 32 + (F.lane & 31), hi = F.lane >> 5, total = NHEAD * NBLK;
    int idx = F.bx; if (idx >= total) return;
    att::KVRegs R; bf16x8 qr[4], qn[4];
    att::kv_issue(R, Kb, Vb, idx >> 3, idx & 7, F.wave, F.lane); att::q_load(qr, Qb, (unsigned)((idx >> 3) * 256 + row), idx & 7, hi);
    for (;;) {
        lds_sync(); att::kv_commit(F.lds, R, F.wave, F.lane); lds_sync();
        const int nidx = idx + F.G; const bool has1 = nidx < total;
        if (has1) { att::kv_issue(R, Kb, Vb, nidx >> 3, nidx & 7, F.wave, F.lane); att::q_load(qn, Qb, (unsigned)((nidx >> 3) * 256 + row), nidx & 7, hi); }
        att::item_compute<true>(F, idx & 7, idx >> 3, (unsigned)((idx >> 3) * 256 + row), qr, [&]() { if (has1) {
#pragma unroll
            for (int i = 0; i < 4; ++i) { ATT_TOUCH4(R.k[i]); ATT_TOUCH4(R.v[i]); ATT_TOUCH4(qn[i]); } } });
        if (!has1) break;
        idx = nidx;
#pragma unroll
        for (int i = 0; i < 4; ++i) qr[i] = qn[i];
    }
}

__device__ __forceinline__ void final_phase(Frame& F) {
    const int gw = F.bx * NWAVES + F.wave, NGW = F.G * NWAVES; const float* SSQ = WSP(float, WS_SSQ); const bf16* XBp = WSP(bf16, WS_XB);
    f32x4 g[4]; const float* fnorm = inptr(IN_FINAL_NORM);
#pragma unroll
    for (int j = 0; j < 4; ++j) g[j] = ((const f32x4*)fnorm)[F.lane + 64 * j];
    for (int m0 = gw * 4; m0 < M; m0 += NGW * 4) {
        unsigned long long q[4][4]; float ri[4];
#pragma unroll
        for (int rr = 0; rr < 4; ++rr) { const int m = m0 + rr;
            const float s = ((SSQ[m] + SSQ[M + m]) + SSQ[2 * M + m]) + SSQ[3 * M + m]; ri[rr] = 1.0f / sqrtf(s * (1.0f / 1024.0f) + EPS);
#pragma unroll
            for (int j = 0; j < 4; ++j) q[rr][j] = ((const unsigned long long*)(XBp + (size_t)m * D))[F.lane + 64 * j]; }
#pragma unroll
        for (int rr = 0; rr < 4; ++rr) { f32x4* xr = (f32x4*)(F.out + (size_t)(m0 + rr) * D) + F.lane;
#pragma unroll
            for (int j = 0; j < 4; ++j) { const unsigned lo = (unsigned)q[rr][j], hi = (unsigned)(q[rr][j] >> 32);
                const f32x4 v = {__uint_as_float(lo << 16), __uint_as_float(lo & 0xffff0000u), __uint_as_float(hi << 16), __uint_as_float(hi & 0xffff0000u)};
                xr[64 * j] = v * ri[rr] * g[j]; } }
    }
}

struct Args { const float* in[22]; float* out; unsigned char* ws; int ph_lo, ph_hi; };
__global__ void __launch_bounds__(NWAVES * 64, 2) skel_fwd(Args args) {
    extern __shared__ __attribute__((aligned(16))) unsigned char lds[];
    Frame F;
    F.lds = (LAS unsigned char*)lds;
    F.MISC = (volatile LAS unsigned*)(F.lds + MISC_OFF);
    F.tid = threadIdx.x; F.lane = F.tid & 63; F.wave = __builtin_amdgcn_readfirstlane(F.tid >> 6);
    F.G = gridDim.x; F.bx = blockIdx.x;
    F.ws = args.ws; F.ctl = (gu32*)(args.ws + WS_CTL); F.out = args.out;
    for (int u = F.tid; u < (LDS_BYTES - LDSCTL_OFF) / 4; u += NWAVES * 64) ((LAS unsigned*)(F.lds + LDSCTL_OFF))[u] = 0u;
    __syncthreads();
    XcdBarrier bar; bar.bar = (unsigned*)(F.ctl + CW_BAR); bar.x = 0; bar.st = nullptr;
    if (N_LAUNCHES == 1) bar = xcd_barrier_post((unsigned*)(F.ctl + CW_BAR), F.MISC + 8);
    const int lo = args.ph_lo, hi = args.ph_hi;
    unsigned char* ws = F.ws;
#define XB ((const pg8::bf16_t*)(ws + WS_XB))
#define SSQ ((const float*)(ws + WS_SSQ))
#ifndef DBG_ONLY
#define DBG_ONLY -1
#endif
#define IN(k) (lo <= (k) && (k) < hi && (DBG_ONLY < 0 || (k) == DBG_ONLY))
#ifndef PROBE_REPS
#define REPS(k) 1
#else
    constexpr int probe_reps[NPHASE] = PROBE_REPS;
#define REPS(k) probe_reps[k]
#endif
#define REPLOOP(k) for (int rep_ = 0; rep_ < REPS(k); ++rep_, (rep_ < REPS(k) ? xcd_barrier(bar) : (void)0))
#ifdef PROBE_AMP
    unsigned long long ts_prev = __builtin_amdgcn_s_memrealtime(), ts_amp = 0;
#define STAMP(k) do { const unsigned long long now_ = __builtin_amdgcn_s_memrealtime(); if ((k) == PROBE_AMP) ts_amp = now_ - ts_prev; ts_prev = now_; } while (0)
#else
#define STAMP(k) do { } while (0)
#endif
#ifdef PROBE_BAR2
#define SEAM_BAR() do { xcd_barrier(bar); xcd_barrier(bar); } while (0)
#else
#define SEAM_BAR() xcd_barrier(bar)
#endif
#define SEAM(k) do { if (IN(k) && IN((k) + 1)) SEAM_BAR(); STAMP(k); asm volatile("" : "+v"(F.tid), "+v"(F.lane)); asm volatile("" : "+s"(F.ws), "+s"(F.out), "+s"(F.G), "+s"(F.bx), "+s"(F.wave)); ws = F.ws; } while (0)
    LAS float* TAB = (LAS float*)(F.lds + TAB_OFF);

    if (IN(PH_P0)) REPLOOP(PH_P0) { p0_phase(F); } SEAM(PH_P0);
    if (IN(PH_P1)) REPLOOP(PH_P1) { p1_phase(F); } SEAM(PH_P1);
#define FFN_PHASES(f, PH_GU, XIN, F32IN) \
    if (IN(PH_GU)) REPLOOP(PH_GU) { \
        pg8::Gemm g{XB, (const pg8::bf16_t*)(ws + WS_WGU) + (size_t)(f) * NGU * 1024, M, NGU, D}; pg8::StaticOrder S; S.init(M, NGU, F.G, vbx); \
        pg8::fill_tables(TAB, S, SSQ, (const float*)(ws + WS_BGU) + (f) * NGU); pg8::EpiGU E{(pg8::bf16_t*)(ws + WS_R1), TAB}; \
        pg8::gemm_phase<pg8::EpiGU, pg8::StaticOrder, true, true>(F.lds + RING_OFF, g, S, E); } \
    SEAM(PH_GU); \
    if (IN(PH_GU + 1)) REPLOOP(PH_GU + 1) { \
        pg8::Gemm g{(const pg8::bf16_t*)(ws + WS_R1), (const pg8::bf16_t*)(ws + WS_WDN) + (size_t)(f) * 1024 * DFF, M, D, DFF}; pg8::StaticOrder S; S.init(M, D, F.G, vbx); \
        pg8::EpiRes<F32IN> E{XIN, (pg8::bf16_t*)(ws + WS_XB), nullptr, (float*)(ws + WS_SSQ)}; \
        pg8::gemm_phase<pg8::EpiRes<F32IN>, pg8::StaticOrder, false, true>(F.lds + RING_OFF, g, S, E); } \
    SEAM(PH_GU + 1);
#define OUT_PHASE(PH, WOFF, BIAS) \
    if (IN(PH)) REPLOOP(PH) { \
        pg8::Gemm g{(const pg8::bf16_t*)(ws + WS_MIX), (const pg8::bf16_t*)(ws + WOFF), M, D, D}; pg8::StaticOrder S; S.init(M, D, F.G, vbx); \
        pg8::EpiRes<false> E{nullptr, (pg8::bf16_t*)(ws + WS_XB), BIAS, (float*)(ws + WS_SSQ)}; \
        pg8::gemm_phase<pg8::EpiRes<false>, pg8::StaticOrder, false, true>(F.lds + RING_OFF, g, S, E); } \
    SEAM(PH);

    int vbx = F.bx;
    if (N_LAUNCHES == 1 && lo == 0 && F.G == 256) { bool ok = true;
        for (int j = 0; j < 16; ++j) { const unsigned cn = xb_ld(&bar.bar[XB_XCNT(j)]); ok = ok && (cn == (j < 8 ? 32u : 0u)); }
        if (ok) vbx = (int)F.MISC[10] * 8 + (int)bar.x; }
    vbx = __builtin_amdgcn_readfirstlane(vbx);
    FFN_PHASES(0, PH_L0_GU1, inptr(IN_X), true)
    if (IN(PH_L0_CIN)) REPLOOP(PH_L0_CIN) {
        pg8::Gemm g{XB, (const pg8::bf16_t*)(ws + WS_WCIN), M, NCIN, D}; pg8::StaticOrder S; S.init(M, NCIN, F.G, vbx);
        pg8::fill_tables(TAB, S, SSQ, (const float*)(ws + WS_BCIN)); pg8::EpiCin E{(pg8::bf16_t*)(ws + WS_R1), TAB};
        pg8::gemm_phase<pg8::EpiCin, pg8::StaticOrder, true, true>(F.lds + RING_OFF, g, S, E); }
    SEAM(PH_L0_CIN);
    if (IN(PH_L0_CONV)) REPLOOP(PH_L0_CONV) conv_phase(F);
    SEAM(PH_L0_CONV);
    OUT_PHASE(PH_L0_COUT, WS_WCOUT, nullptr)
    FFN_PHASES(1, PH_L0_GU2, nullptr, false)
    FFN_PHASES(2, PH_L1_GU1, nullptr, false)
    if (IN(PH_L1_PIN)) REPLOOP(PH_L1_PIN) {
        pg8::Gemm g{XB, (const pg8::bf16_t*)(ws + WS_WPIN), M, NPIN, D}; pg8::StaticOrder S; S.init(M, NPIN, F.G, vbx);
        pg8::fill_tables(TAB, S, SSQ, (const float*)(ws + WS_BPIN)); pg8::EpiPin E{(pg8::bf16_t*)(ws + WS_Q), TAB, (float*)(ws + WS_KMP)};
        pg8::gemm_phase<pg8::EpiPin, pg8::StaticOrder, true, true>(F.lds + RING_OFF, g, S, E); }
    SEAM(PH_L1_PIN);
    if (IN(PH_L1_SEL)) REPLOOP(PH_L1_SEL) sel_phase(F);
    SEAM(PH_L1_SEL);
    if (IN(PH_L1_ATTA)) REPLOOP(PH_L1_ATTA) atta_phase(F);
    SEAM(PH_L1_ATTA);
    if (IN(PH_L1_ATTB)) REPLOOP(PH_L1_ATTB) attb_phase(F);
    SEAM(PH_L1_ATTB);
    OUT_PHASE(PH_L1_POUT, WS_WPOUT, (const float*)(ws + WS_BPOUT))
    FFN_PHASES(3, PH_L1_GU2, nullptr, false)
    if (IN(PH_FINAL)) REPLOOP(PH_FINAL) final_phase(F);
#ifdef PROBE_AMP
    STAMP(PH_FINAL);
    if (F.bx == 0) { const unsigned long long t0_ = __builtin_amdgcn_s_memrealtime(); while (__builtin_amdgcn_s_memrealtime() - t0_ < 8ull * ts_amp) __builtin_amdgcn_s_sleep(8); }
#endif
#undef IN
#undef SEAM
}

extern "C" void kernel_launch(void* const* d_in, const int* in_sizes, int n_in, void* d_out, int out_size, void* d_ws, size_t ws_size, hipStream_t stream) {
    static int grid = 0;
    if (grid == 0) {
        if (n_in != 22 || in_sizes[0] != M * D || out_size != M * D || ws_size < WS_END) { fprintf(stderr, "kernel_launch: unexpected shapes/workspace (n_in %d, ws %zu < %zu); nothing launched\n", n_in, ws_size, (size_t)WS_END); grid = -1; return; }
        int dev = 0, cus = 0;
        if (hipGetDevice(&dev) != hipSuccess || hipDeviceGetAttribute(&cus, hipDeviceAttributeMultiprocessorCount, dev) != hipSuccess) { grid = -1; return; }
        if (hipFuncSetAttribute((const void*)skel_fwd, hipFuncAttributeMaxDynamicSharedMemorySize, LDS_BYTES) != hipSuccess) { fprintf(stderr, "kernel_launch: hipFuncSetAttribute failed\n"); grid = -1; return; }
        (void)hipGetLastError();
        grid = cus;
        if (grid != 256) fprintf(stderr, "kernel_launch: %d CUs; this kernel is laid out for 256\n", grid);
    }
    if (grid < 0) return;
    if (hipMemsetAsync((char*)d_ws + WS_CTL, 0, CTL_ZERO_BYTES, stream) != hipSuccess) return;
    Args a{};
    for (int i = 0; i < 22; ++i) a.in[i] = (const float*)d_in[i];
    a.out = (float*)d_out; a.ws = (unsigned char*)d_ws;
    for (int li = 0; li < N_LAUNCHES; ++li) {
        a.ph_lo = (N_LAUNCHES == 1) ? 0 : li; a.ph_hi = (N_LAUNCHES == 1) ? (int)NPHASE : li + 1;
        hipLaunchKernelGGL(skel_fwd, dim3(grid), dim3(NWAVES * 64), LDS_BYTES, stream, a);
        if (hipPeekAtLastError() != hipSuccess) { fprintf(stderr, "kernel_launch: launch %d failed\n", li); break; }
    }
}
```
